# Optimizing an MI355X kernel written in HIP

```python
import jax, jax.numpy as jnp
from jax import lax
import numpy as np

D_MODEL = 1024
BATCH = 16
SEQ = 2048
DEPTH = 1

HG_HEADS = 4
HG_KEY_DIM = 128
HG_VAL_DIM = 128
HG_CHUNK = 64
HG_QK_W = HG_HEADS * HG_KEY_DIM
HG_V_W = HG_HEADS * HG_VAL_DIM
ATT_Q_HEADS = 8
ATT_KV_HEADS = 2
ATT_HEAD_DIM = 64
ATT_GROUP = ATT_Q_HEADS // ATT_KV_HEADS
ATT_Q_W = ATT_Q_HEADS * ATT_HEAD_DIM
ATT_KV_W = ATT_KV_HEADS * ATT_HEAD_DIM
WINDOW = 128
ATT_BLOCK = 128
ROPE_THETA = 500000.0
ROPE_DIM = ATT_HEAD_DIM // 4
N_EXPERTS = 32
TOP_K = 4
D_EXPERT = D_MODEL
SWIGLU_ALPHA = 1.702
SWIGLU_LIMIT = 7.0
MOE_BLOCK = 128
EPS = 1e-6
IN_WIDTHS = (HG_QK_W, HG_QK_W, HG_V_W, HG_V_W, ATT_Q_W, ATT_KV_W, ATT_KV_W, D_MODEL, D_MODEL)
IN_WIDTH = HG_QK_W * 2 + HG_V_W * 2 + ATT_Q_W + ATT_KV_W * 2 + D_MODEL * 2

kernel_name = 'hybrid_hgrn2_swa_sink_moe_adaln'


def _split_points():
    pts, acc = [], 0
    for w in IN_WIDTHS[:-1]:
        acc += w
        pts.append(acc)
    return pts


def rms_norm(x, gain):
    xf = x.astype(jnp.float32)
    y = xf * lax.rsqrt(jnp.mean(xf * xf, axis=-1, keepdims=True) + EPS)
    return (y * gain.astype(jnp.float32)).astype(x.dtype)


def partial_rotary(x, positions):
    half = ROPE_DIM // 2
    inv_freq = ROPE_THETA ** (-jnp.arange(half, dtype=jnp.float32) / half)
    ang = positions.astype(jnp.float32)[:, None, :, None] * inv_freq
    cos, sin = jnp.cos(ang), jnp.sin(ang)
    xr = x[..., :ROPE_DIM].astype(jnp.float32)
    x1, x2 = xr[..., :half], xr[..., half:]
    rot = jnp.concatenate([x1 * cos - x2 * sin, x2 * cos + x1 * sin], axis=-1).astype(x.dtype)
    return jnp.concatenate([rot, x[..., ROPE_DIM:]], axis=-1)


def hgrn2_branch(q_pre, f_pre, i_pre, g_pre, lower_bound, out_norm_gain):
    B, S, _ = q_pre.shape
    f32 = jnp.float32

    def heads(t, d):
        return t.reshape(B, S, HG_HEADS, d).transpose(0, 2, 1, 3)

    forget = lower_bound + (1.0 - lower_bound) * jax.nn.sigmoid(f_pre.astype(f32))
    q = heads(jax.nn.silu(q_pre.astype(f32)), HG_KEY_DIM)
    k = heads(1.0 - forget, HG_KEY_DIM)
    log_f = heads(jnp.log(forget), HG_KEY_DIM)
    v = heads(i_pre.astype(f32), HG_VAL_DIM)
    n_chunks = S // HG_CHUNK

    def chunks(t):
        return t.reshape(B, HG_HEADS, n_chunks, HG_CHUNK, t.shape[-1]).transpose(2, 0, 1, 3, 4)

    causal = jnp.tril(jnp.ones((HG_CHUNK, HG_CHUNK), dtype=bool))[:, :, None]

    def step(state, inp):
        qc, kc, vc, lfc = inp
        b = jnp.cumsum(lfc, axis=-2)
        o_inter = jnp.einsum('bhck,bhkv->bhcv', qc * jnp.exp(b), state)
        rel = b[:, :, :, None, :] - b[:, :, None, :, :]
        decay = jnp.exp(jnp.where(causal, rel, -jnp.inf))
        scores = jnp.einsum('bhik,bhjk,bhijk->bhij', qc, kc, decay)
        o = o_inter + jnp.einsum('bhij,bhjv->bhiv', scores, vc)
        b_last = b[:, :, -1:, :]
        new_state = jnp.exp(b_last[:, :, 0, :])[..., None] * state + jnp.einsum(
            'bhjk,bhjv->bhkv', kc * jnp.exp(b_last - b), vc)
        return new_state, o

    state0 = jnp.zeros((B, HG_HEADS, HG_KEY_DIM, HG_VAL_DIM), f32)
    _, o = lax.scan(step, state0, (chunks(q), chunks(k), chunks(v), chunks(log_f)))
    o = o.transpose(1, 2, 0, 3, 4).reshape(B, HG_HEADS, S, HG_VAL_DIM).transpose(0, 2, 1, 3)
    o = rms_norm(o, out_norm_gain).reshape(B, S, HG_V_W) * jax.nn.silu(g_pre.astype(f32))
    return o.astype(q_pre.dtype)


def swa_branch(q_pre, k_pre, v_pre, positions, q_gain, k_gain, sinks):
    B, S, _ = q_pre.shape
    nb = S // ATT_BLOCK
    f32 = jnp.float32
    q = q_pre.reshape(B, S, ATT_Q_HEADS, ATT_HEAD_DIM).transpose(0, 2, 1, 3)
    k = k_pre.reshape(B, S, ATT_KV_HEADS, ATT_HEAD_DIM).transpose(0, 2, 1, 3)
    v = v_pre.reshape(B, S, ATT_KV_HEADS, ATT_HEAD_DIM).transpose(0, 2, 1, 3)
    q = partial_rotary(rms_norm(q, q_gain), positions)
    k = partial_rotary(rms_norm(k, k_gain), positions)
    q = q.reshape(B, ATT_KV_HEADS, ATT_GROUP, nb, ATT_BLOCK, ATT_HEAD_DIM)

    def banded(t):
        tb = t.reshape(B, ATT_KV_HEADS, nb, ATT_BLOCK, ATT_HEAD_DIM)
        prev = jnp.pad(tb, ((0, 0), (0, 0), (1, 0), (0, 0), (0, 0)))[:, :, :-1]
        return jnp.concatenate([prev, tb], axis=3)

    kb, vb = banded(k), banded(v)
    scores = jnp.einsum('bhgnqd,bhnkd->bhgnqk', q, kb).astype(f32) * (ATT_HEAD_DIM ** -0.5)
    blk = jnp.arange(nb)[:, None] * ATT_BLOCK
    q_pos = blk + jnp.arange(ATT_BLOCK)[None, :]
    k_pos = blk - ATT_BLOCK + jnp.arange(2 * ATT_BLOCK)[None, :]
    dist = q_pos[:, :, None] - k_pos[:, None, :]
    mask = (dist >= 0) & (dist < WINDOW) & (k_pos[:, None, :] >= 0)
    scores = jnp.where(mask, scores, -jnp.inf)
    sink = sinks.astype(f32).reshape(1, ATT_KV_HEADS, ATT_GROUP, 1, 1, 1)
    logits = jnp.concatenate([scores, jnp.broadcast_to(sink, scores.shape[:-1] + (1,))], axis=-1)
    probs = jax.nn.softmax(logits, axis=-1)[..., :-1]
    out = jnp.einsum('bhgnqk,bhnkd->bhgnqd', probs.astype(vb.dtype), vb)
    out = out.reshape(B, ATT_Q_HEADS, S, ATT_HEAD_DIM).transpose(0, 2, 1, 3)
    return out.reshape(B, S, ATT_Q_W)


def moe_ffn(h, w_router, b_router, w_up, b_up, w_down, b_down):
    B, S, D = h.shape
    T = B * S
    A = T * TOP_K
    xf = h.reshape(T, D)
    logits = (xf @ w_router + b_router).astype(jnp.float32)
    top_vals, top_idx = lax.top_k(logits, TOP_K)
    gates = jax.nn.softmax(top_vals, axis=-1)
    flat_e = top_idx.reshape(A)
    flat_tok = (jnp.arange(A, dtype=jnp.int32) // TOP_K).astype(jnp.int32)
    flat_w = gates.reshape(A)
    order = jnp.argsort(flat_e)
    sorted_e = flat_e[order]
    counts = jnp.bincount(flat_e, length=N_EXPERTS)
    padded = (counts + MOE_BLOCK - 1) // MOE_BLOCK * MOE_BLOCK
    start = jnp.cumsum(counts) - counts
    pad_end = jnp.cumsum(padded)
    pad_start = pad_end - padded
    dest = pad_start[sorted_e] + jnp.arange(A) - start[sorted_e]
    P = A + N_EXPERTS * MOE_BLOCK
    n_blocks = P // MOE_BLOCK
    tok_buf = jnp.full((P,), T, jnp.int32).at[dest].set(flat_tok[order])
    w_buf = jnp.zeros((P,), jnp.float32).at[dest].set(flat_w[order])
    block_expert = jnp.minimum(
        jnp.searchsorted(pad_end, jnp.arange(n_blocks) * MOE_BLOCK, side='right'), N_EXPERTS - 1)
    x_pad = jnp.concatenate([xf, jnp.zeros((1, D), xf.dtype)], axis=0)
    x_buf = x_pad[tok_buf].reshape(n_blocks, MOE_BLOCK, D)

    def expert_block(args):
        xb, e = args
        hu = xb @ w_up[e] + b_up[e]
        x_glu = jnp.minimum(hu[:, ::2], SWIGLU_LIMIT)
        x_lin = jnp.clip(hu[:, 1::2], -SWIGLU_LIMIT, SWIGLU_LIMIT)
        act = x_glu * jax.nn.sigmoid(SWIGLU_ALPHA * x_glu) * (x_lin + 1.0)
        return act @ w_down[e] + b_down[e]

    y_buf = lax.map(expert_block, (x_buf, block_expert)).reshape(P, D)
    y = jax.ops.segment_sum(y_buf * w_buf[:, None].astype(y_buf.dtype), tok_buf, num_segments=T + 1)[:T]
    return y.reshape(B, S, D)


def setup_inputs(seed: int = 0) -> dict:
    key = jax.random.key(seed)
    ks = jax.random.split(key, 24)
    D = D_MODEL
    f32 = jnp.float32

    def dense(k, shape, fan_in, scale=1.0):
        return jax.random.normal(k, shape, f32) * (scale * fan_in ** -0.5)

    def gain(k, shape):
        return 1.0 + 0.02 * jax.random.normal(k, shape, f32)

    x = jax.random.normal(ks[0], (BATCH, SEQ, D), f32)
    c = jax.random.normal(ks[1], (BATCH, D), f32)
    positions = (jax.random.randint(ks[2], (BATCH, 1), 0, 4096, dtype=jnp.int32)
                 + jnp.arange(SEQ, dtype=jnp.int32)[None, :]).astype(jnp.int32)
    return {
        'x': x,
        'c': c,
        'positions': positions,
        'w_ada': dense(ks[3], (DEPTH, D, 6 * D), D, 0.5),
        'b_ada': 0.02 * jax.random.normal(ks[4], (DEPTH, 6 * D), f32),
        'norm1_gain': gain(ks[5], (DEPTH, D)),
        'w_in': dense(ks[6], (DEPTH, D, IN_WIDTH), D),
        'lower_bound_logits': 0.1 * jax.random.normal(ks[7], (DEPTH + 1, HG_QK_W), f32),
        'hg_norm_gain': gain(ks[8], (DEPTH, HG_VAL_DIM)),
        'w_hg_branch': dense(ks[9], (DEPTH, HG_V_W, D), HG_V_W),
        'q_norm_gain': gain(ks[10], (DEPTH, ATT_HEAD_DIM)),
        'k_norm_gain': gain(ks[11], (DEPTH, ATT_HEAD_DIM)),
        'attn_sinks': jax.random.normal(ks[12], (DEPTH, ATT_Q_HEADS), f32),
        'w_attn_branch': dense(ks[13], (DEPTH, ATT_Q_W, D), ATT_Q_W),
        'w_out': dense(ks[14], (DEPTH, D, D), D),
        'norm2_gain': gain(ks[15], (DEPTH, D)),
        'w_router': dense(ks[16], (DEPTH, D, N_EXPERTS), D),
        'b_router': 0.01 * jax.random.normal(ks[17], (DEPTH, N_EXPERTS), f32),
        'w_up': dense(ks[18], (DEPTH, N_EXPERTS, D, 2 * D_EXPERT), D),
        'b_up': 0.01 * jax.random.normal(ks[19], (DEPTH, N_EXPERTS, 2 * D_EXPERT), f32),
        'w_down': dense(ks[20], (DEPTH, N_EXPERTS, D_EXPERT, D), D_EXPERT),
        'b_down': 0.01 * jax.random.normal(ks[21], (DEPTH, N_EXPERTS, D), f32),
    }


def reference(x, c, positions, w_ada, b_ada, norm1_gain, w_in, lower_bound_logits, hg_norm_gain,
              w_hg_branch, q_norm_gain, k_norm_gain, attn_sinks, w_attn_branch, w_out, norm2_gain,
              w_router, b_router, w_up, b_up, w_down, b_down):
    lower_bounds = jnp.cumsum(jax.nn.softmax(lower_bound_logits.astype(jnp.float32), axis=0), axis=0)
    cond = jax.nn.silu(c)
    split_pts = _split_points()
    for l in range(DEPTH):
        mod = cond @ w_ada[l] + b_ada[l]
        sh1, sc1, g1, sh2, sc2, g2 = jnp.split(mod[:, None, :], 6, axis=-1)
        h = rms_norm(x, norm1_gain[l]) * (1.0 + sc1) + sh1
        proj = h @ w_in[l]
        hq, hf, hi, hg, aq, ak, av, gate_h, gate_a = jnp.split(proj, split_pts, axis=-1)
        y_h = hgrn2_branch(hq, hf, hi, hg, lower_bounds[l], hg_norm_gain[l]) @ w_hg_branch[l]
        y_a = swa_branch(aq, ak, av, positions, q_norm_gain[l], k_norm_gain[l], attn_sinks[l]) @ w_attn_branch[l]
        merged = jax.nn.sigmoid(gate_h) * y_h + jax.nn.sigmoid(gate_a) * y_a
        x = x + g1 * (merged @ w_out[l])
        h2 = rms_norm(x, norm2_gain[l]) * (1.0 + sc2) + sh2
        x = x + g2 * moe_ffn(h2, w_router[l], b_router[l], w_up[l], b_up[l], w_down[l], b_down[l])
    return x
```

```cpp
#include <hip/hip_runtime.h>
#include <cstdio>
#include <cstdint>
#include <cmath>

typedef unsigned short bf16;
constexpr int BATCH = 16, SEQ = 2048, DM = 1024, T = BATCH * SEQ;
constexpr int INW = 4864, NEXP = 32, TOPK = 4, DEXP = 1024;
constexpr float EPS = 1e-6f;

constexpr size_t MiB = 1u << 20;
constexpr size_t WS_CTL = 0;
constexpr size_t WS_MOD = 1 * MiB;
constexpr size_t WS_LB = 1 * MiB + 512 * 1024;
constexpr size_t WS_BUPP = 2 * MiB;
constexpr size_t WS_TOKL = 4 * MiB;
constexpr size_t WS_GATL = 8 * MiB;
constexpr size_t WS_TOPI = 12 * MiB;
constexpr size_t WS_TOPW = 13 * MiB;
constexpr size_t WS_WIN = 16 * MiB, WS_WHG = 26 * MiB, WS_WATT = 27 * MiB, WS_WOUT = 28 * MiB, WS_WUP = 32 * MiB, WS_WDN = 160 * MiB;
constexpr size_t WS_H2 = 224 * MiB;
constexpr size_t WS_R = 290 * MiB;
constexpr size_t WS_XN = WS_R, WS_QH = WS_R + 64 * MiB, WS_LF = WS_R + 96 * MiB, WS_VH = WS_R + 160 * MiB, WS_GH = WS_R + 192 * MiB,
                 WS_AQ = WS_R + 224 * MiB, WS_AKV = WS_R + 256 * MiB, WS_SGH = WS_R + 272 * MiB, WS_SGA = WS_R + 336 * MiB,
                 WS_HOAO = WS_R + 400 * MiB, WS_MRG = WS_R + 464 * MiB;
constexpr size_t WS_ACT = WS_R, WS_Y = WS_R + 272 * MiB;
constexpr size_t WS_TMP = 820 * MiB;
constexpr size_t WS_OTMP = WS_TMP, WS_QN = WS_TMP + 64 * MiB, WS_KN = WS_TMP + 128 * MiB;
constexpr size_t WS_END = 964 * MiB;

__device__ __forceinline__ float bf2f(bf16 v) { return __uint_as_float((unsigned)v << 16); }
__device__ __forceinline__ bf16 f2bf(float f) { unsigned u = __float_as_uint(f); return (bf16)((u + 0x7fffu + ((u >> 16) & 1u)) >> 16); }
__device__ __forceinline__ float silu_f(float x) { return x / (1.f + __expf(-x)); }
__device__ __forceinline__ float sigm_f(float x) { return 1.f / (1.f + __expf(-x)); }
__device__ __forceinline__ float wave_sum(float v) {
#pragma unroll
    for (int o = 1; o < 64; o <<= 1) v += __shfl_xor(v, o);
    return v;
}

__device__ __forceinline__ void rope_cs(int pos, int i, float& cs, float& sn) {
    const float invf = exp2f(-(float)i * 0.125f * 18.931568569324174f);
    double a = (double)pos * (double)invf * 0.15915494309189535; a -= floor(a);
    sn = __builtin_amdgcn_sinf((float)a); cs = __builtin_amdgcn_cosf((float)a);
}
#ifndef DEV_ORACLE
#define DEV_ORACLE 0
#endif
#if DEV_ORACLE
__global__ void n_mod(const float* c, const float* w_ada, const float* b_ada, float* MOD) {
    const int n = blockIdx.x * 256 + threadIdx.x, b = blockIdx.y;
    __shared__ float cond[1024];
    for (int k = threadIdx.x; k < 1024; k += 256) cond[k] = silu_f(c[b * 1024 + k]);
    __syncthreads();
    float acc = 0.f;
    for (int k = 0; k < 1024; ++k) acc += cond[k] * w_ada[(size_t)k * 6144 + n];
    MOD[b * 6144 + n] = acc + b_ada[n];
}
__global__ void n_misc(const float* lbl, float* LB, bf16* H2) {
    const int i = blockIdx.x * 256 + threadIdx.x;
    if (i < 512) LB[i] = 1.f / (1.f + __expf(lbl[512 + i] - lbl[i]));
    if (i < 1024) H2[(size_t)T * 1024 + i] = 0;
}
__global__ void k_normmod(const float* x, const float* gain, const float* MOD, int sh_off, int sc_off, bf16* out) {
    const int lane = threadIdx.x & 63, row = blockIdx.x * 4 + (threadIdx.x >> 6), b = row / SEQ;
    const float4* xr = (const float4*)(x + (size_t)row * DM) + lane;
    float4 v[4]; float s = 0.f;
#pragma unroll
    for (int j = 0; j < 4; ++j) { v[j] = xr[64 * j]; s += v[j].x * v[j].x + v[j].y * v[j].y + v[j].z * v[j].z + v[j].w * v[j].w; }
    const float rstd = rsqrtf(wave_sum(s) * (1.f / DM) + EPS);
    const float* mb = MOD + (size_t)b * 6144;
#pragma unroll
    for (int j = 0; j < 4; ++j) {
        const int c = 4 * lane + 256 * j;
        const float4 g = *(const float4*)(gain + c), sc = *(const float4*)(mb + sc_off + c), sh = *(const float4*)(mb + sh_off + c);
        ushort4 o;
        o.x = f2bf(v[j].x * rstd * g.x * (1.f + sc.x) + sh.x); o.y = f2bf(v[j].y * rstd * g.y * (1.f + sc.y) + sh.y);
        o.z = f2bf(v[j].z * rstd * g.z * (1.f + sc.z) + sh.z); o.w = f2bf(v[j].w * rstd * g.w * (1.f + sc.w) + sh.w);
        *(ushort4*)(out + (size_t)row * DM + c) = o;
    }
}
template <class Epi> __global__ void n_gemm(const bf16* A, int lda, const float* W, int N, int K, Epi epi) {
    __shared__ float As[16][65], Ws[16][65];
    const int tx = threadIdx.x & 15, ty = threadIdx.x >> 4, m0 = blockIdx.y * 64, n0 = blockIdx.x * 64;
    float acc[4][4];
#pragma unroll
    for (int i = 0; i < 4; ++i)
#pragma unroll
        for (int j = 0; j < 4; ++j) acc[i][j] = 0.f;
    for (int k0 = 0; k0 < K; k0 += 16) {
        for (int i = threadIdx.x; i < 1024; i += 256) { const int r = i >> 4, kk = i & 15; As[kk][r] = bf2f(A[(size_t)(m0 + r) * lda + k0 + kk]); }
        for (int i = threadIdx.x; i < 1024; i += 256) { const int kk = i >> 6, cc = i & 63; Ws[kk][cc] = W[(size_t)(k0 + kk) * N + n0 + cc]; }
        __syncthreads();
#pragma unroll
        for (int kk = 0; kk < 16; ++kk) {
            float a[4], b[4];
#pragma unroll
            for (int i = 0; i < 4; ++i) { a[i] = As[kk][ty * 4 + i]; b[i] = Ws[kk][tx * 4 + i]; }
#pragma unroll
            for (int i = 0; i < 4; ++i)
#pragma unroll
                for (int j = 0; j < 4; ++j) acc[i][j] += a[i] * b[j];
        }
        __syncthreads();
    }
#pragma unroll
    for (int i = 0; i < 4; ++i)
#pragma unroll
        for (int j = 0; j < 4; ++j) epi(m0 + ty * 4 + i, n0 + tx * 4 + j, acc[i][j]);
}
struct EpiInN {
    bf16* QH; float* LF; bf16 *VH, *GH, *AQ, *AKV, *SGH, *SGA; const float* LB;
    __device__ void operator()(int r, int c, float v) const {
        if (c < 512) QH[(size_t)r * 512 + c] = f2bf(silu_f(v));
        else if (c < 1024) { const int cc = c - 512; const float lb = LB[cc]; LF[(size_t)r * 512 + cc] = __logf(lb + (1.f - lb) * sigm_f(v)); }
        else if (c < 1536) VH[(size_t)r * 512 + (c - 1024)] = f2bf(v);
        else if (c < 2048) GH[(size_t)r * 512 + (c - 1536)] = f2bf(silu_f(v));
        else if (c < 2560) AQ[(size_t)r * 512 + (c - 2048)] = f2bf(v);
        else if (c < 2816) AKV[(size_t)r * 256 + (c - 2560)] = f2bf(v);
        else if (c < 3840) SGH[(size_t)r * 1024 + (c - 2816)] = f2bf(sigm_f(v));
        else SGA[(size_t)r * 1024 + (c - 3840)] = f2bf(sigm_f(v));
    }
};
struct EpiM1N { bf16* MRG; const bf16* SG; __device__ void operator()(int r, int c, float v) const { MRG[(size_t)r * 1024 + c] = f2bf(bf2f(SG[(size_t)r * 1024 + c]) * v); } };
struct EpiM2N { bf16* MRG; const bf16* SG; __device__ void operator()(int r, int c, float v) const { MRG[(size_t)r * 1024 + c] = f2bf(bf2f(MRG[(size_t)r * 1024 + c]) + bf2f(SG[(size_t)r * 1024 + c]) * v); } };
struct EpiOutN { const float* x; const float* MOD; float* out; __device__ void operator()(int r, int c, float v) const { out[(size_t)r * 1024 + c] = x[(size_t)r * 1024 + c] + MOD[(size_t)(r / SEQ) * 6144 + 2048 + c] * v; } };

__global__ void n_hgrn(const bf16* QH, const float* LF, const bf16* VH, float* OTMP) {
    const int bh = blockIdx.x >> 1, vh = blockIdx.x & 1, b = bh >> 2, h = bh & 3, v = threadIdx.x;
    __shared__ float S[128 * 64];
    __shared__ float sq[128], sf[128], sk[128];
    for (int i = v; i < 128 * 64; i += 64) S[i] = 0.f;
    for (int t = 0; t < SEQ; ++t) {
        const size_t row = (size_t)b * SEQ + t;
        __syncthreads();
        for (int k = v; k < 128; k += 64) { const float lf = LF[row * 512 + h * 128 + k]; const float f = __expf(lf); sf[k] = f; sk[k] = 1.f - f; sq[k] = bf2f(QH[row * 512 + h * 128 + k]); }
        __syncthreads();
        const float vv = bf2f(VH[row * 512 + h * 128 + vh * 64 + v]);
        float o = 0.f;
        for (int k = 0; k < 128; ++k) { float s = S[k * 64 + v]; s = sf[k] * s + sk[k] * vv; S[k * 64 + v] = s; o += s * sq[k]; }
        OTMP[row * 512 + h * 128 + vh * 64 + v] = o;
    }
}
__global__ void n_hgrn_norm(const float* OTMP, const float* gain, const bf16* GH, bf16* HOAO) {
    const int lane = threadIdx.x & 63, idx = blockIdx.x * 4 + (threadIdx.x >> 6), t = idx >> 2, h = idx & 3;
    const float a = OTMP[(size_t)t * 512 + h * 128 + lane], b = OTMP[(size_t)t * 512 + h * 128 + 64 + lane];
    const float rstd = rsqrtf(wave_sum(a * a + b * b) * (1.f / 128.f) + EPS);
    HOAO[(size_t)t * 1024 + h * 128 + lane] = f2bf(a * rstd * gain[lane] * bf2f(GH[(size_t)t * 512 + h * 128 + lane]));
    HOAO[(size_t)t * 1024 + h * 128 + 64 + lane] = f2bf(b * rstd * gain[64 + lane] * bf2f(GH[(size_t)t * 512 + h * 128 + 64 + lane]));
}
__global__ void n_qkn(const bf16* AQ, const bf16* AKV, const int* pos, const float* qg, const float* kg, float* QN, float* KN) {
    const int idx = blockIdx.x * 256 + threadIdx.x, t = idx / 10, j = idx % 10;
    if (t >= T) return;
    const bf16* src = j < 8 ? AQ + (size_t)t * 512 + j * 64 : AKV + (size_t)t * 256 + (j - 8) * 64;
    const float* g = j < 8 ? qg : kg;
    float* dst = j < 8 ? QN + (size_t)t * 512 + j * 64 : KN + (size_t)t * 128 + (j - 8) * 64;
    float ss = 0.f;
    for (int d = 0; d < 64; ++d) { const float v = bf2f(src[d]); ss += v * v; }
    const float rstd = rsqrtf(ss * (1.f / 64.f) + EPS);
    const int p = pos[t];
    for (int d = 0; d < 64; ++d) {
        float v = bf2f(src[d]) * rstd * g[d];
        if (d < 16) {
            const int i = d & 7; float cs, sn; rope_cs(p, i, cs, sn);
            const float x1 = bf2f(src[i]) * rstd * g[i], x2 = bf2f(src[i + 8]) * rstd * g[i + 8];
            v = d < 8 ? x1 * cs - x2 * sn : x2 * cs + x1 * sn;
        }
        dst[d] = v;
    }
}
__global__ void __launch_bounds__(256) n_attn(const float* QN, const float* KN, const bf16* AKV, const float* sinks, bf16* HOAO) {
    const int idx = blockIdx.x * 256 + threadIdx.x, t = idx >> 3, hq = idx & 7, kvh = hq >> 2, ts = t % SEQ, b0 = t - ts;
    float q[64], acc[64];
#pragma unroll
    for (int d = 0; d < 64; ++d) { q[d] = QN[(size_t)t * 512 + hq * 64 + d] * 0.125f; acc[d] = 0.f; }
    float m = sinks[hq], l = 1.f;
    for (int kt = (ts >= 127 ? ts - 127 : 0); kt <= ts; ++kt) {
        const float* kr = KN + (size_t)(b0 + kt) * 128 + kvh * 64; const bf16* vr = AKV + (size_t)(b0 + kt) * 256 + 128 + kvh * 64;
        float s = 0.f;
#pragma unroll
        for (int d = 0; d < 64; ++d) s += q[d] * kr[d];
        const float mn = fmaxf(m, s), sc = __expf(m - mn), p = __expf(s - mn);
        l = l * sc + p; m = mn;
#pragma unroll
        for (int d = 0; d < 64; ++d) acc[d] = acc[d] * sc + p * bf2f(vr[d]);
    }
    const float il = 1.f / l;
#pragma unroll
    for (int d = 0; d < 64; ++d) HOAO[(size_t)t * 1024 + 512 + hq * 64 + d] = f2bf(acc[d] * il);
}
__global__ void __launch_bounds__(256) n_route(const float* x1, const float* gain, const float* MOD, const float* wr, const float* br, bf16* H2, int* TOPI, float* TOPW) {
    const int lane = threadIdx.x & 63, row = blockIdx.x * 4 + (threadIdx.x >> 6), b = row / SEQ;
    const float4* xr = (const float4*)(x1 + (size_t)row * DM) + lane;
    float4 v[4]; float s = 0.f;
#pragma unroll
    for (int j = 0; j < 4; ++j) { v[j] = xr[64 * j]; s += v[j].x * v[j].x + v[j].y * v[j].y + v[j].z * v[j].z + v[j].w * v[j].w; }
    const float rstd = rsqrtf(wave_sum(s) * (1.f / DM) + EPS);
    const float* mb = MOD + (size_t)b * 6144;
    float hv[16];
#pragma unroll
    for (int j = 0; j < 4; ++j) {
        const int c = 4 * lane + 256 * j;
        const float4 g = *(const float4*)(gain + c), sc = *(const float4*)(mb + 4096 + c), sh = *(const float4*)(mb + 3072 + c);
        hv[4 * j + 0] = v[j].x * rstd * g.x * (1.f + sc.x) + sh.x; hv[4 * j + 1] = v[j].y * rstd * g.y * (1.f + sc.y) + sh.y;
        hv[4 * j + 2] = v[j].z * rstd * g.z * (1.f + sc.z) + sh.z; hv[4 * j + 3] = v[j].w * rstd * g.w * (1.f + sc.w) + sh.w;
        ushort4 o; o.x = f2bf(hv[4 * j]); o.y = f2bf(hv[4 * j + 1]); o.z = f2bf(hv[4 * j + 2]); o.w = f2bf(hv[4 * j + 3]);
        *(ushort4*)(H2 + (size_t)row * DM + c) = o;
    }
    float lg[32];
#pragma unroll
    for (int e = 0; e < 32; ++e) {
        float p = 0.f;
#pragma unroll
        for (int j = 0; j < 4; ++j)
#pragma unroll
            for (int i = 0; i < 4; ++i) p += hv[4 * j + i] * wr[(size_t)(4 * lane + 256 * j + i) * 32 + e];
        lg[e] = wave_sum(p) + br[e];
    }
    unsigned used = 0u; float tv[4]; int ti[4];
#pragma unroll
    for (int k = 0; k < 4; ++k) {
        float best = -INFINITY; int bi = 0;
#pragma unroll
        for (int e = 0; e < 32; ++e) { const bool ok = !((used >> e) & 1u) && lg[e] > best; best = ok ? lg[e] : best; bi = ok ? e : bi; }
        used |= 1u << bi; tv[k] = best; ti[k] = bi;
    }
    const float e1 = __expf(tv[1] - tv[0]), e2 = __expf(tv[2] - tv[0]), e3 = __expf(tv[3] - tv[0]), inv = 1.f / (1.f + e1 + e2 + e3);
    if (lane == 0) {
        TOPI[row * 4 + 0] = ti[0]; TOPI[row * 4 + 1] = ti[1]; TOPI[row * 4 + 2] = ti[2]; TOPI[row * 4 + 3] = ti[3];
        TOPW[row * 4 + 0] = inv; TOPW[row * 4 + 1] = e1 * inv; TOPW[row * 4 + 2] = e2 * inv; TOPW[row * 4 + 3] = e3 * inv;
    }
}
__global__ void n_moe(const bf16* H2, const int* TOPI, const float* TOPW, const float* w_up, const float* b_up, const float* w_dn, const float* b_dn, bf16* Y) {
    const int a = blockIdx.x, t = a >> 2, tid = threadIdx.x, e = TOPI[a];
    const float gate = TOPW[a];
    __shared__ float hr[1024], av[1024];
    for (int k = tid; k < 1024; k += 256) hr[k] = bf2f(H2[(size_t)t * 1024 + k]);
    __syncthreads();
    const float* wu = w_up + (size_t)e * 1024 * 2048; const float* bu = b_up + (size_t)e * 2048;
    float ag[4], al[4];
#pragma unroll
    for (int j = 0; j < 4; ++j) { ag[j] = 0.f; al[j] = 0.f; }
    for (int k = 0; k < 1024; ++k) {
        const float h = hr[k];
#pragma unroll
        for (int j = 0; j < 4; ++j) { const float2 w = *(const float2*)(wu + (size_t)k * 2048 + 2 * (tid + 256 * j)); ag[j] += h * w.x; al[j] += h * w.y; }
    }
#pragma unroll
    for (int j = 0; j < 4; ++j) {
        const int o = tid + 256 * j;
        const float g = fminf(ag[j] + bu[2 * o], 7.f), li = fminf(fmaxf(al[j] + bu[2 * o + 1], -7.f), 7.f);
        av[o] = g * sigm_f(1.702f * g) * (li + 1.f);
    }
    __syncthreads();
    const float* wd = w_dn + (size_t)e * 1024 * 1024; const float* bd = b_dn + (size_t)e * 1024;
    float y[4];
#pragma unroll
    for (int j = 0; j < 4; ++j) y[j] = 0.f;
    for (int k = 0; k < 1024; ++k) {
        const float h = av[k];
#pragma unroll
        for (int j = 0; j < 4; ++j) y[j] += h * wd[(size_t)k * 1024 + tid + 256 * j];
    }
#pragma unroll
    for (int j = 0; j < 4; ++j) Y[(size_t)a * 1024 + tid + 256 * j] = f2bf(gate * (y[j] + bd[tid + 256 * j]));
}
__global__ void k_final(float* out, const float* MOD, const bf16* Y) {
    const int lane = threadIdx.x & 63, row = blockIdx.x * 4 + (threadIdx.x >> 6), b = row / SEQ;
    const float* g2 = MOD + (size_t)b * 6144 + 5120;
#pragma unroll
    for (int j = 0; j < 4; ++j) {
        const int c = 4 * lane + 256 * j;
        float4 x = *(float4*)(out + (size_t)row * DM + c); const float4 g = *(const float4*)(g2 + c);
        float s0 = 0.f, s1 = 0.f, s2 = 0.f, s3 = 0.f;
#pragma unroll
        for (int k = 0; k < 4; ++k) { const ushort4 y = *(const ushort4*)(Y + ((size_t)row * 4 + k) * DM + c); s0 += bf2f(y.x); s1 += bf2f(y.y); s2 += bf2f(y.z); s3 += bf2f(y.w); }
        x.x += g.x * s0; x.y += g.y * s1; x.z += g.z * s2; x.w += g.w * s3;
        *(float4*)(out + (size_t)row * DM + c) = x;
    }
}

#endif

namespace pg8 {
#define PG8_LAS __attribute__((address_space(3)))
typedef unsigned short bf16_t;
typedef short bf16x8 __attribute__((ext_vector_type(8)));
typedef float f32x4 __attribute__((ext_vector_type(4)));
typedef unsigned u32x4 __attribute__((ext_vector_type(4)));
constexpr int BM = 256, BK = 64, HALF = 128, HTB = HALF * BK * 2  , STAGE_BYTES = 8 * HTB, NXCD = 8, WGM = 8;

__host__ __device__ __forceinline__ int lds_byte(int r, int c) { const int st = (r >> 4) * 2 + (c >> 5), rr = r & 15, cc = c & 31, ob = rr * 64 + cc * 2; return st * 1024 + (ob ^ (((ob >> 9) & 1) << 5)); }
__host__ __device__ __forceinline__ void stage_rc(int b, int& R, int& C) { const int st = b / 1024, sb = b % 1024, swz = sb ^ (((sb >> 9) & 1) << 5); R = (st >> 1) * 16 + swz / 64; C = (st & 1) * 32 + (swz % 64) / 2; }
__host__ __device__ __forceinline__ int perm32(int rho) { const int n = rho >> 4, i = rho & 15; return 8 * (i >> 2) + 4 * n + (i & 3); }

struct Unit { int pm, pn, arow0, nvalid; };
struct Gemm { const bf16_t* A; const bf16_t* Bt; int M, N, K; const int* rowidx; int zero_row; int lda; };

struct StaticOrder {
    int nM, nN, nwg, G, c;
    __host__ __device__ void init(int M, int N, int G_, int c_) { nM = M / BM; nN = N / BM; nwg = nM * nN; G = G_; c = c_; }
    __host__ __device__ bool next(int i, Unit& u) const {
        const long L = (long)i * G + c; if (L >= nwg) return false;
        int wgid = (int)L; { const int q = nwg / NXCD, r = nwg % NXCD, xcd = wgid % NXCD, off = wgid / NXCD; wgid = (xcd < r ? xcd * (q + 1) : r * (q + 1) + (xcd - r) * q) + off; }
        const int nig = WGM * nN, gid = wgid / nig, fm = gid * WGM, gsz = (nM - fm) < WGM ? (nM - fm) : WGM;
        u.pm = fm + ((wgid % nig) % gsz); u.pn = (wgid % nig) / gsz; u.arow0 = 0; u.nvalid = 0; return true;
    }
};
__device__ __forceinline__ unsigned cvt_pk_bf16(float lo, float hi) { unsigned r; asm volatile("v_cvt_pk_bf16_f32 %0, %1, %2" : "=v"(r) : "v"(lo), "v"(hi)); return r; }

template <class Epi, class Sched, bool ALIGN_EPI, bool GATHER>
__device__ __forceinline__ void gemm_phase(PG8_LAS unsigned char* lds, const Gemm g, const Sched& S, const Epi& E) {
    const int tid = threadIdx.x, wid = __builtin_amdgcn_readfirstlane(tid >> 6), lane = tid & 63, wr = wid >> 2, wc = wid & 3, fr = lane & 15, fq = lane >> 4;
    const int K = g.K, nt = K / BK, lda = g.lda;
    unsigned voffA[2], voffB[2];
#pragma unroll
    for (int i = 0; i < 2; ++i) { int R, C; stage_rc(tid * 16 + i * 8192, R, C); const int Rb = Epi::PERM ? ((R & ~31) + perm32(R & 31)) : R;
        voffA[i] = (unsigned)(R * lda + C) * 2u; voffB[i] = (unsigned)(Rb * K + C) * 2u; }
    unsigned tokP[2], cpk = 0;
    const size_t kstep = (size_t)(BK * 2);
    const size_t hstep = (size_t)HALF * K * 2;
    const size_t hstepA = GATHER ? 0 : (size_t)HALF * lda * 2; const size_t tstepA = (size_t)BM * lda * 2;
    const size_t tstep = 2 * hstep;
    const unsigned ldsw = (unsigned)wid * 1024u;
    const int aoff = lds_byte(wr * 64 + fr, fq * 8), boff = lds_byte(wc * 32 + fr, fq * 8);
#define PG8_SA(b, h) (((b) * 2 + (h)) * HTB)
#define PG8_SB(b, h) ((4 + (b) * 2 + (h)) * HTB)
#define PG8_STAGE(bufoff, gbase, voff) do { _Pragma("unroll") for (int _i = 0; _i < 2; ++_i) \
        __builtin_amdgcn_global_load_lds((const unsigned*)((const char*)(gbase) + (voff)[_i]), (PG8_LAS unsigned*)(lds + (bufoff) + ldsw + _i * 8192), 16, 0, 0); } while (0)
#define PG8_STAGE_A(b, h, gbase) do { if constexpr (GATHER) { _Pragma("unroll") for (int _i = 0; _i < 2; ++_i) { const unsigned off_ = ((tokP[_i] >> (16 * (h))) & 0xffffu) * (unsigned)(lda * 2) + ((cpk >> (8 * _i)) & 0xffu); \
        __builtin_amdgcn_global_load_lds((const unsigned*)((const char*)(gbase) + off_), (PG8_LAS unsigned*)(lds + PG8_SA(b, h) + ldsw + _i * 8192), 16, 0, 0); } } else { PG8_STAGE(PG8_SA(b, h), (gbase) + (h) * hstepA, voffA); } } while (0)
#define PG8_GOFF(dst, u) do { _Pragma("unroll") for (int _i = 0; _i < 2; ++_i) { int R_, C_; stage_rc(tid * 16 + _i * 8192, R_, C_); \
        const int t0_ = (R_ < (u).nvalid) ? (g.rowidx[(u).arow0 + R_] >> 2) : g.zero_row, t1_ = (HALF + R_ < (u).nvalid) ? (g.rowidx[(u).arow0 + HALF + R_] >> 2) : g.zero_row; dst[_i] = (unsigned)t0_ | ((unsigned)t1_ << 16); } } while (0)
#define PG8_LDA(dst, b, h) do { _Pragma("unroll") for (int m = 0; m < 4; ++m) _Pragma("unroll") for (int k = 0; k < 2; ++k) dst[m][k] = *(const PG8_LAS bf16x8*)(lds + PG8_SA(b, h) + aoff + m * 2048 + k * 1024); } while (0)
#define PG8_LDB(dst, b, h) do { _Pragma("unroll") for (int n = 0; n < 2; ++n) _Pragma("unroll") for (int k = 0; k < 2; ++k) dst[n][k] = *(const PG8_LAS bf16x8*)(lds + PG8_SB(b, h) + boff + n * 2048 + k * 1024); } while (0)
#define PG8_MMA(ai, bj, At, Bt) do { __builtin_amdgcn_s_setprio(1); _Pragma("unroll") for (int m = 0; m < 4; ++m) _Pragma("unroll") for (int n = 0; n < 2; ++n) _Pragma("unroll") for (int k = 0; k < 2; ++k) \
        acc[ai][bj][m][n] = __builtin_amdgcn_mfma_f32_16x16x32_bf16(Bt[n][k], At[m][k], acc[ai][bj][m][n], 0, 0, 0); __builtin_amdgcn_s_setprio(0); } while (0)
#define PG8_WAIT_V(n) asm volatile("s_waitcnt vmcnt(" #n ")" ::: "memory")
#define PG8_WAIT_L(n) asm volatile("s_waitcnt lgkmcnt(" #n ")" ::: "memory")
#define PG8_BAR __builtin_amdgcn_s_barrier()
#define PG8_SCHED __builtin_amdgcn_sched_barrier(0)
    Unit cur, nxt; int ui = 0;
    if (!S.next(0, cur)) return;
    f32x4 acc[2][2][4][2];
#pragma unroll
    for (int a = 0; a < 2; ++a)
#pragma unroll
        for (int b = 0; b < 2; ++b)
#pragma unroll
            for (int m = 0; m < 4; ++m)
#pragma unroll
                for (int n = 0; n < 2; ++n) acc[a][b][m][n] = (f32x4){0.f, 0.f, 0.f, 0.f};
    bf16x8 At[4][2], B0[2][2], B1[2][2];
    const char* cA = GATHER ? (const char*)g.A : (const char*)g.A + (size_t)cur.pm * tstepA; const char* cB = (const char*)g.Bt + (size_t)cur.pn * tstep;
    if constexpr (GATHER) { PG8_GOFF(tokP, cur); int R0_, C0_, R1_, C1_; stage_rc(tid * 16, R0_, C0_); stage_rc(tid * 16 + 8192, R1_, C1_); cpk = (unsigned)(C0_ * 2) | ((unsigned)(C1_ * 2) << 8); }
    PG8_STAGE(PG8_SB(0, 0), cB, voffB); PG8_STAGE(PG8_SB(0, 1), cB + hstep, voffB); PG8_STAGE_A(0, 0, cA); PG8_STAGE_A(0, 1, cA);
    if (wr == 1) PG8_BAR;
    PG8_WAIT_V(2); PG8_BAR;
    PG8_STAGE(PG8_SB(1, 0), cB + kstep, voffB); PG8_STAGE_A(1, 0, cA + kstep); PG8_STAGE(PG8_SB(1, 1), cB + hstep + kstep, voffB);
    PG8_WAIT_V(6); PG8_BAR;
    for (;;) {
        const bool has_next = S.next(ui + 1, nxt);
        if constexpr (GATHER) { if (has_next) { unsigned tokN[2]; PG8_GOFF(tokN, nxt); *(PG8_LAS unsigned long long*)(lds + STAGE_BYTES + tid * 8) = (unsigned long long)tokN[0] | ((unsigned long long)tokN[1] << 32); } }
        const char* nA = GATHER ? cA : (has_next ? (const char*)g.A + (size_t)nxt.pm * tstepA : cA); const char* nB = has_next ? (const char*)g.Bt + (size_t)nxt.pn * tstep : cB;
        for (int t = 0; t < nt; t += 2) {
            const bool last = (t == nt - 2);
            const char* a1 = cA + (size_t)(t + 1) * kstep;
            const char* a2 = last ? nA : cA + (size_t)(t + 2) * kstep; const char* b2 = last ? nB : cB + (size_t)(t + 2) * kstep;
            const char* a3 = a2 + kstep; const char* b3 = b2 + kstep;
            PG8_LDB(B0, 0, 0); PG8_LDB(B1, 0, 1); PG8_SCHED; PG8_LDA(At, 0, 0); PG8_STAGE_A(1, 1, a1);
            PG8_WAIT_V(8); PG8_WAIT_L(0); PG8_BAR; PG8_MMA(0, 0, At, B0); PG8_MMA(0, 1, At, B1); PG8_BAR; PG8_SCHED;
            if constexpr (GATHER) { if (last && has_next) { const unsigned long long tn_ = *(const PG8_LAS unsigned long long*)(lds + STAGE_BYTES + tid * 8); tokP[0] = (unsigned)tn_; tokP[1] = (unsigned)(tn_ >> 32); } }
            PG8_LDA(At, 0, 1); PG8_STAGE(PG8_SB(0, 0), b2, voffB); PG8_STAGE(PG8_SB(0, 1), b2 + hstep, voffB); PG8_STAGE_A(0, 0, a2);
            PG8_WAIT_V(8); PG8_WAIT_L(0); PG8_BAR; PG8_MMA(1, 0, At, B0); PG8_MMA(1, 1, At, B1); PG8_BAR; PG8_SCHED;
            PG8_LDB(B0, 1, 0); PG8_LDB(B1, 1, 1); PG8_SCHED; PG8_LDA(At, 1, 0); PG8_STAGE_A(0, 1, a2);
            PG8_WAIT_V(8); PG8_WAIT_L(0); PG8_BAR; PG8_MMA(0, 0, At, B0); PG8_MMA(0, 1, At, B1); PG8_BAR; PG8_SCHED;
            PG8_LDA(At, 1, 1); PG8_STAGE(PG8_SB(1, 0), b3, voffB); PG8_STAGE(PG8_SB(1, 1), b3 + hstep, voffB); PG8_STAGE_A(1, 0, a3);
            PG8_WAIT_V(8); PG8_WAIT_L(0); PG8_BAR; PG8_MMA(1, 0, At, B0); PG8_MMA(1, 1, At, B1); PG8_BAR; PG8_SCHED;
        }
        if constexpr (ALIGN_EPI) { if (wr == 0) PG8_BAR; }
        E(acc, cur, wr, wc, fr, fq);
        if (!has_next) break;
#pragma unroll
        for (int a = 0; a < 2; ++a)
#pragma unroll
            for (int b = 0; b < 2; ++b)
#pragma unroll
                for (int m = 0; m < 4; ++m)
#pragma unroll
                    for (int n = 0; n < 2; ++n) acc[a][b][m][n] = (f32x4){0.f, 0.f, 0.f, 0.f};
        cur = nxt; cA = nA; cB = nB; ++ui;
        if constexpr (ALIGN_EPI) { if (wr == 1) PG8_BAR; }
    }
    PG8_WAIT_V(0);
    if constexpr (!ALIGN_EPI) { if (wr == 0) PG8_BAR; }
    PG8_BAR;
#undef PG8_SA
#undef PG8_SB
#undef PG8_STAGE
#undef PG8_STAGE_A
#undef PG8_GOFF
#undef PG8_LDA
#undef PG8_LDB
#undef PG8_MMA
#undef PG8_WAIT_V
#undef PG8_WAIT_L
#undef PG8_BAR
#undef PG8_SCHED
}
}

constexpr int NWAVES = 8;
constexpr int LDS_BYTES = 163840;
constexpr int LDSCTL_OFF = 162816;
constexpr int MISC_OFF = LDSCTL_OFF;
constexpr int CW_BAR = 4096;
constexpr int CW_CNT = 64;
constexpr size_t CTL_ZERO_BYTES = 64 * 1024;

#define GAS __attribute__((address_space(1)))
#define LAS __attribute__((address_space(3)))
typedef unsigned v4u __attribute__((ext_vector_type(4)));
typedef float f32x4 __attribute__((ext_vector_type(4)));
typedef short bf16x8 __attribute__((ext_vector_type(8)));
typedef GAS unsigned gu32;
#define RLX_AGENT __ATOMIC_RELAXED, __HIP_MEMORY_SCOPE_AGENT
#define LDS_WAIT() asm volatile("s_waitcnt lgkmcnt(0)" ::: "memory")
#define VM_WAIT() asm volatile("s_waitcnt vmcnt(0)" ::: "memory")
__device__ __forceinline__ unsigned pk2(float lo, float hi) { return (unsigned)f2bf(lo) | ((unsigned)f2bf(hi) << 16); }
__device__ __forceinline__ float fsigm(float x) { return __builtin_amdgcn_rcpf(1.f + __expf(-x)); }

#define XB_TMO      128
#define XB_XCNT(j)  (256  + 64 * (j))
#define XB_XSUB(j)  (1280 + 64 * (j))
#define XB_XGEN(j)  (2304 + 64 * (j))
#define XB_TOP      3328
#define XB_TOPGEN   3392
#define XCD_BAR_WORDS 3456
#define XB_SPIN_CAP (1u << 18)

__device__ __forceinline__ unsigned xb_ld(unsigned* p)              { return __hip_atomic_load(p, __ATOMIC_RELAXED, __HIP_MEMORY_SCOPE_AGENT); }
__device__ __forceinline__ unsigned xb_add(unsigned* p, unsigned v) { return __hip_atomic_fetch_add(p, v, __ATOMIC_RELAXED, __HIP_MEMORY_SCOPE_AGENT); }
__device__ __forceinline__ unsigned xb_xcc_id() { return (unsigned)__builtin_amdgcn_s_getreg((3 << 11) | 20) & 0xFu; }
#define XB_SPIN(cond, bar) do { unsigned _sp = 0; while (cond) { __builtin_amdgcn_s_sleep(1); \
    if ((++_sp & 255u) == 0u) { if (xb_ld(&(bar)[XB_TMO])) break; if (_sp > XB_SPIN_CAP) { atomicAdd(&(bar)[XB_TMO], 1u); break; } } } } while (0)

struct XcdBarrier {
    unsigned* bar; unsigned x;
    volatile LAS unsigned* st;
};

__device__ __forceinline__ XcdBarrier xcd_barrier_post(unsigned* bar, volatile LAS unsigned* st) {
    XcdBarrier b; b.bar = bar; b.x = xb_xcc_id(); b.st = st;
    if (threadIdx.x == 0) (void)xb_add(&bar[XB_XCNT(b.x)], 1u);
    return b;
}
__device__ __forceinline__ void xcd_barrier_complete(unsigned* bar, unsigned x, unsigned& nloc, unsigned& nx) {
    const unsigned G = gridDim.x * gridDim.y * gridDim.z;
    unsigned sum, cnt, mine, sp = 0u;
    for (;;) {
        sum = 0u; cnt = 0u; mine = 0u;
#pragma unroll
        for (unsigned j = 0; j < 16; ++j) { const unsigned c = xb_ld(&bar[XB_XCNT(j)]); sum += c; cnt += (c > 0u) ? 1u : 0u; mine = (j == x) ? c : mine; }
        if (sum == G) break;
        __builtin_amdgcn_s_sleep(1);
        if ((++sp & 255u) == 0u) { if (xb_ld(&bar[XB_TMO])) break; if (sp > XB_SPIN_CAP) { atomicAdd(&bar[XB_TMO], 1u); break; } }
    }
    nloc = mine > 0u ? mine : 1u; nx = cnt > 0u ? cnt : 1u;
}

__device__ __forceinline__ void xcd_barrier(const XcdBarrier& b) {
    asm volatile("s_waitcnt vmcnt(0)" ::: "memory");
    __syncthreads();
    if (threadIdx.x == 0) {
        unsigned* bar = b.bar;
        __builtin_amdgcn_s_waitcnt(0);
        unsigned nloc = b.st[0], nx = b.st[1];
        if (nloc == 0u) { xcd_barrier_complete(bar, b.x, nloc, nx); b.st[0] = nloc; b.st[1] = nx; }
        const unsigned old = xb_add(&bar[XB_XSUB(b.x)], 1u);
        const unsigned gen = old / nloc;
        if (old + 1u == (gen + 1u) * nloc) {
            __builtin_amdgcn_fence(__ATOMIC_RELEASE, "agent");
            asm volatile("s_waitcnt vmcnt(0)" ::: "memory");
            const unsigned og = xb_add(&bar[XB_TOP], 1u);
            const unsigned tg = og / nx;
            if (og + 1u == (tg + 1u) * nx) xb_add(&bar[XB_TOPGEN], 1u);
            else XB_SPIN(xb_ld(&bar[XB_TOPGEN]) == tg, bar);
            __builtin_amdgcn_fence(__ATOMIC_ACQUIRE, "agent");
            xb_add(&bar[XB_XGEN(b.x)], 1u);
            asm volatile("s_waitcnt vmcnt(0)" ::: "memory");
        } else {
            XB_SPIN(xb_ld(&bar[XB_XGEN(b.x)]) == gen, bar);
            __builtin_amdgcn_fence(__ATOMIC_ACQUIRE, "agent");
            asm volatile("s_waitcnt vmcnt(0)" ::: "memory");
        }
    }
    __syncthreads();
}

struct Frame {
    LAS unsigned char* lds; volatile LAS unsigned* MISC; gu32* ctl; int tid, lane, wave, G;
    const float *x, *c; const int* pos; const float *w_ada, *b_ada, *n1g, *w_in, *lbl, *hgg, *w_hg, *qg, *kg, *sinks, *w_att, *w_out, *n2g, *w_r, *b_r, *w_up, *b_up, *w_dn, *b_dn;
    float* out; unsigned char* ws;
};
__device__ __forceinline__ int up_vrow(int c) { const int o = c >> 1; return 256 * (o >> 7) + 128 * (c & 1) + (o & 127); }

template <int MAP> __device__ __forceinline__ void p0_item(const float* W, int K, int N, bf16* WT, LAS float* scr, int kb, int nb, int lane) {
    const int k0 = 64 * kb, n0 = 64 * nb;
#pragma unroll 4
    for (int i = 0; i < 16; ++i) { const int kk = 4 * i + (lane >> 4); const f32x4 v = *(const GAS f32x4*)(W + (size_t)(k0 + kk) * N + n0 + 4 * (lane & 15));
        LAS float* d = scr + kk * 65 + 4 * (lane & 15); d[0] = v.x; d[1] = v.y; d[2] = v.z; d[3] = v.w; }
    LDS_WAIT(); asm volatile("" ::: "memory");
    const int c = lane >> 3;
#pragma unroll
    for (int j = 0; j < 8; ++j) { const int n = (lane & 7) + 8 * j; const LAS float* s = scr + (8 * c) * 65 + n;
        v4u o; o.x = pk2(s[0], s[65]); o.y = pk2(s[130], s[195]); o.z = pk2(s[260], s[325]); o.w = pk2(s[390], s[455]);
        const int col = n0 + n, row = MAP ? up_vrow(col) : col;
        *(GAS v4u*)(WT + (size_t)row * K + k0 + 8 * c) = o; }
    LDS_WAIT(); asm volatile("" ::: "memory");
}
__device__ __forceinline__ void p0_mod(Frame& F) {
    LAS float* cT = (LAS float*)F.lds;
    LAS float* red = (LAS float*)(F.lds + 69632);
    const int wg = blockIdx.x;
    for (int i = F.tid; i < 16 * 1024; i += 512) { const int b = i >> 10, k = i & 1023; cT[k * 16 + (k >> 4) * 4 + b] = silu_f(F.c[i]); }
    __syncthreads();
    const int ks = F.tid >> 3, c4 = F.tid & 7, col = wg * 32 + 4 * c4;
    float acc[16][4];
#pragma unroll
    for (int b = 0; b < 16; ++b)
#pragma unroll
        for (int j = 0; j < 4; ++j) acc[b][j] = 0.f;
#pragma unroll 4
    for (int r = 0; r < 16; ++r) {
        const int k = ks * 16 + r; const f32x4 w = *(const GAS f32x4*)(F.w_ada + (size_t)k * 6144 + col);
        const LAS f32x4* cp = (const LAS f32x4*)(cT + k * 16 + (k >> 4) * 4);
#pragma unroll
        for (int q = 0; q < 4; ++q) { const f32x4 cv = cp[q];
#pragma unroll
            for (int j = 0; j < 4; ++j) { acc[4 * q + j][0] += cv[j] * w.x; acc[4 * q + j][1] += cv[j] * w.y; acc[4 * q + j][2] += cv[j] * w.z; acc[4 * q + j][3] += cv[j] * w.w; } }
    }
#pragma unroll
    for (int b = 0; b < 16; ++b)
#pragma unroll
        for (int j = 0; j < 4; ++j) { float v = acc[b][j]; v += __shfl_xor(v, 8); v += __shfl_xor(v, 16); v += __shfl_xor(v, 32); acc[b][j] = v; }
    if (F.lane < 8) {
#pragma unroll
        for (int b = 0; b < 16; ++b)
#pragma unroll
            for (int j = 0; j < 4; ++j) red[(F.wave * 16 + b) * 32 + 4 * c4 + j] = acc[b][j];
    }
    __syncthreads();
    { const int b = F.tid >> 5, cc = F.tid & 31; float s = 0.f;
#pragma unroll
      for (int w = 0; w < 8; ++w) s += red[(w * 16 + b) * 32 + cc];
      ((float*)(F.ws + WS_MOD))[b * 6144 + wg * 32 + cc] = s + F.b_ada[wg * 32 + cc]; }
    __syncthreads();
}
__device__ __forceinline__ void p0_prologue(Frame& F) {
    if (blockIdx.x < 192) p0_mod(F);
    else {
        const int i = ((int)blockIdx.x - 192) * 512 + F.tid;
        float* BUPP = (float*)(F.ws + WS_BUPP);
#pragma unroll
        for (int q = 0; q < 2; ++q) { const int idx = i * 2 + q, e = idx >> 11, c = idx & 2047; BUPP[e * 2048 + up_vrow(c)] = F.b_up[idx]; }
        if (i < 512) ((float*)(F.ws + WS_LB))[i] = 1.f / (1.f + __expf(F.lbl[512 + i] - F.lbl[i]));
        if (i >= 1024 && i < 2048) ((bf16*)(F.ws + WS_H2))[(size_t)T * 1024 + (i - 1024)] = 0;
    }
    LAS float* scr = (LAS float*)(F.lds + F.wave * 16640);
    const int gw = (int)blockIdx.x * NWAVES + F.wave, NGW = F.G * NWAVES;
    constexpr int I_IN = 16 * 76, I_HG = 8 * 16, I_OUT = 16 * 16, I_UP = 16 * 32, I_DN = 16 * 16;
    constexpr int NITEMS = I_IN + 2 * I_HG + I_OUT + 32 * I_UP + 32 * I_DN;
    for (int it = gw; it < NITEMS; it += NGW) {
        int r = it;
        if (r < I_IN) { p0_item<0>(F.w_in, 1024, INW, (bf16*)(F.ws + WS_WIN), scr, r / 76, r % 76, F.lane); continue; } r -= I_IN;
        if (r < I_HG) { p0_item<0>(F.w_hg, 512, 1024, (bf16*)(F.ws + WS_WHG), scr, r / 16, r % 16, F.lane); continue; } r -= I_HG;
        if (r < I_HG) { p0_item<0>(F.w_att, 512, 1024, (bf16*)(F.ws + WS_WATT), scr, r / 16, r % 16, F.lane); continue; } r -= I_HG;
        if (r < I_OUT) { p0_item<0>(F.w_out, 1024, 1024, (bf16*)(F.ws + WS_WOUT), scr, r / 16, r % 16, F.lane); continue; } r -= I_OUT;
        if (r < 32 * I_UP) { const int e = r / I_UP, q = r % I_UP; p0_item<1>(F.w_up + (size_t)e * 1024 * 2048, 1024, 2048, (bf16*)(F.ws + WS_WUP) + (size_t)e * 2048 * 1024, scr, q / 32, q % 32, F.lane); continue; } r -= 32 * I_UP;
        { const int e = r / I_DN, q = r % I_DN; p0_item<0>(F.w_dn + (size_t)e * 1024 * 1024, 1024, 1024, (bf16*)(F.ws + WS_WDN) + (size_t)e * 1024 * 1024, scr, q / 16, q % 16, F.lane); }
    }
}
__device__ __forceinline__ void normmod_row(const float* xrow, const float* gain, const float* sh, const float* sc, bf16* orow, int lane) {
    const GAS f32x4* xr = (const GAS f32x4*)xrow + lane;
    f32x4 v[4]; float s = 0.f;
#pragma unroll
    for (int j = 0; j < 4; ++j) { v[j] = xr[64 * j]; s += (v[j].x * v[j].x + v[j].y * v[j].y) + (v[j].z * v[j].z + v[j].w * v[j].w); }
    const float rstd = rsqrtf(wave_sum(s) * (1.f / DM) + EPS);
#pragma unroll
    for (int j = 0; j < 4; ++j) {
        const int c = 4 * lane + 256 * j;
        const f32x4 g = *(const GAS f32x4*)(gain + c), a = *(const GAS f32x4*)(sc + c), b = *(const GAS f32x4*)(sh + c);
        const unsigned lo = pk2(v[j].x * rstd * g.x * (1.f + a.x) + b.x, v[j].y * rstd * g.y * (1.f + a.y) + b.y), hi = pk2(v[j].z * rstd * g.z * (1.f + a.z) + b.z, v[j].w * rstd * g.w * (1.f + a.w) + b.w);
        *(GAS unsigned long long*)(orow + c) = (unsigned long long)lo | ((unsigned long long)hi << 32);
    }
}
__device__ __forceinline__ void p1_xn(Frame& F) {
    const int gw = (int)blockIdx.x * NWAVES + F.wave, NGW = F.G * NWAVES; const float* MOD = (const float*)(F.ws + WS_MOD); bf16* XN = (bf16*)(F.ws + WS_XN);
    for (int m = gw; m < T; m += NGW) { const float* mb = MOD + (size_t)(m / SEQ) * 6144; normmod_row(F.x + (size_t)m * DM, F.n1g, mb, mb + 1024, XN + (size_t)m * DM, F.lane); }
}

__device__ __forceinline__ float bflo(unsigned u) { return __uint_as_float(u << 16); }
__device__ __forceinline__ float bfhi(unsigned u) { return __uint_as_float(u & 0xffff0000u); }
struct EpiIn {
    static constexpr bool PERM = true; unsigned char* ws;
    __device__ __forceinline__ void operator()(const f32x4 (&acc)[2][2][4][2], const pg8::Unit& u, int wr, int wc, int fr, int fq) const {
        const int pn = u.pn, row0 = u.pm * 256 + wr * 64 + fr, cl = wc * 32 + 8 * fq;
        if (pn == 2 || pn == 3) {
            float* LF = (float*)(ws + WS_LF); const float* LB = (const float*)(ws + WS_LB); const int cb = (pn - 2) * 256;
#pragma unroll
            for (int bj = 0; bj < 2; ++bj) { const int col = cb + 128 * bj + cl; const f32x4 l0 = *(const f32x4*)(LB + col), l1 = *(const f32x4*)(LB + col + 4);
#pragma unroll
                for (int ai = 0; ai < 2; ++ai)
#pragma unroll
                    for (int m = 0; m < 4; ++m) { float* rp = LF + (size_t)(row0 + 128 * ai + 16 * m) * 512 + col; const f32x4 v0 = acc[ai][bj][m][0], v1 = acc[ai][bj][m][1]; f32x4 o0, o1;
#pragma unroll
                        for (int j = 0; j < 4; ++j) { o0[j] = __logf(l0[j] + (1.f - l0[j]) * fsigm(v0[j])); o1[j] = __logf(l1[j] + (1.f - l1[j]) * fsigm(v1[j])); }
                        *(f32x4*)rp = o0; *(f32x4*)(rp + 4) = o1; } }
            return;
        }
        bf16* dst; int ld = 512, cb, act = 0;
        if (pn < 2) { dst = (bf16*)(ws + WS_QH); cb = pn * 256; act = 1; }
        else if (pn < 6) { dst = (bf16*)(ws + WS_VH); cb = (pn - 4) * 256; }
        else if (pn < 8) { dst = (bf16*)(ws + WS_GH); cb = (pn - 6) * 256; act = 1; }
        else if (pn < 10) { dst = (bf16*)(ws + WS_AQ); cb = (pn - 8) * 256; }
        else if (pn == 10) { dst = (bf16*)(ws + WS_AKV); cb = 0; ld = 256; }
        else if (pn < 15) { dst = (bf16*)(ws + WS_SGH); cb = (pn - 11) * 256; ld = 1024; act = 2; }
        else { dst = (bf16*)(ws + WS_SGA); cb = (pn - 15) * 256; ld = 1024; act = 2; }
#pragma unroll
        for (int ai = 0; ai < 2; ++ai)
#pragma unroll
            for (int m = 0; m < 4; ++m) { bf16* rp = dst + (size_t)(row0 + 128 * ai + 16 * m) * ld + cb + cl;
#pragma unroll
                for (int bj = 0; bj < 2; ++bj) { f32x4 v0 = acc[ai][bj][m][0], v1 = acc[ai][bj][m][1];
                    if (act == 1) {
#pragma unroll
                        for (int j = 0; j < 4; ++j) { v0[j] *= fsigm(v0[j]); v1[j] *= fsigm(v1[j]); } }
                    else if (act == 2) {
#pragma unroll
                        for (int j = 0; j < 4; ++j) { v0[j] = fsigm(v0[j]); v1[j] = fsigm(v1[j]); } }
                    v4u w; w.x = pg8::cvt_pk_bf16(v0[0], v0[1]); w.y = pg8::cvt_pk_bf16(v0[2], v0[3]); w.z = pg8::cvt_pk_bf16(v1[0], v1[1]); w.w = pg8::cvt_pk_bf16(v1[2], v1[3]);
                    *(v4u*)(rp + 128 * bj) = w; } }
    }
};
template <bool SECOND> struct EpiMrg {
    static constexpr bool PERM = true; bf16* MRG; const bf16* SG;
    __device__ __forceinline__ void operator()(const f32x4 (&acc)[2][2][4][2], const pg8::Unit& u, int wr, int wc, int fr, int fq) const {
        const int row0 = u.pm * 256 + wr * 64 + fr, col0 = u.pn * 256 + wc * 32 + 8 * fq;
#pragma unroll
        for (int ai = 0; ai < 2; ++ai)
#pragma unroll
            for (int m = 0; m < 4; ++m) { const size_t off = (size_t)(row0 + 128 * ai + 16 * m) * 1024 + col0;
#pragma unroll
                for (int bj = 0; bj < 2; ++bj) { const v4u s = *(const v4u*)(SG + off + 128 * bj); const f32x4 v0 = acc[ai][bj][m][0], v1 = acc[ai][bj][m][1];
                    float o[8] = {bflo(s.x) * v0[0], bfhi(s.x) * v0[1], bflo(s.y) * v0[2], bfhi(s.y) * v0[3], bflo(s.z) * v1[0], bfhi(s.z) * v1[1], bflo(s.w) * v1[2], bfhi(s.w) * v1[3]};
                    if (SECOND) { const v4u p = *(const v4u*)(MRG + off + 128 * bj); o[0] += bflo(p.x); o[1] += bfhi(p.x); o[2] += bflo(p.y); o[3] += bfhi(p.y); o[4] += bflo(p.z); o[5] += bfhi(p.z); o[6] += bflo(p.w); o[7] += bfhi(p.w); }
                    v4u w; w.x = pg8::cvt_pk_bf16(o[0], o[1]); w.y = pg8::cvt_pk_bf16(o[2], o[3]); w.z = pg8::cvt_pk_bf16(o[4], o[5]); w.w = pg8::cvt_pk_bf16(o[6], o[7]);
                    *(v4u*)(MRG + off + 128 * bj) = w; } }
    }
};
struct EpiOut {
    static constexpr bool PERM = false; const float* x; const float* MOD; float* out;
    __device__ __forceinline__ void operator()(const f32x4 (&acc)[2][2][4][2], const pg8::Unit& u, int wr, int wc, int fr, int fq) const {
        const int row0 = u.pm * 256 + wr * 64 + fr, col0 = u.pn * 256 + wc * 32 + 4 * fq; const float* g1 = MOD + (size_t)(u.pm >> 3) * 6144 + 2048;
        f32x4 gv[2][2];
#pragma unroll
        for (int bj = 0; bj < 2; ++bj)
#pragma unroll
            for (int n = 0; n < 2; ++n) gv[bj][n] = *(const f32x4*)(g1 + col0 + 128 * bj + 16 * n);
#pragma unroll
        for (int ai = 0; ai < 2; ++ai)
#pragma unroll
            for (int m = 0; m < 4; ++m) { const size_t off = (size_t)(row0 + 128 * ai + 16 * m) * 1024 + col0;
#pragma unroll
                for (int bj = 0; bj < 2; ++bj)
#pragma unroll
                    for (int n = 0; n < 2; ++n) *(f32x4*)(out + off + 128 * bj + 16 * n) = *(const f32x4*)(x + off + 128 * bj + 16 * n) + gv[bj][n] * acc[ai][bj][m][n]; }
    }
};

typedef float f32x16 __attribute__((ext_vector_type(16)));
constexpr int RT_PITCH = 2064;
constexpr int R_TILE = 0, R_PART = 66048, R_LOG = 99840, R_REC = 104064, R_HIST = 112256;
__device__ __forceinline__ void p6_route(Frame& F) {
    const float* MOD = (const float*)(F.ws + WS_MOD); bf16* H2 = (bf16*)(F.ws + WS_H2);
    int* TOKL = (int*)(F.ws + WS_TOKL); float* GATL = (float*)(F.ws + WS_GATL); int* TOPI = (int*)(F.ws + WS_TOPI); float* TOPW = (float*)(F.ws + WS_TOPW);
    LAS float* PART = (LAS float*)(F.lds + R_PART); LAS float* LOG = (LAS float*)(F.lds + R_LOG);
    LAS int* REC_E = (LAS int*)(F.lds + R_REC); LAS int* REC_TK = REC_E + 512; LAS float* REC_G = (LAS float*)(REC_E + 1024); LAS int* REC_RK = REC_E + 1536;
    LAS int* HIST = (LAS int*)(F.lds + R_HIST); LAS int* BASE = HIST + 32;
    const int lane = F.lane, wave = F.wave, r32 = lane & 31, hi = lane >> 5;
    bf16x8 wB[8];
#pragma unroll
    for (int s = 0; s < 8; ++s) { const int k0 = 128 * wave + 16 * s + 8 * hi; unsigned p[4];
#pragma unroll
        for (int j = 0; j < 4; ++j) p[j] = pk2(F.w_r[(size_t)(k0 + 2 * j) * 32 + r32], F.w_r[(size_t)(k0 + 2 * j + 1) * 32 + r32]);
        v4u q = {p[0], p[1], p[2], p[3]}; wB[s] = __builtin_bit_cast(bf16x8, q); }
    if (F.tid < 32) HIST[F.tid] = 0;
    __syncthreads();
    for (int tb = (int)blockIdx.x * 4; tb < T / 32; tb += F.G * 4) {
        const int ntile = (T / 32 - tb) < 4 ? (T / 32 - tb) : 4;
        for (int tl = 0; tl < ntile; ++tl) {
            const int t0 = (tb + tl) * 32;
#pragma unroll 1
            for (int rr = 0; rr < 4; ++rr) {
                const int row = t0 + 4 * wave + rr; const float* mb = MOD + (size_t)(row / SEQ) * 6144;
                const GAS f32x4* xr = (const GAS f32x4*)(F.out + (size_t)row * DM) + lane;
                f32x4 v[4]; float s = 0.f;
#pragma unroll
                for (int j = 0; j < 4; ++j) { v[j] = xr[64 * j]; s += (v[j].x * v[j].x + v[j].y * v[j].y) + (v[j].z * v[j].z + v[j].w * v[j].w); }
                const float rstd = rsqrtf(wave_sum(s) * (1.f / DM) + EPS);
#pragma unroll
                for (int j = 0; j < 4; ++j) {
                    const int c = 4 * lane + 256 * j;
                    const f32x4 g = *(const GAS f32x4*)(F.n2g + c), a = *(const GAS f32x4*)(mb + 4096 + c), b = *(const GAS f32x4*)(mb + 3072 + c);
                    const unsigned lo = pk2(v[j].x * rstd * g.x * (1.f + a.x) + b.x, v[j].y * rstd * g.y * (1.f + a.y) + b.y), hh = pk2(v[j].z * rstd * g.z * (1.f + a.z) + b.z, v[j].w * rstd * g.w * (1.f + a.w) + b.w);
                    const unsigned long long pk = (unsigned long long)lo | ((unsigned long long)hh << 32);
                    *(GAS unsigned long long*)(H2 + (size_t)row * DM + c) = pk;
                    *(LAS unsigned long long*)(F.lds + R_TILE + (4 * wave + rr) * RT_PITCH + c * 2) = pk;
                }
            }
            __syncthreads();
            f32x16 acc = {};
#pragma unroll
            for (int s = 0; s < 8; ++s) { const bf16x8 af = *(const LAS bf16x8*)(F.lds + R_TILE + r32 * RT_PITCH + (128 * wave + 16 * s + 8 * hi) * 2);
                acc = __builtin_amdgcn_mfma_f32_32x32x16_bf16(af, wB[s], acc, 0, 0, 0); }
#pragma unroll
            for (int r = 0; r < 16; ++r) { const int tok = (r & 3) + 8 * (r >> 2) + 4 * hi; PART[(wave * 32 + tok) * 33 + r32] = acc[r]; }
            __syncthreads();
#pragma unroll
            for (int q = 0; q < 2; ++q) { const int idx = F.tid + 512 * q, tok = idx >> 5, e = idx & 31; float s = F.b_r[e];
#pragma unroll
                for (int w = 0; w < 8; ++w) s += PART[(w * 32 + tok) * 33 + e];
                LOG[tok * 33 + e] = s; }
            __syncthreads();
            if (F.tid < 32) {
                float lg[32];
#pragma unroll
                for (int e = 0; e < 32; ++e) lg[e] = LOG[F.tid * 33 + e];
                unsigned used = 0u; float tv[4]; int ti[4];
#pragma unroll
                for (int k = 0; k < 4; ++k) { float best = -INFINITY; int bi = 0;
#pragma unroll
                    for (int e = 0; e < 32; ++e) { const bool ok = !((used >> e) & 1u) && lg[e] > best; best = ok ? lg[e] : best; bi = ok ? e : bi; }
                    used |= 1u << bi; tv[k] = best; ti[k] = bi; }
                const float e1 = __expf(tv[1] - tv[0]), e2 = __expf(tv[2] - tv[0]), e3 = __expf(tv[3] - tv[0]), inv = 1.f / (1.f + e1 + e2 + e3);
                const float gw[4] = {inv, e1 * inv, e2 * inv, e3 * inv};
                const int t = t0 + F.tid;
#pragma unroll
                for (int k = 0; k < 4; ++k) { const int slot = tl * 128 + F.tid * 4 + k; REC_E[slot] = ti[k]; REC_TK[slot] = t * 4 + k; REC_G[slot] = gw[k];
                    REC_RK[slot] = __hip_atomic_fetch_add(&HIST[ti[k]], 1, __ATOMIC_RELAXED, __HIP_MEMORY_SCOPE_WORKGROUP);
                    TOPI[t * 4 + k] = ti[k]; TOPW[t * 4 + k] = gw[k]; }
            }
        }
        __syncthreads();
        if (F.tid < 32) BASE[F.tid] = (int)__hip_atomic_fetch_add(F.ctl + CW_CNT + F.tid, (unsigned)HIST[F.tid], RLX_AGENT);
        __syncthreads();
        for (int slot = F.tid; slot < ntile * 128; slot += 512) { const int e = REC_E[slot], p = BASE[e] + REC_RK[slot]; TOKL[(size_t)e * T + p] = REC_TK[slot]; GATL[(size_t)e * T + p] = REC_G[slot]; }
        __syncthreads();
        if (F.tid < 32) HIST[F.tid] = 0;
        __syncthreads();
    }
}

__device__ __forceinline__ void moe_tables(Frame& F) {
    if (F.tid < 32) F.MISC[64 + F.tid] = __hip_atomic_load(F.ctl + CW_CNT + F.tid, RLX_AGENT);
    __syncthreads();
    if (F.tid == 0) { unsigned s = 0; for (int e = 0; e < 32; ++e) { F.MISC[16 + e] = s; s += (F.MISC[64 + e] + 255u) >> 8; } F.MISC[48] = s; }
    __syncthreads();
}
template <int NC> struct MoeOrder {
    volatile LAS unsigned* MISC; int G, c;
    __device__ __forceinline__ bool next(int i, pg8::Unit& u) const {
        const int total = (int)MISC[48]; int rt, pl;
        if ((G & 7) == 0 && ((G >> 3) % NC) == 0) { const int rpr = G / NC, perx = rpr >> 3, xcd = c & 7, s = c >> 3; rt = i * rpr + xcd * perx + s / NC; pl = s % NC; }
        else { const int L = i * G + c; rt = L / NC; pl = L % NC; }
        if (rt >= total) return false;
        int e = 0;
        for (int q = 1; q < 32; ++q) e += ((int)MISC[16 + q] <= rt) ? 1 : 0;
        const int j = rt - (int)MISC[16 + e];
        u.pm = rt; u.pn = e * NC + pl; u.arow0 = e * T + 256 * j; u.nvalid = (int)MISC[64 + e] - 256 * j; return true;
    }
};
struct EpiUp {
    static constexpr bool PERM = true; bf16* ACT; const float* BUPP;
    __device__ __forceinline__ void operator()(const f32x4 (&acc)[2][2][4][2], const pg8::Unit& u, int wr, int wc, int fr, int fq) const {
        const int e = u.pn >> 3, pl = u.pn & 7, row0 = u.pm * 256 + wr * 64 + fr, cl = wc * 32 + 8 * fq;
        const float* bp = BUPP + e * 2048 + 256 * pl + cl;
        const f32x4 bg0 = *(const f32x4*)bp, bg1 = *(const f32x4*)(bp + 4), bl0 = *(const f32x4*)(bp + 128), bl1 = *(const f32x4*)(bp + 132);
#pragma unroll
        for (int ai = 0; ai < 2; ++ai)
#pragma unroll
            for (int m = 0; m < 4; ++m) { bf16* rp = ACT + (size_t)(row0 + 128 * ai + 16 * m) * 1024 + 128 * pl + cl;
                const f32x4 g0 = acc[ai][0][m][0] + bg0, g1 = acc[ai][0][m][1] + bg1, l0 = acc[ai][1][m][0] + bl0, l1 = acc[ai][1][m][1] + bl1; float o[8];
#pragma unroll
                for (int j = 0; j < 4; ++j) { const float ga = fminf(g0[j], 7.f), la = fminf(fmaxf(l0[j], -7.f), 7.f), gb = fminf(g1[j], 7.f), lb = fminf(fmaxf(l1[j], -7.f), 7.f);
                    o[j] = ga * fsigm(1.702f * ga) * (la + 1.f); o[4 + j] = gb * fsigm(1.702f * gb) * (lb + 1.f); }
                v4u w; w.x = pg8::cvt_pk_bf16(o[0], o[1]); w.y = pg8::cvt_pk_bf16(o[2], o[3]); w.z = pg8::cvt_pk_bf16(o[4], o[5]); w.w = pg8::cvt_pk_bf16(o[6], o[7]);
                *(v4u*)rp = w; }
    }
};
struct EpiDn {
    static constexpr bool PERM = true; bf16* Y; const float* b_dn; const int* TOKL; const float* GATL;
    __device__ __forceinline__ void operator()(const f32x4 (&acc)[2][2][4][2], const pg8::Unit& u, int wr, int wc, int fr, int fq) const {
        const int e = u.pn >> 2, pl = u.pn & 3, cl = wc * 32 + 8 * fq; const float* bp = b_dn + e * 1024 + 256 * pl + cl;
        f32x4 bv[2][2];
#pragma unroll
        for (int bj = 0; bj < 2; ++bj) { bv[bj][0] = *(const f32x4*)(bp + 128 * bj); bv[bj][1] = *(const f32x4*)(bp + 128 * bj + 4); }
#pragma unroll
        for (int ai = 0; ai < 2; ++ai)
#pragma unroll
            for (int m = 0; m < 4; ++m) { const int r = 128 * ai + 64 * wr + 16 * m + fr;
                if (r < u.nvalid) { const int slot = TOKL[u.arow0 + r]; const float gt = GATL[u.arow0 + r]; bf16* rp = Y + (size_t)slot * 1024 + 256 * pl + cl;
#pragma unroll
                    for (int bj = 0; bj < 2; ++bj) { const f32x4 v0 = (acc[ai][bj][m][0] + bv[bj][0]) * gt, v1 = (acc[ai][bj][m][1] + bv[bj][1]) * gt;
                        v4u w; w.x = pg8::cvt_pk_bf16(v0[0], v0[1]); w.y = pg8::cvt_pk_bf16(v0[2], v0[3]); w.z = pg8::cvt_pk_bf16(v1[0], v1[1]); w.w = pg8::cvt_pk_bf16(v1[2], v1[3]);
                        *(v4u*)(rp + 128 * bj) = w; } } }
    }
};
__device__ __forceinline__ void p9_final(Frame& F) {
    const int gw = (int)blockIdx.x * NWAVES + F.wave, NGW = F.G * NWAVES; const float* MOD = (const float*)(F.ws + WS_MOD); const bf16* Y = (const bf16*)(F.ws + WS_Y);
    for (int row = gw; row < T; row += NGW) {
        const float* g2 = MOD + (size_t)(row / SEQ) * 6144 + 5120;
#pragma unroll
        for (int j = 0; j < 4; ++j) {
            const int c = 4 * F.lane + 256 * j;
            f32x4 xv = *(const GAS f32x4*)(F.out + (size_t)row * DM + c); const f32x4 g = *(const GAS f32x4*)(g2 + c);
            float s0 = 0.f, s1 = 0.f, s2 = 0.f, s3 = 0.f;
#pragma unroll
            for (int k = 0; k < 4; ++k) { const unsigned long long y = *(const GAS unsigned long long*)(Y + ((size_t)row * 4 + k) * DM + c); const unsigned ylo = (unsigned)y, yhi = (unsigned)(y >> 32);
                s0 += bflo(ylo); s1 += bfhi(ylo); s2 += bflo(yhi); s3 += bfhi(yhi); }
            xv.x += g.x * s0; xv.y += g.y * s1; xv.z += g.z * s2; xv.w += g.w * s3;
            *(GAS f32x4*)(F.out + (size_t)row * DM + c) = xv;
        }
    }
}

typedef short v4i16_t __attribute__((ext_vector_type(4)));
namespace att {
constexpr int L_K = 0, L_V = 32768, L_OST = 65536, L_WSF = 98304;
constexpr float SC2 = 0.125f * 1.4426950408889634f;
__device__ __forceinline__ int crow(int r, int hi) { return (r & 3) + 8 * (r >> 2) + 4 * hi; }
__device__ __forceinline__ bf16x8 vtr2(LAS const unsigned char* p) {
    const v4i16_t lo = __builtin_amdgcn_ds_read_tr16_b64_v4i16((LAS v4i16_t*)p), hi = __builtin_amdgcn_ds_read_tr16_b64_v4i16((LAS v4i16_t*)(p + 512));
    return (bf16x8){lo[0], lo[1], lo[2], lo[3], hi[0], hi[1], hi[2], hi[3]};
}
__device__ __forceinline__ void unit(Frame& F, int b, int kvh, int qb) {
    const bf16* AQ = (const bf16*)(F.ws + WS_AQ); const bf16* AKV = (const bf16*)(F.ws + WS_AKV); bf16* HOAO = (bf16*)(F.ws + WS_HOAO);
    const int tid = F.tid, lane = F.lane, wave = F.wave, r32 = lane & 31, hi = lane >> 5;
    const int tq0 = b * SEQ + qb * 128, tk0 = tq0 - 128;
    {
        const int key = tid >> 1, half = tid & 1; const bool valid = (qb > 0) || (key >= 128); const int token = valid ? tk0 + key : tq0;
        const bf16* kp = AKV + (size_t)token * 256 + kvh * 64 + half * 32;
        v4u kr[4], vr[4];
#pragma unroll
        for (int q = 0; q < 4; ++q) { kr[q] = *(const GAS v4u*)(kp + 8 * q); vr[q] = *(const GAS v4u*)(kp + 128 + 8 * q); }
        float x[32]; float ss = 0.f;
#pragma unroll
        for (int q = 0; q < 4; ++q) { x[8 * q + 0] = bflo(kr[q].x); x[8 * q + 1] = bfhi(kr[q].x); x[8 * q + 2] = bflo(kr[q].y); x[8 * q + 3] = bfhi(kr[q].y);
            x[8 * q + 4] = bflo(kr[q].z); x[8 * q + 5] = bfhi(kr[q].z); x[8 * q + 6] = bflo(kr[q].w); x[8 * q + 7] = bfhi(kr[q].w); }
#pragma unroll
        for (int d = 0; d < 32; ++d) ss += x[d] * x[d];
        ss += __shfl_xor(ss, 1);
        const float rstd = valid ? rsqrtf(ss * (1.f / 64.f) + EPS) : 0.f;
#pragma unroll
        for (int q = 0; q < 8; ++q) { const f32x4 g = *(const GAS f32x4*)(F.kg + half * 32 + 4 * q); x[4 * q] *= rstd * g.x; x[4 * q + 1] *= rstd * g.y; x[4 * q + 2] *= rstd * g.z; x[4 * q + 3] *= rstd * g.w; }
        if (half == 0) { const int p = F.pos[token];
#pragma unroll
            for (int i = 0; i < 8; ++i) { float cs, sn; rope_cs(p, i, cs, sn); const float x1 = x[i], x2 = x[i + 8]; x[i] = x1 * cs - x2 * sn; x[i + 8] = x2 * cs + x1 * sn; } }
#pragma unroll
        for (int q = 0; q < 4; ++q) { v4u w; w.x = pk2(x[8 * q], x[8 * q + 1]); w.y = pk2(x[8 * q + 2], x[8 * q + 3]); w.z = pk2(x[8 * q + 4], x[8 * q + 5]); w.w = pk2(x[8 * q + 6], x[8 * q + 7]);
            *(LAS v4u*)(F.lds + L_K + (half * 4 + q) * 4096 + key * 16) = w; }
        const int kk = key & 63; LAS unsigned char* vd = F.lds + L_V + (key >> 6) * 8192 + half * 4096 + (kk >> 4) * 1024 + (kk & 15) * 64;
#pragma unroll
        for (int q = 0; q < 4; ++q) { v4u w = vr[q]; if (!valid) w = (v4u){0u, 0u, 0u, 0u}; *(LAS v4u*)(vd + 16 * q) = w; }
    }
    __syncthreads();
    LAS float* wsf = (LAS float*)(F.lds + L_WSF) + wave * 64;
    LAS bf16* stg = (LAS bf16*)(F.lds + L_OST + wave * 4096);
    LAS const unsigned char* vbase = F.lds + L_V + ((lane >> 4) & 1) * 32 + (lane & 3) * 8 + (4 * hi + ((lane & 15) >> 2)) * 64;
#pragma unroll 1
    for (int sbi = 0; sbi < 2; ++sbi) {
        const int sb = wave * 2 + sbi, g = sb >> 2, r0 = (sb & 3) * 32, hq = kvh * 4 + g, tq = tq0 + r0 + r32;
        bf16x8 qr[4];
        {
            const bf16* qp = AQ + (size_t)tq * 512 + hq * 64 + 8 * hi; float x[4][8]; float ss = 0.f;
#pragma unroll
            for (int d0 = 0; d0 < 4; ++d0) { const v4u r = *(const GAS v4u*)(qp + 16 * d0); x[d0][0] = bflo(r.x); x[d0][1] = bfhi(r.x); x[d0][2] = bflo(r.y); x[d0][3] = bfhi(r.y); x[d0][4] = bflo(r.z); x[d0][5] = bfhi(r.z); x[d0][6] = bflo(r.w); x[d0][7] = bfhi(r.w); }
#pragma unroll
            for (int d0 = 0; d0 < 4; ++d0)
#pragma unroll
                for (int j = 0; j < 8; ++j) ss += x[d0][j] * x[d0][j];
            ss += __shfl_xor(ss, 32);
            const float rs = rsqrtf(ss * (1.f / 64.f) + EPS) * SC2;
#pragma unroll
            for (int d0 = 0; d0 < 4; ++d0) { const f32x4 g0 = *(const GAS f32x4*)(F.qg + 16 * d0 + 8 * hi), g1 = *(const GAS f32x4*)(F.qg + 16 * d0 + 8 * hi + 4);
                x[d0][0] *= rs * g0.x; x[d0][1] *= rs * g0.y; x[d0][2] *= rs * g0.z; x[d0][3] *= rs * g0.w; x[d0][4] *= rs * g1.x; x[d0][5] *= rs * g1.y; x[d0][6] *= rs * g1.z; x[d0][7] *= rs * g1.w; }
            const int p = F.pos[tq];
#pragma unroll
            for (int j = 0; j < 8; ++j) { float cs, sn; rope_cs(p, j, cs, sn); const float mine = x[0][j], oth = __shfl_xor(mine, 32); x[0][j] = mine * cs + (hi ? oth : -oth) * sn; }
#pragma unroll
            for (int d0 = 0; d0 < 4; ++d0) { v4u w; w.x = pk2(x[d0][0], x[d0][1]); w.y = pk2(x[d0][2], x[d0][3]); w.z = pk2(x[d0][4], x[d0][5]); w.w = pk2(x[d0][6], x[d0][7]); qr[d0] = __builtin_bit_cast(bf16x8, w); }
        }
        const int kt0 = r0 >> 5, qi = r0 + r32;
        f32x16 p[5];
#pragma unroll
        for (int t = 0; t < 5; ++t) {
            f32x16 a = {};
#pragma unroll
            for (int d0 = 0; d0 < 4; ++d0) { const bf16x8 kf = *(const LAS bf16x8*)(F.lds + L_K + (2 * d0 + hi) * 4096 + (32 * (kt0 + t) + r32) * 16); a = __builtin_amdgcn_mfma_f32_32x32x16_bf16(kf, qr[d0], a, 0, 0, 0); }
#pragma unroll
            for (int r = 0; r < 16; ++r) { const int kk = 32 * (kt0 + t) + crow(r, hi); const bool ok = (kk > qi) && (kk <= qi + 128) && (qb > 0 || kk >= 128); a[r] = ok ? a[r] : -INFINITY; }
            p[t] = a;
        }
        const float sink2 = F.sinks[hq] * 1.4426950408889634f;
        float m = sink2;
#pragma unroll
        for (int t = 0; t < 5; ++t)
#pragma unroll
            for (int r = 0; r < 16; ++r) m = fmaxf(m, p[t][r]);
        m = fmaxf(m, __shfl_xor(m, 32));
        float l = 0.f;
#pragma unroll
        for (int t = 0; t < 5; ++t)
#pragma unroll
            for (int r = 0; r < 16; ++r) { const float e = __builtin_amdgcn_exp2f(p[t][r] - m); p[t][r] = e; l += e; }
        l += __shfl_xor(l, 32);
        l += __builtin_amdgcn_exp2f(sink2 - m);
        f32x16 o[2]; o[0] = (f32x16){}; o[1] = (f32x16){};
#pragma unroll
        for (int t = 0; t < 5; ++t) {
            const int kt = kt0 + t; LAS const unsigned char* vs = vbase + (kt >> 1) * 8192 + (2 * (kt & 1)) * 1024;
#pragma unroll
            for (int s = 0; s < 2; ++s) {
                v4u w; w.x = pk2(p[t][8 * s], p[t][8 * s + 1]); w.y = pk2(p[t][8 * s + 2], p[t][8 * s + 3]); w.z = pk2(p[t][8 * s + 4], p[t][8 * s + 5]); w.w = pk2(p[t][8 * s + 6], p[t][8 * s + 7]);
                const bf16x8 pa = __builtin_bit_cast(bf16x8, w);
#pragma unroll
                for (int d0 = 0; d0 < 2; ++d0) { const bf16x8 vf = vtr2(vs + d0 * 4096 + s * 1024); o[d0] = __builtin_amdgcn_mfma_f32_32x32x16_bf16(pa, vf, o[d0], 0, 0, 0); }
            }
        }
        if (hi == 0) wsf[r32] = l;
        LDS_WAIT(); asm volatile("" ::: "memory");
#pragma unroll
        for (int r = 0; r < 16; ++r) { const int orow = crow(r, hi); const float rl = __builtin_amdgcn_rcpf(wsf[orow]);
#pragma unroll
            for (int d0 = 0; d0 < 2; ++d0) stg[orow * 64 + d0 * 32 + r32] = f2bf(o[d0][r] * rl); }
        LDS_WAIT(); asm volatile("" ::: "memory");
#pragma unroll
        for (int i = 0; i < 4; ++i) { const int row = i * 8 + (lane >> 3), ch = lane & 7; const v4u v = *(const LAS v4u*)(stg + row * 64 + ch * 8);
            *(GAS v4u*)(HOAO + (size_t)(tq0 + r0 + row) * 1024 + 512 + hq * 64 + ch * 8) = v; }
        LDS_WAIT(); asm volatile("" ::: "memory");
    }
    __syncthreads();
}
}

namespace hg {
typedef float f32x2v __attribute__((ext_vector_type(2)));
constexpr int PK = 272, PJ = 144;
constexpr int L_QE = 0, L_KE = 17408, L_KDT = 34816, L_VT = 53248, L_P = 71680, L_ST = 80896, L_OST = 115712, L_SEGP = 149504, L_DK = 153600;
constexpr int OP = 132;
__device__ __forceinline__ void run(Frame& F, int b, int h) {
    const bf16* QH = (const bf16*)(F.ws + WS_QH); const float* LF = (const float*)(F.ws + WS_LF); const bf16* VH = (const bf16*)(F.ws + WS_VH); const bf16* GH = (const bf16*)(F.ws + WS_GH);
    bf16* HOAO = (bf16*)(F.ws + WS_HOAO);
    const int tid = F.tid, lane = F.lane, wave = F.wave, r32 = lane & 31, hi = lane >> 5;
    LAS unsigned char* L = F.lds;
    LAS float* SEGP = (LAS float*)(L + L_SEGP); LAS float* DK = (LAS float*)(L + L_DK); LAS float* OST = (LAS float*)(L + L_OST);
    for (int i = tid; i < (L_OST - L_P) / 16; i += 512) *(LAS v4u*)(L + L_P + i * 16) = (v4u){0u, 0u, 0u, 0u};
    f32x16 st[2]; st[0] = (f32x16){}; st[1] = (f32x16){};
    const int kp2 = 2 * lane;
    const size_t rowb = (size_t)b * SEQ;
    float fv[8][2]; unsigned qv[8], vv[8];
    const int oi = tid >> 3, os = tid & 7;
    float gn[16];
#pragma unroll
    for (int q = 0; q < 4; ++q) { const f32x4 g = *(const GAS f32x4*)(F.hgg + 16 * os + 4 * q); gn[4 * q] = g.x; gn[4 * q + 1] = g.y; gn[4 * q + 2] = g.z; gn[4 * q + 3] = g.w; }
#define HG_LOAD(c) do { _Pragma("unroll") for (int jj = 0; jj < 8; ++jj) { const size_t row = rowb + (size_t)(c) * 64 + 8 * wave + jj; \
        const f32x2v lf = *(const GAS f32x2v*)(LF + row * 512 + h * 128 + kp2); fv[jj][0] = lf.x; fv[jj][1] = lf.y; \
        qv[jj] = *(const GAS unsigned*)(QH + row * 512 + h * 128 + kp2); vv[jj] = *(const GAS unsigned*)(VH + row * 512 + h * 128 + kp2); } } while (0)
#define HG_A1() do { float p0 = 1.f, p1 = 1.f; _Pragma("unroll") for (int jj = 0; jj < 8; ++jj) { fv[jj][0] = __expf(fv[jj][0]); fv[jj][1] = __expf(fv[jj][1]); p0 *= fv[jj][0]; p1 *= fv[jj][1]; } \
        *(LAS f32x2v*)(SEGP + wave * 128 + kp2) = (f32x2v){p0, p1}; } while (0)
    HG_LOAD(0); HG_A1();
    __syncthreads();
#pragma unroll 1
    for (int c = 0; c < SEQ / 64; ++c) {
        {
            float pre0 = 1.f, pre1 = 1.f, all0 = 1.f, all1 = 1.f;
#pragma unroll
            for (int s = 0; s < 8; ++s) { const f32x2v sp = *(const LAS f32x2v*)(SEGP + s * 128 + kp2); all0 *= sp.x; all1 *= sp.y; if (s < wave) { pre0 *= sp.x; pre1 *= sp.y; } }
            if (wave == 0) *(LAS f32x2v*)(DK + kp2) = (f32x2v){all0, all1};
            float e0 = pre0, e1 = pre1; unsigned kd0[4], kd1[4], vt0[4], vt1[4]; float kdp0 = 0.f, kdp1 = 0.f;
#pragma unroll
            for (int jj = 0; jj < 8; ++jj) {
                e0 *= fv[jj][0]; e1 *= fv[jj][1];
                const float k0 = 1.f - fv[jj][0], k1 = 1.f - fv[jj][1];
                const float ke0 = k0 * __builtin_amdgcn_rcpf(e0), ke1 = k1 * __builtin_amdgcn_rcpf(e1);
                const int j = 8 * wave + jj;
                *(LAS unsigned*)(L + L_QE + j * PK + kp2 * 2) = pk2(bflo(qv[jj]) * e0, bfhi(qv[jj]) * e1);
                *(LAS unsigned*)(L + L_KE + j * PK + kp2 * 2) = pk2(ke0, ke1);
                const float d0 = ke0 * all0, d1 = ke1 * all1;
                if (jj & 1) { kd0[jj >> 1] = pk2(kdp0, d0); kd1[jj >> 1] = pk2(kdp1, d1); vt0[jj >> 1] = (vv[jj - 1] & 0xffffu) | (vv[jj] << 16); vt1[jj >> 1] = (vv[jj - 1] >> 16) | (vv[jj] & 0xffff0000u); }
                else { kdp0 = d0; kdp1 = d1; }
            }
            *(LAS v4u*)(L + L_KDT + kp2 * PJ + 16 * wave) = (v4u){kd0[0], kd0[1], kd0[2], kd0[3]};
            *(LAS v4u*)(L + L_KDT + (kp2 + 1) * PJ + 16 * wave) = (v4u){kd1[0], kd1[1], kd1[2], kd1[3]};
            *(LAS v4u*)(L + L_VT + kp2 * PJ + 16 * wave) = (v4u){vt0[0], vt0[1], vt0[2], vt0[3]};
            *(LAS v4u*)(L + L_VT + (kp2 + 1) * PJ + 16 * wave) = (v4u){vt1[0], vt1[1], vt1[2], vt1[3]};
        }
        if (c + 1 < SEQ / 64) HG_LOAD(c + 1);
        const size_t orow = rowb + (size_t)c * 64 + oi;
        const v4u gg0 = *(const GAS v4u*)(GH + orow * 512 + h * 128 + 16 * os), gg1 = *(const GAS v4u*)(GH + orow * 512 + h * 128 + 16 * os + 8);
        __syncthreads();
        for (int tl = wave; tl < 10; tl += 8) {
            int ib = 0, rem = tl; while (rem > ib) { rem -= ib + 1; ++ib; } const int jb = rem;
            typedef float f32x4v __attribute__((ext_vector_type(4)));
            f32x4v a = {0.f, 0.f, 0.f, 0.f}; const int l15 = lane & 15, l4 = lane >> 4;
#pragma unroll
            for (int s = 0; s < 4; ++s) { const bf16x8 af = *(const LAS bf16x8*)(L + L_QE + (16 * ib + l15) * PK + (32 * s + 8 * l4) * 2), bfr = *(const LAS bf16x8*)(L + L_KE + (16 * jb + l15) * PK + (32 * s + 8 * l4) * 2);
                a = __builtin_amdgcn_mfma_f32_16x16x32_bf16(af, bfr, a, 0, 0, 0); }
#pragma unroll
            for (int r = 0; r < 4; ++r) { const int i = 16 * ib + 4 * l4 + r, j = 16 * jb + l15; const float v = (j <= i) ? a[r] : 0.f; *(LAS bf16*)(L + L_P + i * PJ + j * 2) = f2bf(v); }
        }
        const int ib = wave >> 2, vb = wave & 3;
        f32x16 o = {};
#pragma unroll
        for (int s = 0; s < 8; ++s) { const bf16x8 af = *(const LAS bf16x8*)(L + L_QE + (32 * ib + r32) * PK + (16 * s + 8 * hi) * 2), bfr = *(const LAS bf16x8*)(L + L_ST + (32 * vb + r32) * PK + (16 * s + 8 * hi) * 2);
            o = __builtin_amdgcn_mfma_f32_32x32x16_bf16(af, bfr, o, 0, 0, 0); }
#pragma unroll
        for (int q = 0; q < 2; ++q) { const int kb = 2 * (wave >> 2) + q; const float dk = DK[32 * kb + r32];
#pragma unroll
            for (int r = 0; r < 16; ++r) st[q][r] *= dk;
#pragma unroll
            for (int s = 0; s < 4; ++s) { const bf16x8 af = *(const LAS bf16x8*)(L + L_VT + (32 * vb + r32) * PJ + (16 * s + 8 * hi) * 2), bfr = *(const LAS bf16x8*)(L + L_KDT + (32 * kb + r32) * PJ + (16 * s + 8 * hi) * 2);
                st[q] = __builtin_amdgcn_mfma_f32_32x32x16_bf16(af, bfr, st[q], 0, 0, 0); } }
        __syncthreads();
#pragma unroll
        for (int s = 0; s < 4; ++s) { const bf16x8 af = *(const LAS bf16x8*)(L + L_P + (32 * ib + r32) * PJ + (16 * s + 8 * hi) * 2), bfr = *(const LAS bf16x8*)(L + L_VT + (32 * vb + r32) * PJ + (16 * s + 8 * hi) * 2);
            o = __builtin_amdgcn_mfma_f32_32x32x16_bf16(af, bfr, o, 0, 0, 0); }
#pragma unroll
        for (int r = 0; r < 16; ++r) OST[(32 * ib + att::crow(r, hi)) * OP + 32 * vb + r32] = o[r];
#pragma unroll
        for (int q = 0; q < 2; ++q) { const int kb = 2 * (wave >> 2) + q;
#pragma unroll
            for (int r = 0; r < 16; ++r) *(LAS bf16*)(L + L_ST + (32 * vb + att::crow(r, hi)) * PK + (32 * kb + r32) * 2) = f2bf(st[q][r]); }
        if (c + 1 < SEQ / 64) HG_A1();
        __syncthreads();
        {
            float ov[16]; float ss = 0.f;
#pragma unroll
            for (int q = 0; q < 4; ++q) { const f32x4 t = *(const LAS f32x4*)(OST + oi * OP + 16 * os + 4 * q); ov[4 * q] = t.x; ov[4 * q + 1] = t.y; ov[4 * q + 2] = t.z; ov[4 * q + 3] = t.w; ss += (t.x * t.x + t.y * t.y) + (t.z * t.z + t.w * t.w); }
            ss += __shfl_xor(ss, 1); ss += __shfl_xor(ss, 2); ss += __shfl_xor(ss, 4);
            const float rstd = rsqrtf(ss * (1.f / 128.f) + EPS);
            const unsigned gw[8] = {gg0.x, gg0.y, gg0.z, gg0.w, gg1.x, gg1.y, gg1.z, gg1.w}; unsigned ow[8];
#pragma unroll
            for (int q = 0; q < 8; ++q) ow[q] = pk2(ov[2 * q] * rstd * gn[2 * q] * bflo(gw[q]), ov[2 * q + 1] * rstd * gn[2 * q + 1] * bfhi(gw[q]));
            bf16* op = HOAO + orow * 1024 + h * 128 + 16 * os;
            *(GAS v4u*)op = (v4u){ow[0], ow[1], ow[2], ow[3]}; *(GAS v4u*)(op + 8) = (v4u){ow[4], ow[5], ow[6], ow[7]};
        }
    }
#undef HG_LOAD
#undef HG_A1
    __syncthreads();
}
}
__device__ __forceinline__ void p3_mixers(Frame& F, int sub) {
    constexpr int NHG = 64;
    if ((int)blockIdx.x < NHG) { if (sub & 1) { for (int u = blockIdx.x; u < BATCH * 4; u += NHG) hg::run(F, u >> 2, u & 3); } }
    else if (sub & 2) { const int na = F.G - NHG; for (int u = (int)blockIdx.x - NHG; u < BATCH * 2 * 16; u += na) att::unit(F, u >> 5, (u >> 4) & 1, u & 15); }
}

struct Args { const void* in[22]; float* out; unsigned char* ws; int ph_lo, ph_hi, one, sub; };
__global__ void __launch_bounds__(NWAVES * 64, 2) skel_fwd(Args args) {
    extern __shared__ __attribute__((aligned(16))) unsigned char lds[];
    Frame F;
    F.lds = (LAS unsigned char*)lds; F.MISC = (volatile LAS unsigned*)(F.lds + MISC_OFF);
    F.tid = threadIdx.x; F.lane = F.tid & 63; F.wave = __builtin_amdgcn_readfirstlane(F.tid >> 6); F.G = gridDim.x;
    F.x = (const float*)args.in[0]; F.c = (const float*)args.in[1]; F.pos = (const int*)args.in[2]; F.w_ada = (const float*)args.in[3]; F.b_ada = (const float*)args.in[4];
    F.n1g = (const float*)args.in[5]; F.w_in = (const float*)args.in[6]; F.lbl = (const float*)args.in[7]; F.hgg = (const float*)args.in[8]; F.w_hg = (const float*)args.in[9];
    F.qg = (const float*)args.in[10]; F.kg = (const float*)args.in[11]; F.sinks = (const float*)args.in[12]; F.w_att = (const float*)args.in[13]; F.w_out = (const float*)args.in[14];
    F.n2g = (const float*)args.in[15]; F.w_r = (const float*)args.in[16]; F.b_r = (const float*)args.in[17]; F.w_up = (const float*)args.in[18]; F.b_up = (const float*)args.in[19];
    F.w_dn = (const float*)args.in[20]; F.b_dn = (const float*)args.in[21]; F.out = args.out; F.ws = args.ws; F.ctl = (gu32*)(args.ws + WS_CTL);
    for (int u = F.tid; u < (LDS_BYTES - LDSCTL_OFF) / 4; u += NWAVES * 64) ((LAS unsigned*)(F.lds + LDSCTL_OFF))[u] = 0u;
    __syncthreads();
    XcdBarrier bar; bar.bar = (unsigned*)(F.ctl + CW_BAR); bar.x = 0; bar.st = nullptr;
    if (args.one) bar = xcd_barrier_post((unsigned*)(F.ctl + CW_BAR), F.MISC + 8);
    const int lo = args.ph_lo, hi = args.ph_hi;
#define IN(k) (lo <= (k) && (k) < hi)
#define SEAM(k) do { if (IN(k) && IN((k) + 1)) xcd_barrier(bar); } while (0)
    unsigned char* ws = args.ws;
    if (IN(0)) { p0_prologue(F); SEAM(0); }
    if (IN(1)) { p1_xn(F); SEAM(1); }
    if (IN(2)) {
        pg8::Gemm g{(const bf16*)(ws + WS_XN), (const bf16*)(ws + WS_WIN), T, INW, 1024, nullptr, 0, 1024}; pg8::StaticOrder S; S.init(T, INW, F.G, (int)blockIdx.x);
        EpiIn E{ws}; pg8::gemm_phase<EpiIn, pg8::StaticOrder, true, false>(F.lds, g, S, E); SEAM(2);
    }
    if (IN(3)) { p3_mixers(F, args.sub); SEAM(3); }
    if (IN(4)) {
        pg8::StaticOrder S; S.init(T, 1024, F.G, (int)blockIdx.x);
        { pg8::Gemm g{(const bf16*)(ws + WS_HOAO), (const bf16*)(ws + WS_WHG), T, 1024, 512, nullptr, 0, 1024}; EpiMrg<false> E{(bf16*)(ws + WS_MRG), (const bf16*)(ws + WS_SGH)};
          pg8::gemm_phase<EpiMrg<false>, pg8::StaticOrder, true, false>(F.lds, g, S, E); }
        { pg8::Gemm g{(const bf16*)(ws + WS_HOAO) + 512, (const bf16*)(ws + WS_WATT), T, 1024, 512, nullptr, 0, 1024}; EpiMrg<true> E{(bf16*)(ws + WS_MRG), (const bf16*)(ws + WS_SGA)};
          pg8::gemm_phase<EpiMrg<true>, pg8::StaticOrder, true, false>(F.lds, g, S, E); }
        SEAM(4);
    }
    if (IN(5)) {
        pg8::Gemm g{(const bf16*)(ws + WS_MRG), (const bf16*)(ws + WS_WOUT), T, 1024, 1024, nullptr, 0, 1024}; pg8::StaticOrder S; S.init(T, 1024, F.G, (int)blockIdx.x);
        EpiOut E{F.x, (const float*)(ws + WS_MOD), F.out}; pg8::gemm_phase<EpiOut, pg8::StaticOrder, true, false>(F.lds, g, S, E); SEAM(5);
    }
    if (IN(6)) { p6_route(F); SEAM(6); }
    if (IN(7)) {
        moe_tables(F);
        pg8::Gemm g{(const bf16*)(ws + WS_H2), (const bf16*)(ws + WS_WUP), T, NEXP * 2048, 1024, (const int*)(ws + WS_TOKL), T, 1024}; MoeOrder<8> S{F.MISC, F.G, (int)blockIdx.x};
        EpiUp E{(bf16*)(ws + WS_ACT), (const float*)(ws + WS_BUPP)}; pg8::gemm_phase<EpiUp, MoeOrder<8>, true, true>(F.lds, g, S, E); SEAM(7);
    }
    if (IN(8)) {
        moe_tables(F);
        pg8::Gemm g{(const bf16*)(ws + WS_ACT), (const bf16*)(ws + WS_WDN), T, NEXP * 1024, 1024, nullptr, 0, 1024}; MoeOrder<4> S{F.MISC, F.G, (int)blockIdx.x};
        EpiDn E{(bf16*)(ws + WS_Y), F.b_dn, (const int*)(ws + WS_TOKL), (const float*)(ws + WS_GATL)}; pg8::gemm_phase<EpiDn, MoeOrder<4>, true, false>(F.lds, g, S, E); SEAM(8);
    }
    if (IN(9)) { p9_final(F); }
#undef IN
#undef SEAM
}

#ifndef DEV_MASK
#define DEV_MASK 0x3ff
#ifndef DEV_SUB
#define DEV_SUB 3
#endif
#endif
extern "C" void kernel_launch(void* const* d_in, const int* in_sizes, int n_in, void* d_out, int out_size, void* d_ws, size_t ws_size, hipStream_t stream) {
    static int grid = 0;
    if (grid == 0) {
        if (n_in != 22 || ws_size < WS_END || out_size != T * DM) { fprintf(stderr, "kernel_launch: unexpected shapes n_in %d ws %zu out %d\n", n_in, ws_size, out_size); grid = -1; return; }
        int dev = 0, cus = 0;
        if (hipGetDevice(&dev) != hipSuccess || hipDeviceGetAttribute(&cus, hipDeviceAttributeMultiprocessorCount, dev) != hipSuccess) { grid = -1; return; }
        if (hipFuncSetAttribute((const void*)skel_fwd, hipFuncAttributeMaxDynamicSharedMemorySize, LDS_BYTES) != hipSuccess) { fprintf(stderr, "kernel_launch: hipFuncSetAttribute failed\n"); grid = -1; return; }
        int per_cu = 0;
        if (hipOccupancyMaxActiveBlocksPerMultiprocessor(&per_cu, (const void*)skel_fwd, NWAVES * 64, LDS_BYTES) != hipSuccess || per_cu < 1) { fprintf(stderr, "kernel_launch: occupancy query says %d workgroups per CU; nothing launched\n", per_cu); grid = -1; return; }
        (void)hipGetLastError();
        grid = cus;
    }
    if (grid < 0) return;
    unsigned char* ws = (unsigned char*)d_ws; float* out = (float*)d_out;
#if DEV_ORACLE
    const float* x = (const float*)d_in[0]; const int* pos = (const int*)d_in[2];
    const float* hgg = (const float*)d_in[8]; const float* qg = (const float*)d_in[10]; const float* kg = (const float*)d_in[11];
    const float* sinks = (const float*)d_in[12]; const float* n2g = (const float*)d_in[15]; const float* w_r = (const float*)d_in[16]; const float* b_r = (const float*)d_in[17];
    const float* w_up = (const float*)d_in[18]; const float* b_up = (const float*)d_in[19]; const float* w_dn = (const float*)d_in[20]; const float* b_dn = (const float*)d_in[21];
    float* MOD = (float*)(ws + WS_MOD); float* LB = (float*)(ws + WS_LB);
    bf16* XN = (bf16*)(ws + WS_XN); bf16* QH = (bf16*)(ws + WS_QH); float* LF = (float*)(ws + WS_LF); bf16* VH = (bf16*)(ws + WS_VH); bf16* GH = (bf16*)(ws + WS_GH);
    bf16* AQ = (bf16*)(ws + WS_AQ); bf16* AKV = (bf16*)(ws + WS_AKV); bf16* SGH = (bf16*)(ws + WS_SGH); bf16* SGA = (bf16*)(ws + WS_SGA);
    bf16* HOAO = (bf16*)(ws + WS_HOAO); bf16* MRG = (bf16*)(ws + WS_MRG); bf16* H2 = (bf16*)(ws + WS_H2); bf16* Y = (bf16*)(ws + WS_Y);
    int* TOPI = (int*)(ws + WS_TOPI); float* TOPW = (float*)(ws + WS_TOPW);
    float* OTMP = (float*)(ws + WS_OTMP); float* QN = (float*)(ws + WS_QN); float* KN = (float*)(ws + WS_KN);
#endif
    (void)hipMemsetAsync(ws + WS_CTL, 0, CTL_ZERO_BYTES, stream);
    Args a{}; for (int i = 0; i < 22; ++i) a.in[i] = d_in[i];
    a.out = out; a.ws = ws; a.one = 0;
#if DEV_ORACLE
#define SK(p) do { a.ph_lo = (p); a.ph_hi = (p) + 1; hipLaunchKernelGGL(skel_fwd, dim3(grid), dim3(NWAVES * 64), LDS_BYTES, stream, a); } while (0)
#define ON(p) ((DEV_MASK >> (p)) & 1)
    if (ON(0)) SK(0); else { n_mod<<<dim3(24, 16), 256, 0, stream>>>((const float*)d_in[1], (const float*)d_in[3], (const float*)d_in[4], MOD); n_misc<<<4, 256, 0, stream>>>((const float*)d_in[7], LB, H2); }
    if (ON(1)) SK(1); else k_normmod<<<T / 4, 256, 0, stream>>>(x, (const float*)d_in[5], MOD, 0, 1024, XN);
    if (ON(2)) SK(2); else n_gemm<EpiInN><<<dim3(INW / 64, T / 64), 256, 0, stream>>>(XN, 1024, (const float*)d_in[6], INW, 1024, EpiInN{QH, LF, VH, GH, AQ, AKV, SGH, SGA, LB});
    a.sub = ON(3) ? DEV_SUB : 0;
    if (a.sub) SK(3);
    if (!(a.sub & 1)) { n_hgrn<<<128, 64, 0, stream>>>(QH, LF, VH, OTMP); n_hgrn_norm<<<T, 256, 0, stream>>>(OTMP, hgg, GH, HOAO); }
    if (!(a.sub & 2)) { n_qkn<<<(T * 10 + 255) / 256, 256, 0, stream>>>(AQ, AKV, pos, qg, kg, QN, KN); n_attn<<<T * 8 / 256, 256, 0, stream>>>(QN, KN, AKV, sinks, HOAO); }
    if (ON(4)) SK(4); else {
        n_gemm<EpiM1N><<<dim3(16, T / 64), 256, 0, stream>>>(HOAO, 1024, (const float*)d_in[9], 1024, 512, EpiM1N{MRG, SGH});
        n_gemm<EpiM2N><<<dim3(16, T / 64), 256, 0, stream>>>(HOAO + 512, 1024, (const float*)d_in[13], 1024, 512, EpiM2N{MRG, SGA});
    }
    if (ON(5)) SK(5); else n_gemm<EpiOutN><<<dim3(16, T / 64), 256, 0, stream>>>(MRG, 1024, (const float*)d_in[14], 1024, 1024, EpiOutN{x, MOD, out});
    if (ON(6)) SK(6); else n_route<<<T / 4, 256, 0, stream>>>(out, n2g, MOD, w_r, b_r, H2, TOPI, TOPW);
    if (ON(7) && ON(8)) { SK(7); SK(8); } else n_moe<<<T * 4, 256, 0, stream>>>(H2, TOPI, TOPW, w_up, b_up, w_dn, b_dn, Y);
    if (ON(9)) SK(9); else k_final<<<T / 4, 256, 0, stream>>>(out, MOD, Y);
#else
    a.one = 1; a.sub = 3; a.ph_lo = 0; a.ph_hi = 10;
    hipLaunchKernelGGL(skel_fwd, dim3(grid), dim3(NWAVES * 64), LDS_BYTES, stream, a);
#endif
}
```

```cpp
#include <hip/hip_runtime.h>
#include <cstdio>
#include <cstdint>
#include <cmath>

typedef unsigned short bf16;
constexpr int BATCH = 16, SEQ = 2048, DM = 1024, T = BATCH * SEQ;
constexpr int INW = 4864, NEXP = 32, TOPK = 4, DEXP = 1024;
constexpr float EPS = 1e-6f;

constexpr size_t MiB = 1u << 20;
constexpr size_t WS_CTL = 0;
constexpr size_t WS_MOD = 1 * MiB;
constexpr size_t WS_LB = 1 * MiB + 512 * 1024;
constexpr size_t WS_BUPP = 2 * MiB;
constexpr size_t WS_TOKL = 4 * MiB;
constexpr size_t WS_GATL = 8 * MiB;
constexpr size_t WS_TOPI = 12 * MiB;
constexpr size_t WS_TOPW = 13 * MiB;
constexpr size_t WS_WIN = 16 * MiB, WS_WHG = 26 * MiB, WS_WATT = 27 * MiB, WS_WOUT = 28 * MiB, WS_WUP = 32 * MiB, WS_WDN = 160 * MiB;
constexpr size_t WS_H2 = 224 * MiB;
constexpr size_t WS_R = 290 * MiB;
constexpr size_t WS_XN = WS_R, WS_QH = WS_R + 64 * MiB, WS_LF = WS_R + 96 * MiB, WS_VH = WS_R + 160 * MiB, WS_GH = WS_R + 192 * MiB,
                 WS_AQ = WS_R + 224 * MiB, WS_AKV = WS_R + 256 * MiB, WS_SGH = WS_R + 272 * MiB, WS_SGA = WS_R + 336 * MiB,
                 WS_HOAO = WS_R + 400 * MiB, WS_MRG = WS_R + 464 * MiB;
constexpr size_t WS_ACT = WS_R, WS_Y = WS_R + 272 * MiB;
constexpr size_t WS_TMP = 820 * MiB;
constexpr size_t WS_OTMP = WS_TMP, WS_QN = WS_TMP + 64 * MiB, WS_KN = WS_TMP + 128 * MiB;
constexpr size_t WS_END = 964 * MiB;

__device__ __forceinline__ float bf2f(bf16 v) { return __uint_as_float((unsigned)v << 16); }
typedef float f32x2_t __attribute__((ext_vector_type(2))); typedef __bf16 bf16x2_t __attribute__((ext_vector_type(2)));
__device__ __forceinline__ unsigned cvtpk_s(float lo, float hi) { f32x2_t v = {lo, hi}; bf16x2_t b = __builtin_convertvector(v, bf16x2_t); return __builtin_bit_cast(unsigned, b); }
__device__ __forceinline__ bf16 f2bf(float f) { return (bf16)(cvtpk_s(f, f) & 0xffffu); }
__device__ __forceinline__ float silu_f(float x) { return x / (1.f + __expf(-x)); }
__device__ __forceinline__ float sigm_f(float x) { return 1.f / (1.f + __expf(-x)); }
__device__ __forceinline__ float wave_sum(float v) {
#pragma unroll
    for (int o = 1; o < 64; o <<= 1) v += __shfl_xor(v, o);
    return v;
}

__device__ __forceinline__ void rope_cs(int pos, int i, float& cs, float& sn) {
    const float invf = exp2f(-(float)i * 0.125f * 18.931568569324174f);
    double a = (double)pos * (double)invf * 0.15915494309189535; a -= floor(a);
    sn = __builtin_amdgcn_sinf((float)a); cs = __builtin_amdgcn_cosf((float)a);
}
#ifndef DEV_ORACLE
#define DEV_ORACLE 0
#endif
#if DEV_ORACLE
__global__ void n_mod(const float* c, const float* w_ada, const float* b_ada, float* MOD) {
    const int n = blockIdx.x * 256 + threadIdx.x, b = blockIdx.y;
    __shared__ float cond[1024];
    for (int k = threadIdx.x; k < 1024; k += 256) cond[k] = silu_f(c[b * 1024 + k]);
    __syncthreads();
    float acc = 0.f;
    for (int k = 0; k < 1024; ++k) acc += cond[k] * w_ada[(size_t)k * 6144 + n];
    MOD[b * 6144 + n] = acc + b_ada[n];
}
__global__ void n_misc(const float* lbl, float* LB, bf16* H2) {
    const int i = blockIdx.x * 256 + threadIdx.x;
    if (i < 512) LB[i] = 1.f / (1.f + __expf(lbl[512 + i] - lbl[i]));
    if (i < 1024) H2[(size_t)T * 1024 + i] = 0;
}
__global__ void k_normmod(const float* x, const float* gain, const float* MOD, int sh_off, int sc_off, bf16* out) {
    const int lane = threadIdx.x & 63, row = blockIdx.x * 4 + (threadIdx.x >> 6), b = row / SEQ;
    const float4* xr = (const float4*)(x + (size_t)row * DM) + lane;
    float4 v[4]; float s = 0.f;
#pragma unroll
    for (int j = 0; j < 4; ++j) { v[j] = xr[64 * j]; s += v[j].x * v[j].x + v[j].y * v[j].y + v[j].z * v[j].z + v[j].w * v[j].w; }
    const float rstd = rsqrtf(wave_sum(s) * (1.f / DM) + EPS);
    const float* mb = MOD + (size_t)b * 6144;
#pragma unroll
    for (int j = 0; j < 4; ++j) {
        const int c = 4 * lane + 256 * j;
        const float4 g = *(const float4*)(gain + c), sc = *(const float4*)(mb + sc_off + c), sh = *(const float4*)(mb + sh_off + c);
        ushort4 o;
        o.x = f2bf(v[j].x * rstd * g.x * (1.f + sc.x) + sh.x); o.y = f2bf(v[j].y * rstd * g.y * (1.f + sc.y) + sh.y);
        o.z = f2bf(v[j].z * rstd * g.z * (1.f + sc.z) + sh.z); o.w = f2bf(v[j].w * rstd * g.w * (1.f + sc.w) + sh.w);
        *(ushort4*)(out + (size_t)row * DM + c) = o;
    }
}
template <class Epi> __global__ void n_gemm(const bf16* A, int lda, const float* W, int N, int K, Epi epi) {
    __shared__ float As[16][65], Ws[16][65];
    const int tx = threadIdx.x & 15, ty = threadIdx.x >> 4, m0 = blockIdx.y * 64, n0 = blockIdx.x * 64;
    float acc[4][4];
#pragma unroll
    for (int i = 0; i < 4; ++i)
#pragma unroll
        for (int j = 0; j < 4; ++j) acc[i][j] = 0.f;
    for (int k0 = 0; k0 < K; k0 += 16) {
        for (int i = threadIdx.x; i < 1024; i += 256) { const int r = i >> 4, kk = i & 15; As[kk][r] = bf2f(A[(size_t)(m0 + r) * lda + k0 + kk]); }
        for (int i = threadIdx.x; i < 1024; i += 256) { const int kk = i >> 6, cc = i & 63; Ws[kk][cc] = W[(size_t)(k0 + kk) * N + n0 + cc]; }
        __syncthreads();
#pragma unroll
        for (int kk = 0; kk < 16; ++kk) {
            float a[4], b[4];
#pragma unroll
            for (int i = 0; i < 4; ++i) { a[i] = As[kk][ty * 4 + i]; b[i] = Ws[kk][tx * 4 + i]; }
#pragma unroll
            for (int i = 0; i < 4; ++i)
#pragma unroll
                for (int j = 0; j < 4; ++j) acc[i][j] += a[i] * b[j];
        }
        __syncthreads();
    }
#pragma unroll
    for (int i = 0; i < 4; ++i)
#pragma unroll
        for (int j = 0; j < 4; ++j) epi(m0 + ty * 4 + i, n0 + tx * 4 + j, acc[i][j]);
}
struct EpiInN {
    bf16* QH; float* LF; bf16 *VH, *GH, *AQ, *AKV, *SGH, *SGA; const float* LB;
    __device__ void operator()(int r, int c, float v) const {
        if (c < 512) QH[(size_t)r * 512 + c] = f2bf(silu_f(v));
        else if (c < 1024) { const int cc = c - 512; const float lb = LB[cc]; LF[(size_t)r * 512 + cc] = __logf(lb + (1.f - lb) * sigm_f(v)); }
        else if (c < 1536) VH[(size_t)r * 512 + (c - 1024)] = f2bf(v);
        else if (c < 2048) GH[(size_t)r * 512 + (c - 1536)] = f2bf(silu_f(v));
        else if (c < 2560) AQ[(size_t)r * 512 + (c - 2048)] = f2bf(v);
        else if (c < 2816) AKV[(size_t)r * 256 + (c - 2560)] = f2bf(v);
        else if (c < 3840) SGH[(size_t)r * 1024 + (c - 2816)] = f2bf(sigm_f(v));
        else SGA[(size_t)r * 1024 + (c - 3840)] = f2bf(sigm_f(v));
    }
};
struct EpiM1N { bf16* MRG; const bf16* SG; __device__ void operator()(int r, int c, float v) const { MRG[(size_t)r * 1024 + c] = f2bf(bf2f(SG[(size_t)r * 1024 + c]) * v); } };
struct EpiM2N { bf16* MRG; const bf16* SG; __device__ void operator()(int r, int c, float v) const { MRG[(size_t)r * 1024 + c] = f2bf(bf2f(MRG[(size_t)r * 1024 + c]) + bf2f(SG[(size_t)r * 1024 + c]) * v); } };
struct EpiOutN { const float* x; const float* MOD; float* out; __device__ void operator()(int r, int c, float v) const { out[(size_t)r * 1024 + c] = x[(size_t)r * 1024 + c] + MOD[(size_t)(r / SEQ) * 6144 + 2048 + c] * v; } };

__global__ void n_hgrn(const bf16* QH, const float* LF, const bf16* VH, float* OTMP) {
    const int bh = blockIdx.x >> 1, vh = blockIdx.x & 1, b = bh >> 2, h = bh & 3, v = threadIdx.x;
    __shared__ float S[128 * 64];
    __shared__ float sq[128], sf[128], sk[128];
    for (int i = v; i < 128 * 64; i += 64) S[i] = 0.f;
    for (int t = 0; t < SEQ; ++t) {
        const size_t row = (size_t)b * SEQ + t;
        __syncthreads();
        for (int k = v; k < 128; k += 64) { const float lf = LF[row * 512 + h * 128 + k]; const float f = __expf(lf); sf[k] = f; sk[k] = 1.f - f; sq[k] = bf2f(QH[row * 512 + h * 128 + k]); }
        __syncthreads();
        const float vv = bf2f(VH[row * 512 + h * 128 + vh * 64 + v]);
        float o = 0.f;
        for (int k = 0; k < 128; ++k) { float s = S[k * 64 + v]; s = sf[k] * s + sk[k] * vv; S[k * 64 + v] = s; o += s * sq[k]; }
        OTMP[row * 512 + h * 128 + vh * 64 + v] = o;
    }
}
__global__ void n_hgrn_norm(const float* OTMP, const float* gain, const bf16* GH, bf16* HOAO) {
    const int lane = threadIdx.x & 63, idx = blockIdx.x * 4 + (threadIdx.x >> 6), t = idx >> 2, h = idx & 3;
    const float a = OTMP[(size_t)t * 512 + h * 128 + lane], b = OTMP[(size_t)t * 512 + h * 128 + 64 + lane];
    const float rstd = rsqrtf(wave_sum(a * a + b * b) * (1.f / 128.f) + EPS);
    HOAO[(size_t)t * 1024 + h * 128 + lane] = f2bf(a * rstd * gain[lane] * bf2f(GH[(size_t)t * 512 + h * 128 + lane]));
    HOAO[(size_t)t * 1024 + h * 128 + 64 + lane] = f2bf(b * rstd * gain[64 + lane] * bf2f(GH[(size_t)t * 512 + h * 128 + 64 + lane]));
}
__global__ void n_qkn(const bf16* AQ, const bf16* AKV, const int* pos, const float* qg, const float* kg, float* QN, float* KN) {
    const int idx = blockIdx.x * 256 + threadIdx.x, t = idx / 10, j = idx % 10;
    if (t >= T) return;
    const bf16* src = j < 8 ? AQ + (size_t)t * 512 + j * 64 : AKV + (size_t)t * 256 + (j - 8) * 64;
    const float* g = j < 8 ? qg : kg;
    float* dst = j < 8 ? QN + (size_t)t * 512 + j * 64 : KN + (size_t)t * 128 + (j - 8) * 64;
    float ss = 0.f;
    for (int d = 0; d < 64; ++d) { const float v = bf2f(src[d]); ss += v * v; }
    const float rstd = rsqrtf(ss * (1.f / 64.f) + EPS);
    const int p = pos[t];
    for (int d = 0; d < 64; ++d) {
        float v = bf2f(src[d]) * rstd * g[d];
        if (d < 16) {
            const int i = d & 7; float cs, sn; rope_cs(p, i, cs, sn);
            const float x1 = bf2f(src[i]) * rstd * g[i], x2 = bf2f(src[i + 8]) * rstd * g[i + 8];
            v = d < 8 ? x1 * cs - x2 * sn : x2 * cs + x1 * sn;
        }
        dst[d] = v;
    }
}
__global__ void __launch_bounds__(256) n_attn(const float* QN, const float* KN, const bf16* AKV, const float* sinks, bf16* HOAO) {
    const int idx = blockIdx.x * 256 + threadIdx.x, t = idx >> 3, hq = idx & 7, kvh = hq >> 2, ts = t % SEQ, b0 = t - ts;
    float q[64], acc[64];
#pragma unroll
    for (int d = 0; d < 64; ++d) { q[d] = QN[(size_t)t * 512 + hq * 64 + d] * 0.125f; acc[d] = 0.f; }
    float m = sinks[hq], l = 1.f;
    for (int kt = (ts >= 127 ? ts - 127 : 0); kt <= ts; ++kt) {
        const float* kr = KN + (size_t)(b0 + kt) * 128 + kvh * 64; const bf16* vr = AKV + (size_t)(b0 + kt) * 256 + 128 + kvh * 64;
        float s = 0.f;
#pragma unroll
        for (int d = 0; d < 64; ++d) s += q[d] * kr[d];
        const float mn = fmaxf(m, s), sc = __expf(m - mn), p = __expf(s - mn);
        l = l * sc + p; m = mn;
#pragma unroll
        for (int d = 0; d < 64; ++d) acc[d] = acc[d] * sc + p * bf2f(vr[d]);
    }
    const float il = 1.f / l;
#pragma unroll
    for (int d = 0; d < 64; ++d) HOAO[(size_t)t * 1024 + 512 + hq * 64 + d] = f2bf(acc[d] * il);
}
__global__ void __launch_bounds__(256) n_route(const float* x1, const float* gain, const float* MOD, const float* wr, const float* br, bf16* H2, int* TOPI, float* TOPW) {
    const int lane = threadIdx.x & 63, row = blockIdx.x * 4 + (threadIdx.x >> 6), b = row / SEQ;
    const float4* xr = (const float4*)(x1 + (size_t)row * DM) + lane;
    float4 v[4]; float s = 0.f;
#pragma unroll
    for (int j = 0; j < 4; ++j) { v[j] = xr[64 * j]; s += v[j].x * v[j].x + v[j].y * v[j].y + v[j].z * v[j].z + v[j].w * v[j].w; }
    const float rstd = rsqrtf(wave_sum(s) * (1.f / DM) + EPS);
    const float* mb = MOD + (size_t)b * 6144;
    float hv[16];
#pragma unroll
    for (int j = 0; j < 4; ++j) {
        const int c = 4 * lane + 256 * j;
        const float4 g = *(const float4*)(gain + c), sc = *(const float4*)(mb + 4096 + c), sh = *(const float4*)(mb + 3072 + c);
        hv[4 * j + 0] = v[j].x * rstd * g.x * (1.f + sc.x) + sh.x; hv[4 * j + 1] = v[j].y * rstd * g.y * (1.f + sc.y) + sh.y;
        hv[4 * j + 2] = v[j].z * rstd * g.z * (1.f + sc.z) + sh.z; hv[4 * j + 3] = v[j].w * rstd * g.w * (1.f + sc.w) + sh.w;
        ushort4 o; o.x = f2bf(hv[4 * j]); o.y = f2bf(hv[4 * j + 1]); o.z = f2bf(hv[4 * j + 2]); o.w = f2bf(hv[4 * j + 3]);
        *(ushort4*)(H2 + (size_t)row * DM + c) = o;
    }
    float lg[32];
#pragma unroll
    for (int e = 0; e < 32; ++e) {
        float p = 0.f;
#pragma unroll
        for (int j = 0; j < 4; ++j)
#pragma unroll
            for (int i = 0; i < 4; ++i) p += hv[4 * j + i] * wr[(size_t)(4 * lane + 256 * j + i) * 32 + e];
        lg[e] = wave_sum(p) + br[e];
    }
    unsigned used = 0u; float tv[4]; int ti[4];
#pragma unroll
    for (int k = 0; k < 4; ++k) {
        float best = -INFINITY; int bi = 0;
#pragma unroll
        for (int e = 0; e < 32; ++e) { const bool ok = !((used >> e) & 1u) && lg[e] > best; best = ok ? lg[e] : best; bi = ok ? e : bi; }
        used |= 1u << bi; tv[k] = best; ti[k] = bi;
    }
    const float e1 = __expf(tv[1] - tv[0]), e2 = __expf(tv[2] - tv[0]), e3 = __expf(tv[3] - tv[0]), inv = 1.f / (1.f + e1 + e2 + e3);
    if (lane == 0) {
        TOPI[row * 4 + 0] = ti[0]; TOPI[row * 4 + 1] = ti[1]; TOPI[row * 4 + 2] = ti[2]; TOPI[row * 4 + 3] = ti[3];
        TOPW[row * 4 + 0] = inv; TOPW[row * 4 + 1] = e1 * inv; TOPW[row * 4 + 2] = e2 * inv; TOPW[row * 4 + 3] = e3 * inv;
    }
}
__global__ void n_moe(const bf16* H2, const int* TOPI, const float* TOPW, const float* w_up, const float* b_up, const float* w_dn, const float* b_dn, bf16* Y) {
    const int a = blockIdx.x, t = a >> 2, tid = threadIdx.x, e = TOPI[a];
    const float gate = TOPW[a];
    __shared__ float hr[1024], av[1024];
    for (int k = tid; k < 1024; k += 256) hr[k] = bf2f(H2[(size_t)t * 1024 + k]);
    __syncthreads();
    const float* wu = w_up + (size_t)e * 1024 * 2048; const float* bu = b_up + (size_t)e * 2048;
    float ag[4], al[4];
#pragma unroll
    for (int j = 0; j < 4; ++j) { ag[j] = 0.f; al[j] = 0.f; }
    for (int k = 0; k < 1024; ++k) {
        const float h = hr[k];
#pragma unroll
        for (int j = 0; j < 4; ++j) { const float2 w = *(const float2*)(wu + (size_t)k * 2048 + 2 * (tid + 256 * j)); ag[j] += h * w.x; al[j] += h * w.y; }
    }
#pragma unroll
    for (int j = 0; j < 4; ++j) {
        const int o = tid + 256 * j;
        const float g = fminf(ag[j] + bu[2 * o], 7.f), li = fminf(fmaxf(al[j] + bu[2 * o + 1], -7.f), 7.f);
        av[o] = g * sigm_f(1.702f * g) * (li + 1.f);
    }
    __syncthreads();
    const float* wd = w_dn + (size_t)e * 1024 * 1024; const float* bd = b_dn + (size_t)e * 1024;
    float y[4];
#pragma unroll
    for (int j = 0; j < 4; ++j) y[j] = 0.f;
    for (int k = 0; k < 1024; ++k) {
        const float h = av[k];
#pragma unroll
        for (int j = 0; j < 4; ++j) y[j] += h * wd[(size_t)k * 1024 + tid + 256 * j];
    }
#pragma unroll
    for (int j = 0; j < 4; ++j) Y[(size_t)a * 1024 + tid + 256 * j] = f2bf(gate * (y[j] + bd[tid + 256 * j]));
}
__global__ void k_final(float* out, const float* MOD, const bf16* Y) {
    const int lane = threadIdx.x & 63, row = blockIdx.x * 4 + (threadIdx.x >> 6), b = row / SEQ;
    const float* g2 = MOD + (size_t)b * 6144 + 5120;
#pragma unroll
    for (int j = 0; j < 4; ++j) {
        const int c = 4 * lane + 256 * j;
        float4 x = *(float4*)(out + (size_t)row * DM + c); const float4 g = *(const float4*)(g2 + c);
        float s0 = 0.f, s1 = 0.f, s2 = 0.f, s3 = 0.f;
#pragma unroll
        for (int k = 0; k < 4; ++k) { const ushort4 y = *(const ushort4*)(Y + ((size_t)row * 4 + k) * DM + c); s0 += bf2f(y.x); s1 += bf2f(y.y); s2 += bf2f(y.z); s3 += bf2f(y.w); }
        x.x += g.x * s0; x.y += g.y * s1; x.z += g.z * s2; x.w += g.w * s3;
        *(float4*)(out + (size_t)row * DM + c) = x;
    }
}

#endif

namespace pg8 {
#define PG8_LAS __attribute__((address_space(3)))
typedef unsigned short bf16_t;
typedef short bf16x8 __attribute__((ext_vector_type(8)));
typedef float f32x4 __attribute__((ext_vector_type(4)));
typedef unsigned u32x4 __attribute__((ext_vector_type(4)));
constexpr int BM = 256, BK = 64, HALF = 128, HTB = HALF * BK * 2  , STAGE_BYTES = 8 * HTB, NXCD = 8, WGM = 8;

__host__ __device__ __forceinline__ int lds_byte(int r, int c) { const int st = (r >> 4) * 2 + (c >> 5), rr = r & 15, cc = c & 31, ob = rr * 64 + cc * 2; return st * 1024 + (ob ^ (((ob >> 9) & 1) << 5)); }
__host__ __device__ __forceinline__ void stage_rc(int b, int& R, int& C) { const int st = b / 1024, sb = b % 1024, swz = sb ^ (((sb >> 9) & 1) << 5); R = (st >> 1) * 16 + swz / 64; C = (st & 1) * 32 + (swz % 64) / 2; }
__host__ __device__ __forceinline__ int perm32(int rho) { const int n = rho >> 4, i = rho & 15; return 8 * (i >> 2) + 4 * n + (i & 3); }

struct Unit { int pm, pn, arow0, nvalid; };
struct Gemm { const bf16_t* A; const bf16_t* Bt; int M, N, K; const int* rowidx; int zero_row; int lda; };

struct StaticOrder {
    int nM, nN, nwg, G, c;
    __host__ __device__ void init(int M, int N, int G_, int c_) { nM = M / BM; nN = N / BM; nwg = nM * nN; G = G_; c = c_; }
    __host__ __device__ bool next(int i, Unit& u) const {
        const long L = (long)i * G + c; if (L >= nwg) return false;
        int wgid = (int)L; { const int q = nwg / NXCD, r = nwg % NXCD, xcd = wgid % NXCD, off = wgid / NXCD; wgid = (xcd < r ? xcd * (q + 1) : r * (q + 1) + (xcd - r) * q) + off; }
        const int nig = WGM * nN, gid = wgid / nig, fm = gid * WGM, gsz = (nM - fm) < WGM ? (nM - fm) : WGM;
        u.pm = fm + ((wgid % nig) % gsz); u.pn = (wgid % nig) / gsz; u.arow0 = 0; u.nvalid = 0; return true;
    }
};
__device__ __forceinline__ unsigned cvt_pk_bf16(float lo, float hi) { unsigned r; asm volatile("v_cvt_pk_bf16_f32 %0, %1, %2" : "=v"(r) : "v"(lo), "v"(hi)); return r; }

template <class Epi, class Sched, bool ALIGN_EPI, bool GATHER>
__device__ __forceinline__ void gemm_phase(PG8_LAS unsigned char* lds, const Gemm g, const Sched& S, const Epi& E) {
    const int tid = threadIdx.x, wid = __builtin_amdgcn_readfirstlane(tid >> 6), lane = tid & 63, wr = wid >> 2, wc = wid & 3, fr = lane & 15, fq = lane >> 4;
    const int K = g.K, nt = K / BK, lda = g.lda;
    unsigned voffA[2], voffB[2];
#pragma unroll
    for (int i = 0; i < 2; ++i) { int R, C; stage_rc(tid * 16 + i * 8192, R, C); const int Rb = Epi::PERM ? ((R & ~31) + perm32(R & 31)) : R;
        voffA[i] = (unsigned)(R * lda + C) * 2u; voffB[i] = (unsigned)(Rb * K + C) * 2u; }
    unsigned tokP[2], cpk = 0;
    const size_t kstep = (size_t)(BK * 2);
    const size_t hstep = (size_t)HALF * K * 2;
    const size_t hstepA = GATHER ? 0 : (size_t)HALF * lda * 2; const size_t tstepA = (size_t)BM * lda * 2;
    const size_t tstep = 2 * hstep;
    const unsigned ldsw = (unsigned)wid * 1024u;
    const int aoff = lds_byte(wr * 64 + fr, fq * 8), boff = lds_byte(wc * 32 + fr, fq * 8);
#define PG8_SA(b, h) (((b) * 2 + (h)) * HTB)
#define PG8_SB(b, h) ((4 + (b) * 2 + (h)) * HTB)
#define PG8_STAGE(bufoff, gbase, voff) do { _Pragma("unroll") for (int _i = 0; _i < 2; ++_i) \
        __builtin_amdgcn_global_load_lds((const unsigned*)((const char*)(gbase) + (voff)[_i]), (PG8_LAS unsigned*)(lds + (bufoff) + ldsw + _i * 8192), 16, 0, 0); } while (0)
#define PG8_STAGE_A(b, h, gbase) do { if constexpr (GATHER) { _Pragma("unroll") for (int _i = 0; _i < 2; ++_i) { const unsigned off_ = ((tokP[_i] >> (16 * (h))) & 0xffffu) * (unsigned)(lda * 2) + ((cpk >> (8 * _i)) & 0xffu); \
        __builtin_amdgcn_global_load_lds((const unsigned*)((const char*)(gbase) + off_), (PG8_LAS unsigned*)(lds + PG8_SA(b, h) + ldsw + _i * 8192), 16, 0, 0); } } else { PG8_STAGE(PG8_SA(b, h), (gbase) + (h) * hstepA, voffA); } } while (0)
#define PG8_GOFF(dst, u) do { _Pragma("unroll") for (int _i = 0; _i < 2; ++_i) { int R_, C_; stage_rc(tid * 16 + _i * 8192, R_, C_); \
        const int t0_ = (R_ < (u).nvalid) ? (g.rowidx[(u).arow0 + R_] >> 2) : g.zero_row, t1_ = (HALF + R_ < (u).nvalid) ? (g.rowidx[(u).arow0 + HALF + R_] >> 2) : g.zero_row; dst[_i] = (unsigned)t0_ | ((unsigned)t1_ << 16); } } while (0)
#define PG8_LDA(dst, b, h) do { _Pragma("unroll") for (int m = 0; m < 4; ++m) _Pragma("unroll") for (int k = 0; k < 2; ++k) dst[m][k] = *(const PG8_LAS bf16x8*)(lds + PG8_SA(b, h) + aoff + m * 2048 + k * 1024); } while (0)
#define PG8_LDB(dst, b, h) do { _Pragma("unroll") for (int n = 0; n < 2; ++n) _Pragma("unroll") for (int k = 0; k < 2; ++k) dst[n][k] = *(const PG8_LAS bf16x8*)(lds + PG8_SB(b, h) + boff + n * 2048 + k * 1024); } while (0)
#define PG8_MMA(ai, bj, At, Bt) do { __builtin_amdgcn_s_setprio(1); _Pragma("unroll") for (int m = 0; m < 4; ++m) _Pragma("unroll") for (int n = 0; n < 2; ++n) _Pragma("unroll") for (int k = 0; k < 2; ++k) \
        acc[ai][bj][m][n] = __builtin_amdgcn_mfma_f32_16x16x32_bf16(Bt[n][k], At[m][k], acc[ai][bj][m][n], 0, 0, 0); __builtin_amdgcn_s_setprio(0); } while (0)
#define PG8_WAIT_V(n) asm volatile("s_waitcnt vmcnt(" #n ")" ::: "memory")
#define PG8_WAIT_L(n) asm volatile("s_waitcnt lgkmcnt(" #n ")" ::: "memory")
#define PG8_BAR __builtin_amdgcn_s_barrier()
#define PG8_SCHED __builtin_amdgcn_sched_barrier(0)
    Unit cur, nxt; int ui = 0;
    if (!S.next(0, cur)) return;
    f32x4 acc[2][2][4][2];
#pragma unroll
    for (int a = 0; a < 2; ++a)
#pragma unroll
        for (int b = 0; b < 2; ++b)
#pragma unroll
            for (int m = 0; m < 4; ++m)
#pragma unroll
                for (int n = 0; n < 2; ++n) acc[a][b][m][n] = (f32x4){0.f, 0.f, 0.f, 0.f};
    bf16x8 At[4][2], B0[2][2], B1[2][2];
    const char* cA = GATHER ? (const char*)g.A : (const char*)g.A + (size_t)cur.pm * tstepA; const char* cB = (const char*)g.Bt + (size_t)cur.pn * tstep;
    if constexpr (GATHER) { PG8_GOFF(tokP, cur); int R0_, C0_, R1_, C1_; stage_rc(tid * 16, R0_, C0_); stage_rc(tid * 16 + 8192, R1_, C1_); cpk = (unsigned)(C0_ * 2) | ((unsigned)(C1_ * 2) << 8); }
    PG8_STAGE(PG8_SB(0, 0), cB, voffB); PG8_STAGE(PG8_SB(0, 1), cB + hstep, voffB); PG8_STAGE_A(0, 0, cA); PG8_STAGE_A(0, 1, cA);
    if (wr == 1) PG8_BAR;
    PG8_WAIT_V(2); PG8_BAR;
    PG8_STAGE(PG8_SB(1, 0), cB + kstep, voffB); PG8_STAGE_A(1, 0, cA + kstep); PG8_STAGE(PG8_SB(1, 1), cB + hstep + kstep, voffB);
    PG8_WAIT_V(6); PG8_BAR;
    for (;;) {
        const bool has_next = S.next(ui + 1, nxt);
        if constexpr (GATHER) { if (has_next) { unsigned tokN[2]; PG8_GOFF(tokN, nxt); *(PG8_LAS unsigned long long*)(lds + STAGE_BYTES + tid * 8) = (unsigned long long)tokN[0] | ((unsigned long long)tokN[1] << 32); } }
        const char* nA = GATHER ? cA : (has_next ? (const char*)g.A + (size_t)nxt.pm * tstepA : cA); const char* nB = has_next ? (const char*)g.Bt + (size_t)nxt.pn * tstep : cB;
        for (int t = 0; t < nt; t += 2) {
            const bool last = (t == nt - 2);
            const char* a1 = cA + (size_t)(t + 1) * kstep;
            const char* a2 = last ? nA : cA + (size_t)(t + 2) * kstep; const char* b2 = last ? nB : cB + (size_t)(t + 2) * kstep;
            const char* a3 = a2 + kstep; const char* b3 = b2 + kstep;
            PG8_LDB(B0, 0, 0); PG8_LDB(B1, 0, 1); PG8_SCHED; PG8_LDA(At, 0, 0); PG8_STAGE_A(1, 1, a1);
            PG8_WAIT_V(8); PG8_WAIT_L(0); PG8_BAR; PG8_MMA(0, 0, At, B0); PG8_MMA(0, 1, At, B1); PG8_BAR; PG8_SCHED;
            if constexpr (GATHER) { if (last && has_next) { const unsigned long long tn_ = *(const PG8_LAS unsigned long long*)(lds + STAGE_BYTES + tid * 8); tokP[0] = (unsigned)tn_; tokP[1] = (unsigned)(tn_ >> 32); } }
            PG8_LDA(At, 0, 1); PG8_STAGE(PG8_SB(0, 0), b2, voffB); PG8_STAGE(PG8_SB(0, 1), b2 + hstep, voffB); PG8_STAGE_A(0, 0, a2);
            PG8_WAIT_V(8); PG8_WAIT_L(0); PG8_BAR; PG8_MMA(1, 0, At, B0); PG8_MMA(1, 1, At, B1); PG8_BAR; PG8_SCHED;
            PG8_LDB(B0, 1, 0); PG8_LDB(B1, 1, 1); PG8_SCHED; PG8_LDA(At, 1, 0); PG8_STAGE_A(0, 1, a2);
            PG8_WAIT_V(8); PG8_WAIT_L(0); PG8_BAR; PG8_MMA(0, 0, At, B0); PG8_MMA(0, 1, At, B1); PG8_BAR; PG8_SCHED;
            PG8_LDA(At, 1, 1); PG8_STAGE(PG8_SB(1, 0), b3, voffB); PG8_STAGE(PG8_SB(1, 1), b3 + hstep, voffB); PG8_STAGE_A(1, 0, a3);
            PG8_WAIT_V(8); PG8_WAIT_L(0); PG8_BAR; PG8_MMA(1, 0, At, B0); PG8_MMA(1, 1, At, B1); PG8_BAR; PG8_SCHED;
        }
        if constexpr (ALIGN_EPI) { if (wr == 0) PG8_BAR; }
        E(acc, cur, wr, wc, fr, fq);
        if (!has_next) break;
#pragma unroll
        for (int a = 0; a < 2; ++a)
#pragma unroll
            for (int b = 0; b < 2; ++b)
#pragma unroll
                for (int m = 0; m < 4; ++m)
#pragma unroll
                    for (int n = 0; n < 2; ++n) acc[a][b][m][n] = (f32x4){0.f, 0.f, 0.f, 0.f};
        cur = nxt; cA = nA; cB = nB; ++ui;
        if constexpr (ALIGN_EPI) { if (wr == 1) PG8_BAR; }
    }
    PG8_WAIT_V(0);
    if constexpr (!ALIGN_EPI) { if (wr == 0) PG8_BAR; }
    PG8_BAR;
#undef PG8_SA
#undef PG8_SB
#undef PG8_STAGE
#undef PG8_STAGE_A
#undef PG8_GOFF
#undef PG8_LDA
#undef PG8_LDB
#undef PG8_MMA
#undef PG8_WAIT_V
#undef PG8_WAIT_L
#undef PG8_BAR
#undef PG8_SCHED
}
}

constexpr int NWAVES = 8;
constexpr int LDS_BYTES = 163840;
constexpr int LDSCTL_OFF = 162816;
constexpr int MISC_OFF = LDSCTL_OFF;
constexpr int CW_BAR = 4096;
constexpr int CW_CNT = 64;
constexpr size_t CTL_ZERO_BYTES = 64 * 1024;

#define GAS __attribute__((address_space(1)))
#define LAS __attribute__((address_space(3)))
typedef unsigned v4u __attribute__((ext_vector_type(4)));
typedef float f32x4 __attribute__((ext_vector_type(4)));
typedef short bf16x8 __attribute__((ext_vector_type(8)));
typedef GAS unsigned gu32;
#define RLX_AGENT __ATOMIC_RELAXED, __HIP_MEMORY_SCOPE_AGENT
#define LDS_WAIT() asm volatile("s_waitcnt lgkmcnt(0)" ::: "memory")
#define VM_WAIT() asm volatile("s_waitcnt vmcnt(0)" ::: "memory")
__device__ __forceinline__ unsigned pk2(float lo, float hi) { return cvtpk_s(lo, hi); }
__device__ __forceinline__ float fsigm(float x) { return __builtin_amdgcn_rcpf(1.f + __expf(-x)); }

#define XB_TMO      128
#define XB_XCNT(j)  (256  + 64 * (j))
#define XB_XSUB(j)  (1280 + 64 * (j))
#define XB_XGEN(j)  (2304 + 64 * (j))
#define XB_TOP      3328
#define XB_TOPGEN   3392
#define XCD_BAR_WORDS 3456
#define XB_SPIN_CAP (1u << 18)

__device__ __forceinline__ unsigned xb_ld(unsigned* p)              { return __hip_atomic_load(p, __ATOMIC_RELAXED, __HIP_MEMORY_SCOPE_AGENT); }
__device__ __forceinline__ unsigned xb_add(unsigned* p, unsigned v) { return __hip_atomic_fetch_add(p, v, __ATOMIC_RELAXED, __HIP_MEMORY_SCOPE_AGENT); }
__device__ __forceinline__ unsigned xb_xcc_id() { return (unsigned)__builtin_amdgcn_s_getreg((3 << 11) | 20) & 0xFu; }
#define XB_SPIN(cond, bar) do { unsigned _sp = 0; while (cond) { __builtin_amdgcn_s_sleep(1); \
    if ((++_sp & 255u) == 0u) { if (xb_ld(&(bar)[XB_TMO])) break; if (_sp > XB_SPIN_CAP) { atomicAdd(&(bar)[XB_TMO], 1u); break; } } } } while (0)

struct XcdBarrier {
    unsigned* bar; unsigned x;
    volatile LAS unsigned* st;
};

__device__ __forceinline__ XcdBarrier xcd_barrier_post(unsigned* bar, volatile LAS unsigned* st) {
    XcdBarrier b; b.bar = bar; b.x = xb_xcc_id(); b.st = st;
    if (threadIdx.x == 0) (void)xb_add(&bar[XB_XCNT(b.x)], 1u);
    return b;
}
__device__ __forceinline__ void xcd_barrier_complete(unsigned* bar, unsigned x, unsigned& nloc, unsigned& nx) {
    const unsigned G = gridDim.x * gridDim.y * gridDim.z;
    unsigned sum, cnt, mine, sp = 0u;
    for (;;) {
        sum = 0u; cnt = 0u; mine = 0u;
#pragma unroll
        for (unsigned j = 0; j < 16; ++j) { const unsigned c = xb_ld(&bar[XB_XCNT(j)]); sum += c; cnt += (c > 0u) ? 1u : 0u; mine = (j == x) ? c : mine; }
        if (sum == G) break;
        __builtin_amdgcn_s_sleep(1);
        if ((++sp & 255u) == 0u) { if (xb_ld(&bar[XB_TMO])) break; if (sp > XB_SPIN_CAP) { atomicAdd(&bar[XB_TMO], 1u); break; } }
    }
    nloc = mine > 0u ? mine : 1u; nx = cnt > 0u ? cnt : 1u;
}

__device__ __forceinline__ void xcd_barrier(const XcdBarrier& b) {
    asm volatile("s_waitcnt vmcnt(0)" ::: "memory");
    __syncthreads();
    if (threadIdx.x == 0) {
        unsigned* bar = b.bar;
        __builtin_amdgcn_s_waitcnt(0);
        unsigned nloc = b.st[0], nx = b.st[1];
        if (nloc == 0u) { xcd_barrier_complete(bar, b.x, nloc, nx); b.st[0] = nloc; b.st[1] = nx; }
        const unsigned old = xb_add(&bar[XB_XSUB(b.x)], 1u);
        const unsigned gen = old / nloc;
        if (old + 1u == (gen + 1u) * nloc) {
            __builtin_amdgcn_fence(__ATOMIC_RELEASE, "agent");
            asm volatile("s_waitcnt vmcnt(0)" ::: "memory");
            const unsigned og = xb_add(&bar[XB_TOP], 1u);
            const unsigned tg = og / nx;
            if (og + 1u == (tg + 1u) * nx) xb_add(&bar[XB_TOPGEN], 1u);
            else XB_SPIN(xb_ld(&bar[XB_TOPGEN]) == tg, bar);
            __builtin_amdgcn_fence(__ATOMIC_ACQUIRE, "agent");
            xb_add(&bar[XB_XGEN(b.x)], 1u);
            asm volatile("s_waitcnt vmcnt(0)" ::: "memory");
        } else {
            XB_SPIN(xb_ld(&bar[XB_XGEN(b.x)]) == gen, bar);
            __builtin_amdgcn_fence(__ATOMIC_ACQUIRE, "agent");
            asm volatile("s_waitcnt vmcnt(0)" ::: "memory");
        }
    }
    __syncthreads();
}

struct Frame {
    LAS unsigned char* lds; volatile LAS unsigned* MISC; gu32* ctl; int tid, lane, wave, G;
    const float *x, *c; const int* pos; const float *w_ada, *b_ada, *n1g, *w_in, *lbl, *hgg, *w_hg, *qg, *kg, *sinks, *w_att, *w_out, *n2g, *w_r, *b_r, *w_up, *b_up, *w_dn, *b_dn;
    float* out; unsigned char* ws;
};
__device__ __forceinline__ int up_vrow(int c) { const int o = c >> 1; return 256 * (o >> 7) + 128 * (c & 1) + (o & 127); }

template <int MAP> __device__ __forceinline__ void p0_item(const float* W, int K, int N, bf16* WT, LAS float* scr, int kb, int nb, int lane) {
    const int k0 = 64 * kb, n0 = 64 * nb;
#pragma unroll 4
    for (int i = 0; i < 16; ++i) { const int kk = 4 * i + (lane >> 4); const f32x4 v = *(const GAS f32x4*)(W + (size_t)(k0 + kk) * N + n0 + 4 * (lane & 15));
        LAS float* d = scr + kk * 65 + 4 * (lane & 15); d[0] = v.x; d[1] = v.y; d[2] = v.z; d[3] = v.w; }
    LDS_WAIT(); asm volatile("" ::: "memory");
    const int c = lane >> 3;
#pragma unroll
    for (int j = 0; j < 8; ++j) { const int n = (lane & 7) + 8 * j; const LAS float* s = scr + (8 * c) * 65 + n;
        v4u o; o.x = pk2(s[0], s[65]); o.y = pk2(s[130], s[195]); o.z = pk2(s[260], s[325]); o.w = pk2(s[390], s[455]);
        const int col = n0 + n, row = MAP ? up_vrow(col) : col;
        *(GAS v4u*)(WT + (size_t)row * K + k0 + 8 * c) = o; }
    LDS_WAIT(); asm volatile("" ::: "memory");
}
__device__ __forceinline__ void p0_mod(Frame& F) {
    LAS float* cT = (LAS float*)F.lds;
    LAS float* red = (LAS float*)(F.lds + 69632);
    const int wg = blockIdx.x;
    for (int i = F.tid; i < 16 * 1024; i += 512) { const int b = i >> 10, k = i & 1023; cT[k * 16 + (k >> 4) * 4 + b] = silu_f(F.c[i]); }
    __syncthreads();
    const int ks = F.tid >> 3, c4 = F.tid & 7, col = wg * 32 + 4 * c4;
    float acc[16][4];
#pragma unroll
    for (int b = 0; b < 16; ++b)
#pragma unroll
        for (int j = 0; j < 4; ++j) acc[b][j] = 0.f;
#pragma unroll 4
    for (int r = 0; r < 16; ++r) {
        const int k = ks * 16 + r; const f32x4 w = *(const GAS f32x4*)(F.w_ada + (size_t)k * 6144 + col);
        const LAS f32x4* cp = (const LAS f32x4*)(cT + k * 16 + (k >> 4) * 4);
#pragma unroll
        for (int q = 0; q < 4; ++q) { const f32x4 cv = cp[q];
#pragma unroll
            for (int j = 0; j < 4; ++j) { acc[4 * q + j][0] += cv[j] * w.x; acc[4 * q + j][1] += cv[j] * w.y; acc[4 * q + j][2] += cv[j] * w.z; acc[4 * q + j][3] += cv[j] * w.w; } }
    }
#pragma unroll
    for (int b = 0; b < 16; ++b)
#pragma unroll
        for (int j = 0; j < 4; ++j) { float v = acc[b][j]; v += __shfl_xor(v, 8); v += __shfl_xor(v, 16); v += __shfl_xor(v, 32); acc[b][j] = v; }
    if (F.lane < 8) {
#pragma unroll
        for (int b = 0; b < 16; ++b)
#pragma unroll
            for (int j = 0; j < 4; ++j) red[(F.wave * 16 + b) * 32 + 4 * c4 + j] = acc[b][j];
    }
    __syncthreads();
    { const int b = F.tid >> 5, cc = F.tid & 31; float s = 0.f;
#pragma unroll
      for (int w = 0; w < 8; ++w) s += red[(w * 16 + b) * 32 + cc];
      ((float*)(F.ws + WS_MOD))[b * 6144 + wg * 32 + cc] = s + F.b_ada[wg * 32 + cc]; }
    __syncthreads();
}
__device__ __forceinline__ void p0_prologue(Frame& F) {
    if (blockIdx.x < 192) p0_mod(F);
    else {
        const int i = ((int)blockIdx.x - 192) * 512 + F.tid;
        float* BUPP = (float*)(F.ws + WS_BUPP);
#pragma unroll
        for (int q = 0; q < 2; ++q) { const int idx = i * 2 + q, e = idx >> 11, c = idx & 2047; BUPP[e * 2048 + up_vrow(c)] = F.b_up[idx]; }
        if (i < 512) ((float*)(F.ws + WS_LB))[i] = 1.f / (1.f + __expf(F.lbl[512 + i] - F.lbl[i]));
        if (i >= 1024 && i < 2048) ((bf16*)(F.ws + WS_H2))[(size_t)T * 1024 + (i - 1024)] = 0;
    }
    LAS float* scr = (LAS float*)(F.lds + F.wave * 16640);
    const int gw = (int)blockIdx.x * NWAVES + F.wave, NGW = F.G * NWAVES;
    constexpr int I_IN = 16 * 76, I_HG = 8 * 16, I_OUT = 16 * 16;
    constexpr int NITEMS = I_IN + 2 * I_HG + I_OUT;
    for (int it = gw; it < NITEMS; it += NGW) {
        int r = it;
        if (r < I_IN) { p0_item<0>(F.w_in, 1024, INW, (bf16*)(F.ws + WS_WIN), scr, r / 76, r % 76, F.lane); continue; } r -= I_IN;
        if (r < I_HG) { p0_item<0>(F.w_hg, 512, 1024, (bf16*)(F.ws + WS_WHG), scr, r / 16, r % 16, F.lane); continue; } r -= I_HG;
        if (r < I_HG) { p0_item<0>(F.w_att, 512, 1024, (bf16*)(F.ws + WS_WATT), scr, r / 16, r % 16, F.lane); continue; } r -= I_HG;
        p0_item<0>(F.w_out, 1024, 1024, (bf16*)(F.ws + WS_WOUT), scr, r / 16, r % 16, F.lane);
    }
}
__device__ __forceinline__ void moe_weight_copies(Frame& F, int gw, int NGW) {
    LAS float* scr = (LAS float*)(F.lds + F.wave * 16640);
    constexpr int I_UP = 16 * 32, I_DN = 16 * 16;
    for (int it = gw; it < 32 * (I_UP + I_DN); it += NGW) {
        int r = it;
        if (r < 32 * I_UP) { const int e = r / I_UP, q = r % I_UP; p0_item<1>(F.w_up + (size_t)e * 1024 * 2048, 1024, 2048, (bf16*)(F.ws + WS_WUP) + (size_t)e * 2048 * 1024, scr, q / 32, q % 32, F.lane); continue; } r -= 32 * I_UP;
        { const int e = r / I_DN, q = r % I_DN; p0_item<0>(F.w_dn + (size_t)e * 1024 * 1024, 1024, 1024, (bf16*)(F.ws + WS_WDN) + (size_t)e * 1024 * 1024, scr, q / 16, q % 16, F.lane); }
    }
}
__device__ __forceinline__ void normmod_row(const float* xrow, const float* gain, const float* sh, const float* sc, bf16* orow, int lane) {
    const GAS f32x4* xr = (const GAS f32x4*)xrow + lane;
    f32x4 v[4]; float s = 0.f;
#pragma unroll
    for (int j = 0; j < 4; ++j) { v[j] = xr[64 * j]; s += (v[j].x * v[j].x + v[j].y * v[j].y) + (v[j].z * v[j].z + v[j].w * v[j].w); }
    const float rstd = rsqrtf(wave_sum(s) * (1.f / DM) + EPS);
#pragma unroll
    for (int j = 0; j < 4; ++j) {
        const int c = 4 * lane + 256 * j;
        const f32x4 g = *(const GAS f32x4*)(gain + c), a = *(const GAS f32x4*)(sc + c), b = *(const GAS f32x4*)(sh + c);
        const unsigned lo = pk2(v[j].x * rstd * g.x * (1.f + a.x) + b.x, v[j].y * rstd * g.y * (1.f + a.y) + b.y), hi = pk2(v[j].z * rstd * g.z * (1.f + a.z) + b.z, v[j].w * rstd * g.w * (1.f + a.w) + b.w);
        *(GAS unsigned long long*)(orow + c) = (unsigned long long)lo | ((unsigned long long)hi << 32);
    }
}
__device__ __forceinline__ void p1_xn(Frame& F) {
    const int gw = (int)blockIdx.x * NWAVES + F.wave, NGW = F.G * NWAVES; const float* MOD = (const float*)(F.ws + WS_MOD); bf16* XN = (bf16*)(F.ws + WS_XN);
    for (int m = gw; m < T; m += NGW) { const float* mb = MOD + (size_t)(m / SEQ) * 6144; normmod_row(F.x + (size_t)m * DM, F.n1g, mb, mb + 1024, XN + (size_t)m * DM, F.lane); }
}

__device__ __forceinline__ float bflo(unsigned u) { return __uint_as_float(u << 16); }
__device__ __forceinline__ float bfhi(unsigned u) { return __uint_as_float(u & 0xffff0000u); }
struct EpiIn {
    static constexpr bool PERM = true; unsigned char* ws;
    __device__ __forceinline__ void operator()(const f32x4 (&acc)[2][2][4][2], const pg8::Unit& u, int wr, int wc, int fr, int fq) const {
        const int pn = u.pn, row0 = u.pm * 256 + wr * 64 + fr, cl = wc * 32 + 8 * fq;
        if (pn == 2 || pn == 3) {
            float* LF = (float*)(ws + WS_LF); const float* LB = (const float*)(ws + WS_LB); const int cb = (pn - 2) * 256;
#pragma unroll
            for (int bj = 0; bj < 2; ++bj) { const int col = cb + 128 * bj + cl; const f32x4 l0 = *(const f32x4*)(LB + col), l1 = *(const f32x4*)(LB + col + 4);
#pragma unroll
                for (int ai = 0; ai < 2; ++ai)
#pragma unroll
                    for (int m = 0; m < 4; ++m) { float* rp = LF + (size_t)(row0 + 128 * ai + 16 * m) * 512 + col; const f32x4 v0 = acc[ai][bj][m][0], v1 = acc[ai][bj][m][1]; f32x4 o0, o1;
#pragma unroll
                        for (int j = 0; j < 4; ++j) { o0[j] = __logf(l0[j] + (1.f - l0[j]) * fsigm(v0[j])); o1[j] = __logf(l1[j] + (1.f - l1[j]) * fsigm(v1[j])); }
                        *(f32x4*)rp = o0; *(f32x4*)(rp + 4) = o1; } }
            return;
        }
        bf16* dst; int ld = 512, cb, act = 0;
        if (pn < 2) { dst = (bf16*)(ws + WS_QH); cb = pn * 256; act = 1; }
        else if (pn < 6) { dst = (bf16*)(ws + WS_VH); cb = (pn - 4) * 256; }
        else if (pn < 8) { dst = (bf16*)(ws + WS_GH); cb = (pn - 6) * 256; act = 1; }
        else if (pn < 10) { dst = (bf16*)(ws + WS_AQ); cb = (pn - 8) * 256; }
        else if (pn == 10) { dst = (bf16*)(ws + WS_AKV); cb = 0; ld = 256; }
        else if (pn < 15) { dst = (bf16*)(ws + WS_SGH); cb = (pn - 11) * 256; ld = 1024; act = 2; }
        else { dst = (bf16*)(ws + WS_SGA); cb = (pn - 15) * 256; ld = 1024; act = 2; }
#pragma unroll
        for (int ai = 0; ai < 2; ++ai)
#pragma unroll
            for (int m = 0; m < 4; ++m) { bf16* rp = dst + (size_t)(row0 + 128 * ai + 16 * m) * ld + cb + cl;
#pragma unroll
                for (int bj = 0; bj < 2; ++bj) { f32x4 v0 = acc[ai][bj][m][0], v1 = acc[ai][bj][m][1];
                    if (act == 1) {
#pragma unroll
                        for (int j = 0; j < 4; ++j) { v0[j] *= fsigm(v0[j]); v1[j] *= fsigm(v1[j]); } }
                    else if (act == 2) {
#pragma unroll
                        for (int j = 0; j < 4; ++j) { v0[j] = fsigm(v0[j]); v1[j] = fsigm(v1[j]); } }
                    v4u w; w.x = pg8::cvt_pk_bf16(v0[0], v0[1]); w.y = pg8::cvt_pk_bf16(v0[2], v0[3]); w.z = pg8::cvt_pk_bf16(v1[0], v1[1]); w.w = pg8::cvt_pk_bf16(v1[2], v1[3]);
                    *(v4u*)(rp + 128 * bj) = w; } }
    }
};
template <bool SECOND> struct EpiMrg {
    static constexpr bool PERM = true; bf16* MRG; const bf16* SG;
    __device__ __forceinline__ void operator()(const f32x4 (&acc)[2][2][4][2], const pg8::Unit& u, int wr, int wc, int fr, int fq) const {
        const int row0 = u.pm * 256 + wr * 64 + fr, col0 = u.pn * 256 + wc * 32 + 8 * fq;
#pragma unroll
        for (int ai = 0; ai < 2; ++ai)
#pragma unroll
            for (int m = 0; m < 4; ++m) { const size_t off = (size_t)(row0 + 128 * ai + 16 * m) * 1024 + col0;
#pragma unroll
                for (int bj = 0; bj < 2; ++bj) { const v4u s = *(const v4u*)(SG + off + 128 * bj); const f32x4 v0 = acc[ai][bj][m][0], v1 = acc[ai][bj][m][1];
                    float o[8] = {bflo(s.x) * v0[0], bfhi(s.x) * v0[1], bflo(s.y) * v0[2], bfhi(s.y) * v0[3], bflo(s.z) * v1[0], bfhi(s.z) * v1[1], bflo(s.w) * v1[2], bfhi(s.w) * v1[3]};
                    if (SECOND) { const v4u p = *(const v4u*)(MRG + off + 128 * bj); o[0] += bflo(p.x); o[1] += bfhi(p.x); o[2] += bflo(p.y); o[3] += bfhi(p.y); o[4] += bflo(p.z); o[5] += bfhi(p.z); o[6] += bflo(p.w); o[7] += bfhi(p.w); }
                    v4u w; w.x = pg8::cvt_pk_bf16(o[0], o[1]); w.y = pg8::cvt_pk_bf16(o[2], o[3]); w.z = pg8::cvt_pk_bf16(o[4], o[5]); w.w = pg8::cvt_pk_bf16(o[6], o[7]);
                    *(v4u*)(MRG + off + 128 * bj) = w; } }
    }
};
struct EpiOut {
    static constexpr bool PERM = false; const float* x; const float* MOD; float* out;
    __device__ __forceinline__ void operator()(const f32x4 (&acc)[2][2][4][2], const pg8::Unit& u, int wr, int wc, int fr, int fq) const {
        const int row0 = u.pm * 256 + wr * 64 + fr, col0 = u.pn * 256 + wc * 32 + 4 * fq; const float* g1 = MOD + (size_t)(u.pm >> 3) * 6144 + 2048;
        f32x4 gv[2][2];
#pragma unroll
        for (int bj = 0; bj < 2; ++bj)
#pragma unroll
            for (int n = 0; n < 2; ++n) gv[bj][n] = *(const f32x4*)(g1 + col0 + 128 * bj + 16 * n);
#pragma unroll
        for (int ai = 0; ai < 2; ++ai)
#pragma unroll
            for (int m = 0; m < 4; ++m) { const size_t off = (size_t)(row0 + 128 * ai + 16 * m) * 1024 + col0;
#pragma unroll
                for (int bj = 0; bj < 2; ++bj)
#pragma unroll
                    for (int n = 0; n < 2; ++n) *(f32x4*)(out + off + 128 * bj + 16 * n) = *(const f32x4*)(x + off + 128 * bj + 16 * n) + gv[bj][n] * acc[ai][bj][m][n]; }
    }
};

typedef float f32x16 __attribute__((ext_vector_type(16)));
constexpr int RT_PITCH = 2064;
constexpr int R_TILE = 0, R_PART = 66048, R_LOG = 99840, R_REC = 104064, R_HIST = 112256;
__device__ __forceinline__ void p6_route(Frame& F) {
    const float* MOD = (const float*)(F.ws + WS_MOD); bf16* H2 = (bf16*)(F.ws + WS_H2);
    int* TOKL = (int*)(F.ws + WS_TOKL); float* GATL = (float*)(F.ws + WS_GATL); int* TOPI = (int*)(F.ws + WS_TOPI); float* TOPW = (float*)(F.ws + WS_TOPW);
    LAS float* PART = (LAS float*)(F.lds + R_PART); LAS float* LOG = (LAS float*)(F.lds + R_LOG);
    LAS int* REC_E = (LAS int*)(F.lds + R_REC); LAS int* REC_TK = REC_E + 512; LAS float* REC_G = (LAS float*)(REC_E + 1024); LAS int* REC_RK = REC_E + 1536;
    LAS int* HIST = (LAS int*)(F.lds + R_HIST); LAS int* BASE = HIST + 32;
    const int lane = F.lane, wave = F.wave, r32 = lane & 31, hi = lane >> 5;
    bf16x8 wB[8];
#pragma unroll
    for (int s = 0; s < 8; ++s) { const int k0 = 128 * wave + 16 * s + 8 * hi; unsigned p[4];
#pragma unroll
        for (int j = 0; j < 4; ++j) p[j] = pk2(F.w_r[(size_t)(k0 + 2 * j) * 32 + r32], F.w_r[(size_t)(k0 + 2 * j + 1) * 32 + r32]);
        v4u q = {p[0], p[1], p[2], p[3]}; wB[s] = __builtin_bit_cast(bf16x8, q); }
    if (F.tid < 32) HIST[F.tid] = 0;
    __syncthreads();
    for (int tb = (int)blockIdx.x * 4; tb < T / 32; tb += F.G * 4) {
        const int ntile = (T / 32 - tb) < 4 ? (T / 32 - tb) : 4;
        for (int tl = 0; tl < ntile; ++tl) {
            const int t0 = (tb + tl) * 32;
#pragma unroll 1
            for (int rr = 0; rr < 4; ++rr) {
                const int row = t0 + 4 * wave + rr; const float* mb = MOD + (size_t)(row / SEQ) * 6144;
                const GAS f32x4* xr = (const GAS f32x4*)(F.out + (size_t)row * DM) + lane;
                f32x4 v[4]; float s = 0.f;
#pragma unroll
                for (int j = 0; j < 4; ++j) { v[j] = xr[64 * j]; s += (v[j].x * v[j].x + v[j].y * v[j].y) + (v[j].z * v[j].z + v[j].w * v[j].w); }
                const float rstd = rsqrtf(wave_sum(s) * (1.f / DM) + EPS);
#pragma unroll
                for (int j = 0; j < 4; ++j) {
                    const int c = 4 * lane + 256 * j;
                    const f32x4 g = *(const GAS f32x4*)(F.n2g + c), a = *(const GAS f32x4*)(mb + 4096 + c), b = *(const GAS f32x4*)(mb + 3072 + c);
                    const unsigned lo = pk2(v[j].x * rstd * g.x * (1.f + a.x) + b.x, v[j].y * rstd * g.y * (1.f + a.y) + b.y), hh = pk2(v[j].z * rstd * g.z * (1.f + a.z) + b.z, v[j].w * rstd * g.w * (1.f + a.w) + b.w);
                    const unsigned long long pk = (unsigned long long)lo | ((unsigned long long)hh << 32);
                    *(GAS unsigned long long*)(H2 + (size_t)row * DM + c) = pk;
                    *(LAS unsigned long long*)(F.lds + R_TILE + (4 * wave + rr) * RT_PITCH + c * 2) = pk;
                }
            }
            __syncthreads();
            f32x16 acc = {};
#pragma unroll
            for (int s = 0; s < 8; ++s) { const bf16x8 af = *(const LAS bf16x8*)(F.lds + R_TILE + r32 * RT_PITCH + (128 * wave + 16 * s + 8 * hi) * 2);
                acc = __builtin_amdgcn_mfma_f32_32x32x16_bf16(af, wB[s], acc, 0, 0, 0); }
#pragma unroll
            for (int r = 0; r < 16; ++r) { const int tok = (r & 3) + 8 * (r >> 2) + 4 * hi; PART[(wave * 32 + tok) * 33 + r32] = acc[r]; }
            __syncthreads();
#pragma unroll
            for (int q = 0; q < 2; ++q) { const int idx = F.tid + 512 * q, tok = idx >> 5, e = idx & 31; float s = F.b_r[e];
#pragma unroll
                for (int w = 0; w < 8; ++w) s += PART[(w * 32 + tok) * 33 + e];
                LOG[tok * 33 + e] = s; }
            __syncthreads();
            if (F.tid < 32) {
                float lg[32];
#pragma unroll
                for (int e = 0; e < 32; ++e) lg[e] = LOG[F.tid * 33 + e];
                unsigned used = 0u; float tv[4]; int ti[4];
#pragma unroll
                for (int k = 0; k < 4; ++k) { float best = -INFINITY; int bi = 0;
#pragma unroll
                    for (int e = 0; e < 32; ++e) { const bool ok = !((used >> e) & 1u) && lg[e] > best; best = ok ? lg[e] : best; bi = ok ? e : bi; }
                    used |= 1u << bi; tv[k] = best; ti[k] = bi; }
                const float e1 = __expf(tv[1] - tv[0]), e2 = __expf(tv[2] - tv[0]), e3 = __expf(tv[3] - tv[0]), inv = 1.f / (1.f + e1 + e2 + e3);
                const float gw[4] = {inv, e1 * inv, e2 * inv, e3 * inv};
                const int t = t0 + F.tid;
#pragma unroll
                for (int k = 0; k < 4; ++k) { const int slot = tl * 128 + F.tid * 4 + k; REC_E[slot] = ti[k]; REC_TK[slot] = t * 4 + k; REC_G[slot] = gw[k];
                    REC_RK[slot] = __hip_atomic_fetch_add(&HIST[ti[k]], 1, __ATOMIC_RELAXED, __HIP_MEMORY_SCOPE_WORKGROUP);
                    TOPI[t * 4 + k] = ti[k]; TOPW[t * 4 + k] = gw[k]; }
            }
        }
        __syncthreads();
        if (F.tid < 32) BASE[F.tid] = (int)__hip_atomic_fetch_add(F.ctl + CW_CNT + F.tid, (unsigned)HIST[F.tid], RLX_AGENT);
        __syncthreads();
        for (int slot = F.tid; slot < ntile * 128; slot += 512) { const int e = REC_E[slot], p = BASE[e] + REC_RK[slot]; TOKL[(size_t)e * T + p] = REC_TK[slot]; GATL[(size_t)e * T + p] = REC_G[slot]; }
        __syncthreads();
        if (F.tid < 32) HIST[F.tid] = 0;
        __syncthreads();
    }
}

__device__ __forceinline__ void moe_tables(Frame& F) {
    if (F.tid < 32) F.MISC[64 + F.tid] = __hip_atomic_load(F.ctl + CW_CNT + F.tid, RLX_AGENT);
    __syncthreads();
    if (F.tid == 0) { unsigned s = 0; for (int e = 0; e < 32; ++e) { F.MISC[16 + e] = s; s += (F.MISC[64 + e] + 255u) >> 8; } F.MISC[48] = s; }
    __syncthreads();
}
template <int NC> struct MoeOrder {
    volatile LAS unsigned* MISC; int G, c;
    __device__ __forceinline__ bool next(int i, pg8::Unit& u) const {
        const int total = (int)MISC[48]; int rt, pl;
        if ((G & 7) == 0 && ((G >> 3) % NC) == 0) { const int rpr = G / NC, perx = rpr >> 3, xcd = c & 7, s = c >> 3; rt = i * rpr + xcd * perx + s / NC; pl = s % NC; }
        else { const int L = i * G + c; rt = L / NC; pl = L % NC; }
        if (rt >= total) return false;
        int e = 0;
        for (int q = 1; q < 32; ++q) e += ((int)MISC[16 + q] <= rt) ? 1 : 0;
        const int j = rt - (int)MISC[16 + e];
        u.pm = rt; u.pn = e * NC + pl; u.arow0 = e * T + 256 * j; u.nvalid = (int)MISC[64 + e] - 256 * j; return true;
    }
};
struct EpiUp {
    static constexpr bool PERM = true; bf16* ACT; const float* BUPP;
    __device__ __forceinline__ void operator()(const f32x4 (&acc)[2][2][4][2], const pg8::Unit& u, int wr, int wc, int fr, int fq) const {
        const int e = u.pn >> 3, pl = u.pn & 7, row0 = u.pm * 256 + wr * 64 + fr, cl = wc * 32 + 8 * fq;
        const float* bp = BUPP + e * 2048 + 256 * pl + cl;
        const f32x4 bg0 = *(const f32x4*)bp, bg1 = *(const f32x4*)(bp + 4), bl0 = *(const f32x4*)(bp + 128), bl1 = *(const f32x4*)(bp + 132);
#pragma unroll
        for (int ai = 0; ai < 2; ++ai)
#pragma unroll
            for (int m = 0; m < 4; ++m) { bf16* rp = ACT + (size_t)(row0 + 128 * ai + 16 * m) * 1024 + 128 * pl + cl;
                const f32x4 g0 = acc[ai][0][m][0] + bg0, g1 = acc[ai][0][m][1] + bg1, l0 = acc[ai][1][m][0] + bl0, l1 = acc[ai][1][m][1] + bl1; float o[8];
#pragma unroll
                for (int j = 0; j < 4; ++j) { const float ga = fminf(g0[j], 7.f), la = fminf(fmaxf(l0[j], -7.f), 7.f), gb = fminf(g1[j], 7.f), lb = fminf(fmaxf(l1[j], -7.f), 7.f);
                    o[j] = ga * fsigm(1.702f * ga) * (la + 1.f); o[4 + j] = gb * fsigm(1.702f * gb) * (lb + 1.f); }
                v4u w; w.x = pg8::cvt_pk_bf16(o[0], o[1]); w.y = pg8::cvt_pk_bf16(o[2], o[3]); w.z = pg8::cvt_pk_bf16(o[4], o[5]); w.w = pg8::cvt_pk_bf16(o[6], o[7]);
                *(v4u*)rp = w; }
    }
};
struct EpiDn {
    static constexpr bool PERM = true; bf16* Y; const float* b_dn; const int* TOKL; const float* GATL;
    __device__ __forceinline__ void operator()(const f32x4 (&acc)[2][2][4][2], const pg8::Unit& u, int wr, int wc, int fr, int fq) const {
        const int e = u.pn >> 2, pl = u.pn & 3, cl = wc * 32 + 8 * fq; const float* bp = b_dn + e * 1024 + 256 * pl + cl;
        f32x4 bv[2][2];
#pragma unroll
        for (int bj = 0; bj < 2; ++bj) { bv[bj][0] = *(const f32x4*)(bp + 128 * bj); bv[bj][1] = *(const f32x4*)(bp + 128 * bj + 4); }
#pragma unroll
        for (int ai = 0; ai < 2; ++ai)
#pragma unroll
            for (int m = 0; m < 4; ++m) { const int r = 128 * ai + 64 * wr + 16 * m + fr;
                if (r < u.nvalid) { const int slot = TOKL[u.arow0 + r]; const float gt = GATL[u.arow0 + r]; bf16* rp = Y + (size_t)slot * 1024 + 256 * pl + cl;
#pragma unroll
                    for (int bj = 0; bj < 2; ++bj) { const f32x4 v0 = (acc[ai][bj][m][0] + bv[bj][0]) * gt, v1 = (acc[ai][bj][m][1] + bv[bj][1]) * gt;
                        v4u w; w.x = pg8::cvt_pk_bf16(v0[0], v0[1]); w.y = pg8::cvt_pk_bf16(v0[2], v0[3]); w.z = pg8::cvt_pk_bf16(v1[0], v1[1]); w.w = pg8::cvt_pk_bf16(v1[2], v1[3]);
                        *(v4u*)(rp + 128 * bj) = w; } } }
    }
};
__device__ __forceinline__ void p9_final(Frame& F) {
    const int gw = (int)blockIdx.x * NWAVES + F.wave, NGW = F.G * NWAVES; const float* MOD = (const float*)(F.ws + WS_MOD); const bf16* Y = (const bf16*)(F.ws + WS_Y);
    for (int row = gw; row < T; row += NGW) {
        const float* g2 = MOD + (size_t)(row / SEQ) * 6144 + 5120;
#pragma unroll
        for (int j = 0; j < 4; ++j) {
            const int c = 4 * F.lane + 256 * j;
            f32x4 xv = *(const GAS f32x4*)(F.out + (size_t)row * DM + c); const f32x4 g = *(const GAS f32x4*)(g2 + c);
            float s0 = 0.f, s1 = 0.f, s2 = 0.f, s3 = 0.f;
#pragma unroll
            for (int k = 0; k < 4; ++k) { const unsigned long long y = *(const GAS unsigned long long*)(Y + ((size_t)row * 4 + k) * DM + c); const unsigned ylo = (unsigned)y, yhi = (unsigned)(y >> 32);
                s0 += bflo(ylo); s1 += bfhi(ylo); s2 += bflo(yhi); s3 += bfhi(yhi); }
            xv.x += g.x * s0; xv.y += g.y * s1; xv.z += g.z * s2; xv.w += g.w * s3;
            *(GAS f32x4*)(F.out + (size_t)row * DM + c) = xv;
        }
    }
}

typedef short v4i16_t __attribute__((ext_vector_type(4)));
namespace att {
constexpr int L_K = 0, L_V = 32768, L_OST = 65536, L_WSF = 98304;
constexpr float SC2 = 0.125f * 1.4426950408889634f;
__device__ __forceinline__ int crow(int r, int hi) { return (r & 3) + 8 * (r >> 2) + 4 * hi; }
__device__ __forceinline__ bf16x8 vtr2(LAS const unsigned char* p) {
    const v4i16_t lo = __builtin_amdgcn_ds_read_tr16_b64_v4i16((LAS v4i16_t*)p), hi = __builtin_amdgcn_ds_read_tr16_b64_v4i16((LAS v4i16_t*)(p + 512));
    return (bf16x8){lo[0], lo[1], lo[2], lo[3], hi[0], hi[1], hi[2], hi[3]};
}
__device__ __forceinline__ void unit(Frame& F, int b, int kvh, int qb) {
    const bf16* AQ = (const bf16*)(F.ws + WS_AQ); const bf16* AKV = (const bf16*)(F.ws + WS_AKV); bf16* HOAO = (bf16*)(F.ws + WS_HOAO);
    const int tid = F.tid, lane = F.lane, wave = F.wave, r32 = lane & 31, hi = lane >> 5;
    const int tq0 = b * SEQ + qb * 128, tk0 = tq0 - 128;
    {
        const int key = tid >> 1, half = tid & 1; const bool valid = (qb > 0) || (key >= 128); const int token = valid ? tk0 + key : tq0;
        const bf16* kp = AKV + (size_t)token * 256 + kvh * 64 + half * 32;
        v4u kr[4], vr[4];
#pragma unroll
        for (int q = 0; q < 4; ++q) { kr[q] = *(const GAS v4u*)(kp + 8 * q); vr[q] = *(const GAS v4u*)(kp + 128 + 8 * q); }
        float x[32]; float ss = 0.f;
#pragma unroll
        for (int q = 0; q < 4; ++q) { x[8 * q + 0] = bflo(kr[q].x); x[8 * q + 1] = bfhi(kr[q].x); x[8 * q + 2] = bflo(kr[q].y); x[8 * q + 3] = bfhi(kr[q].y);
            x[8 * q + 4] = bflo(kr[q].z); x[8 * q + 5] = bfhi(kr[q].z); x[8 * q + 6] = bflo(kr[q].w); x[8 * q + 7] = bfhi(kr[q].w); }
#pragma unroll
        for (int d = 0; d < 32; ++d) ss += x[d] * x[d];
        ss += __shfl_xor(ss, 1);
        const float rstd = valid ? rsqrtf(ss * (1.f / 64.f) + EPS) : 0.f;
#pragma unroll
        for (int q = 0; q < 8; ++q) { const f32x4 g = *(const GAS f32x4*)(F.kg + half * 32 + 4 * q); x[4 * q] *= rstd * g.x; x[4 * q + 1] *= rstd * g.y; x[4 * q + 2] *= rstd * g.z; x[4 * q + 3] *= rstd * g.w; }
        if (half == 0) { const int p = F.pos[token];
#pragma unroll
            for (int i = 0; i < 8; ++i) { float cs, sn; rope_cs(p, i, cs, sn); const float x1 = x[i], x2 = x[i + 8]; x[i] = x1 * cs - x2 * sn; x[i + 8] = x2 * cs + x1 * sn; } }
#pragma unroll
        for (int q = 0; q < 4; ++q) { v4u w; w.x = pk2(x[8 * q], x[8 * q + 1]); w.y = pk2(x[8 * q + 2], x[8 * q + 3]); w.z = pk2(x[8 * q + 4], x[8 * q + 5]); w.w = pk2(x[8 * q + 6], x[8 * q + 7]);
            *(LAS v4u*)(F.lds + L_K + (half * 4 + q) * 4096 + key * 16) = w; }
        const int kk = key & 63; LAS unsigned char* vd = F.lds + L_V + (key >> 6) * 8192 + half * 4096 + (kk >> 4) * 1024 + (kk & 15) * 64;
#pragma unroll
        for (int q = 0; q < 4; ++q) { v4u w = vr[q]; if (!valid) w = (v4u){0u, 0u, 0u, 0u}; *(LAS v4u*)(vd + 16 * q) = w; }
    }
    __syncthreads();
    LAS float* wsf = (LAS float*)(F.lds + L_WSF) + wave * 64;
    LAS bf16* stg = (LAS bf16*)(F.lds + L_OST + wave * 4096);
    LAS const unsigned char* vbase = F.lds + L_V + ((lane >> 4) & 1) * 32 + (lane & 3) * 8 + (4 * hi + ((lane & 15) >> 2)) * 64;
#pragma unroll 1
    for (int sbi = 0; sbi < 2; ++sbi) {
        const int sb = wave * 2 + sbi, g = sb >> 2, r0 = (sb & 3) * 32, hq = kvh * 4 + g, tq = tq0 + r0 + r32;
        bf16x8 qr[4];
        {
            const bf16* qp = AQ + (size_t)tq * 512 + hq * 64 + 8 * hi; float x[4][8]; float ss = 0.f;
#pragma unroll
            for (int d0 = 0; d0 < 4; ++d0) { const v4u r = *(const GAS v4u*)(qp + 16 * d0); x[d0][0] = bflo(r.x); x[d0][1] = bfhi(r.x); x[d0][2] = bflo(r.y); x[d0][3] = bfhi(r.y); x[d0][4] = bflo(r.z); x[d0][5] = bfhi(r.z); x[d0][6] = bflo(r.w); x[d0][7] = bfhi(r.w); }
#pragma unroll
            for (int d0 = 0; d0 < 4; ++d0)
#pragma unroll
                for (int j = 0; j < 8; ++j) ss += x[d0][j] * x[d0][j];
            ss += __shfl_xor(ss, 32);
            const float rs = rsqrtf(ss * (1.f / 64.f) + EPS) * SC2;
#pragma unroll
            for (int d0 = 0; d0 < 4; ++d0) { const f32x4 g0 = *(const GAS f32x4*)(F.qg + 16 * d0 + 8 * hi), g1 = *(const GAS f32x4*)(F.qg + 16 * d0 + 8 * hi + 4);
                x[d0][0] *= rs * g0.x; x[d0][1] *= rs * g0.y; x[d0][2] *= rs * g0.z; x[d0][3] *= rs * g0.w; x[d0][4] *= rs * g1.x; x[d0][5] *= rs * g1.y; x[d0][6] *= rs * g1.z; x[d0][7] *= rs * g1.w; }
            const int p = F.pos[tq];
#pragma unroll
            for (int j = 0; j < 8; ++j) { float cs, sn; rope_cs(p, j, cs, sn); const float mine = x[0][j], oth = __shfl_xor(mine, 32); x[0][j] = mine * cs + (hi ? oth : -oth) * sn; }
#pragma unroll
            for (int d0 = 0; d0 < 4; ++d0) { v4u w; w.x = pk2(x[d0][0], x[d0][1]); w.y = pk2(x[d0][2], x[d0][3]); w.z = pk2(x[d0][4], x[d0][5]); w.w = pk2(x[d0][6], x[d0][7]); qr[d0] = __builtin_bit_cast(bf16x8, w); }
        }
        const int kt0 = r0 >> 5, qi = r0 + r32;
        f32x16 p[5];
#pragma unroll
        for (int t = 0; t < 5; ++t) {
            f32x16 a = {};
#pragma unroll
            for (int d0 = 0; d0 < 4; ++d0) { const bf16x8 kf = *(const LAS bf16x8*)(F.lds + L_K + (2 * d0 + hi) * 4096 + (32 * (kt0 + t) + r32) * 16); a = __builtin_amdgcn_mfma_f32_32x32x16_bf16(kf, qr[d0], a, 0, 0, 0); }
#pragma unroll
            for (int r = 0; r < 16; ++r) { const int kk = 32 * (kt0 + t) + crow(r, hi); const bool ok = (kk > qi) && (kk <= qi + 128) && (qb > 0 || kk >= 128); a[r] = ok ? a[r] : -INFINITY; }
            p[t] = a;
        }
        const float sink2 = F.sinks[hq] * 1.4426950408889634f;
        float m = sink2;
#pragma unroll
        for (int t = 0; t < 5; ++t)
#pragma unroll
            for (int r = 0; r < 16; ++r) m = fmaxf(m, p[t][r]);
        m = fmaxf(m, __shfl_xor(m, 32));
        float l = 0.f;
#pragma unroll
        for (int t = 0; t < 5; ++t)
#pragma unroll
            for (int r = 0; r < 16; ++r) { const float e = __builtin_amdgcn_exp2f(p[t][r] - m); p[t][r] = e; l += e; }
        l += __shfl_xor(l, 32);
        l += __builtin_amdgcn_exp2f(sink2 - m);
        f32x16 o[2]; o[0] = (f32x16){}; o[1] = (f32x16){};
#pragma unroll
        for (int t = 0; t < 5; ++t) {
            const int kt = kt0 + t; LAS const unsigned char* vs = vbase + (kt >> 1) * 8192 + (2 * (kt & 1)) * 1024;
#pragma unroll
            for (int s = 0; s < 2; ++s) {
                v4u w; w.x = pk2(p[t][8 * s], p[t][8 * s + 1]); w.y = pk2(p[t][8 * s + 2], p[t][8 * s + 3]); w.z = pk2(p[t][8 * s + 4], p[t][8 * s + 5]); w.w = pk2(p[t][8 * s + 6], p[t][8 * s + 7]);
                const bf16x8 pa = __builtin_bit_cast(bf16x8, w);
#pragma unroll
                for (int d0 = 0; d0 < 2; ++d0) { const bf16x8 vf = vtr2(vs + d0 * 4096 + s * 1024); o[d0] = __builtin_amdgcn_mfma_f32_32x32x16_bf16(pa, vf, o[d0], 0, 0, 0); }
            }
        }
        if (hi == 0) wsf[r32] = l;
        LDS_WAIT(); asm volatile("" ::: "memory");
#pragma unroll
        for (int r = 0; r < 16; ++r) { const int orow = crow(r, hi); const float rl = __builtin_amdgcn_rcpf(wsf[orow]);
#pragma unroll
            for (int d0 = 0; d0 < 2; ++d0) stg[orow * 64 + d0 * 32 + r32] = f2bf(o[d0][r] * rl); }
        LDS_WAIT(); asm volatile("" ::: "memory");
#pragma unroll
        for (int i = 0; i < 4; ++i) { const int row = i * 8 + (lane >> 3), ch = lane & 7; const v4u v = *(const LAS v4u*)(stg + row * 64 + ch * 8);
            *(GAS v4u*)(HOAO + (size_t)(tq0 + r0 + row) * 1024 + 512 + hq * 64 + ch * 8) = v; }
        LDS_WAIT(); asm volatile("" ::: "memory");
    }
    __syncthreads();
}
}

namespace hg {
typedef float f32x2v __attribute__((ext_vector_type(2)));
constexpr int PK = 272, PJ = 144;
constexpr int L_QE = 0, L_KE = 17408, L_KDT = 34816, L_VT = 53248, L_P = 71680, L_ST = 80896, L_OST = 115712, L_SEGP = 149504, L_DK = 153600;
constexpr int OP = 132;
__device__ __forceinline__ void run(Frame& F, int b, int h) {
    const bf16* QH = (const bf16*)(F.ws + WS_QH); const float* LF = (const float*)(F.ws + WS_LF); const bf16* VH = (const bf16*)(F.ws + WS_VH); const bf16* GH = (const bf16*)(F.ws + WS_GH);
    bf16* HOAO = (bf16*)(F.ws + WS_HOAO);
    const int tid = F.tid, lane = F.lane, wave = F.wave, r32 = lane & 31, hi = lane >> 5;
    LAS unsigned char* L = F.lds;
    LAS float* SEGP = (LAS float*)(L + L_SEGP); LAS float* DK = (LAS float*)(L + L_DK); LAS float* OST = (LAS float*)(L + L_OST);
    for (int i = tid; i < (L_OST - L_P) / 16; i += 512) *(LAS v4u*)(L + L_P + i * 16) = (v4u){0u, 0u, 0u, 0u};
    f32x16 st[2]; st[0] = (f32x16){}; st[1] = (f32x16){};
    const int kp2 = 2 * lane;
    const size_t rowb = (size_t)b * SEQ;
    float fv[8][2]; unsigned qv[8], vv[8];
    const int oi = tid >> 3, os = tid & 7;
    float gn[16];
#pragma unroll
    for (int q = 0; q < 4; ++q) { const f32x4 g = *(const GAS f32x4*)(F.hgg + 16 * os + 4 * q); gn[4 * q] = g.x; gn[4 * q + 1] = g.y; gn[4 * q + 2] = g.z; gn[4 * q + 3] = g.w; }
#define HG_LOAD(c) do { _Pragma("unroll") for (int jj = 0; jj < 8; ++jj) { const size_t row = rowb + (size_t)(c) * 64 + 8 * wave + jj; \
        const f32x2v lf = *(const GAS f32x2v*)(LF + row * 512 + h * 128 + kp2); fv[jj][0] = lf.x; fv[jj][1] = lf.y; \
        qv[jj] = *(const GAS unsigned*)(QH + row * 512 + h * 128 + kp2); vv[jj] = *(const GAS unsigned*)(VH + row * 512 + h * 128 + kp2); } } while (0)
#define HG_A1() do { float p0 = 1.f, p1 = 1.f; _Pragma("unroll") for (int jj = 0; jj < 8; ++jj) { fv[jj][0] = __expf(fv[jj][0]); fv[jj][1] = __expf(fv[jj][1]); p0 *= fv[jj][0]; p1 *= fv[jj][1]; } \
        *(LAS f32x2v*)(SEGP + wave * 128 + kp2) = (f32x2v){p0, p1}; } while (0)
    HG_LOAD(0); HG_A1();
    __syncthreads();
#pragma unroll 1
    for (int c = 0; c < SEQ / 64; ++c) {
        {
            float pre0 = 1.f, pre1 = 1.f, all0 = 1.f, all1 = 1.f;
#pragma unroll
            for (int s = 0; s < 8; ++s) { const f32x2v sp = *(const LAS f32x2v*)(SEGP + s * 128 + kp2); all0 *= sp.x; all1 *= sp.y; if (s < wave) { pre0 *= sp.x; pre1 *= sp.y; } }
            if (wave == 0) *(LAS f32x2v*)(DK + kp2) = (f32x2v){all0, all1};
            float e0 = pre0, e1 = pre1; unsigned kd0[4], kd1[4], vt0[4], vt1[4]; float kdp0 = 0.f, kdp1 = 0.f;
#pragma unroll
            for (int jj = 0; jj < 8; ++jj) {
                e0 *= fv[jj][0]; e1 *= fv[jj][1];
                const float k0 = 1.f - fv[jj][0], k1 = 1.f - fv[jj][1];
                const float ke0 = k0 * __builtin_amdgcn_rcpf(e0), ke1 = k1 * __builtin_amdgcn_rcpf(e1);
                const int j = 8 * wave + jj;
                *(LAS unsigned*)(L + L_QE + j * PK + kp2 * 2) = pk2(bflo(qv[jj]) * e0, bfhi(qv[jj]) * e1);
                *(LAS unsigned*)(L + L_KE + j * PK + kp2 * 2) = pk2(ke0, ke1);
                const float d0 = ke0 * all0, d1 = ke1 * all1;
                if (jj & 1) { kd0[jj >> 1] = pk2(kdp0, d0); kd1[jj >> 1] = pk2(kdp1, d1); vt0[jj >> 1] = (vv[jj - 1] & 0xffffu) | (vv[jj] << 16); vt1[jj >> 1] = (vv[jj - 1] >> 16) | (vv[jj] & 0xffff0000u); }
                else { kdp0 = d0; kdp1 = d1; }
            }
            *(LAS v4u*)(L + L_KDT + kp2 * PJ + 16 * wave) = (v4u){kd0[0], kd0[1], kd0[2], kd0[3]};
            *(LAS v4u*)(L + L_KDT + (kp2 + 1) * PJ + 16 * wave) = (v4u){kd1[0], kd1[1], kd1[2], kd1[3]};
            *(LAS v4u*)(L + L_VT + kp2 * PJ + 16 * wave) = (v4u){vt0[0], vt0[1], vt0[2], vt0[3]};
            *(LAS v4u*)(L + L_VT + (kp2 + 1) * PJ + 16 * wave) = (v4u){vt1[0], vt1[1], vt1[2], vt1[3]};
        }
        if (c + 1 < SEQ / 64) HG_LOAD(c + 1);
        const size_t orow = rowb + (size_t)c * 64 + oi;
        const v4u gg0 = *(const GAS v4u*)(GH + orow * 512 + h * 128 + 16 * os), gg1 = *(const GAS v4u*)(GH + orow * 512 + h * 128 + 16 * os + 8);
        __syncthreads();
        for (int tl = wave; tl < 10; tl += 8) {
            int ib = 0, rem = tl; while (rem > ib) { rem -= ib + 1; ++ib; } const int jb = rem;
            typedef float f32x4v __attribute__((ext_vector_type(4)));
            f32x4v a = {0.f, 0.f, 0.f, 0.f}; const int l15 = lane & 15, l4 = lane >> 4;
#pragma unroll
            for (int s = 0; s < 4; ++s) { const bf16x8 af = *(const LAS bf16x8*)(L + L_QE + (16 * ib + l15) * PK + (32 * s + 8 * l4) * 2), bfr = *(const LAS bf16x8*)(L + L_KE + (16 * jb + l15) * PK + (32 * s + 8 * l4) * 2);
                a = __builtin_amdgcn_mfma_f32_16x16x32_bf16(af, bfr, a, 0, 0, 0); }
#pragma unroll
            for (int r = 0; r < 4; ++r) { const int i = 16 * ib + 4 * l4 + r, j = 16 * jb + l15; const float v = (j <= i) ? a[r] : 0.f; *(LAS bf16*)(L + L_P + i * PJ + j * 2) = f2bf(v); }
        }
        const int ib = wave >> 2, vb = wave & 3;
        f32x16 o = {};
#pragma unroll
        for (int s = 0; s < 8; ++s) { const bf16x8 af = *(const LAS bf16x8*)(L + L_QE + (32 * ib + r32) * PK + (16 * s + 8 * hi) * 2), bfr = *(const LAS bf16x8*)(L + L_ST + (32 * vb + r32) * PK + (16 * s + 8 * hi) * 2);
            o = __builtin_amdgcn_mfma_f32_32x32x16_bf16(af, bfr, o, 0, 0, 0); }
#pragma unroll
        for (int q = 0; q < 2; ++q) { const int kb = 2 * (wave >> 2) + q; const float dk = DK[32 * kb + r32];
#pragma unroll
            for (int r = 0; r < 16; ++r) st[q][r] *= dk;
#pragma unroll
            for (int s = 0; s < 4; ++s) { const bf16x8 af = *(const LAS bf16x8*)(L + L_VT + (32 * vb + r32) * PJ + (16 * s + 8 * hi) * 2), bfr = *(const LAS bf16x8*)(L + L_KDT + (32 * kb + r32) * PJ + (16 * s + 8 * hi) * 2);
                st[q] = __builtin_amdgcn_mfma_f32_32x32x16_bf16(af, bfr, st[q], 0, 0, 0); } }
        __syncthreads();
#pragma unroll
        for (int s = 0; s < 4; ++s) { const bf16x8 af = *(const LAS bf16x8*)(L + L_P + (32 * ib + r32) * PJ + (16 * s + 8 * hi) * 2), bfr = *(const LAS bf16x8*)(L + L_VT + (32 * vb + r32) * PJ + (16 * s + 8 * hi) * 2);
            o = __builtin_amdgcn_mfma_f32_32x32x16_bf16(af, bfr, o, 0, 0, 0); }
#pragma unroll
        for (int r = 0; r < 16; ++r) OST[(32 * ib + att::crow(r, hi)) * OP + 32 * vb + r32] = o[r];
#pragma unroll
        for (int q = 0; q < 2; ++q) { const int kb = 2 * (wave >> 2) + q;
#pragma unroll
            for (int r = 0; r < 16; ++r) *(LAS bf16*)(L + L_ST + (32 * vb + att::crow(r, hi)) * PK + (32 * kb + r32) * 2) = f2bf(st[q][r]); }
        if (c + 1 < SEQ / 64) HG_A1();
        __syncthreads();
        {
            float ov[16]; float ss = 0.f;
#pragma unroll
            for (int q = 0; q < 4; ++q) { const f32x4 t = *(const LAS f32x4*)(OST + oi * OP + 16 * os + 4 * q); ov[4 * q] = t.x; ov[4 * q + 1] = t.y; ov[4 * q + 2] = t.z; ov[4 * q + 3] = t.w; ss += (t.x * t.x + t.y * t.y) + (t.z * t.z + t.w * t.w); }
            ss += __shfl_xor(ss, 1); ss += __shfl_xor(ss, 2); ss += __shfl_xor(ss, 4);
            const float rstd = rsqrtf(ss * (1.f / 128.f) + EPS);
            const unsigned gw[8] = {gg0.x, gg0.y, gg0.z, gg0.w, gg1.x, gg1.y, gg1.z, gg1.w}; unsigned ow[8];
#pragma unroll
            for (int q = 0; q < 8; ++q) ow[q] = pk2(ov[2 * q] * rstd * gn[2 * q] * bflo(gw[q]), ov[2 * q + 1] * rstd * gn[2 * q + 1] * bfhi(gw[q]));
            bf16* op = HOAO + orow * 1024 + h * 128 + 16 * os;
            *(GAS v4u*)op = (v4u){ow[0], ow[1], ow[2], ow[3]}; *(GAS v4u*)(op + 8) = (v4u){ow[4], ow[5], ow[6], ow[7]};
        }
    }
#undef HG_LOAD
#undef HG_A1
    __syncthreads();
}
}
__device__ __forceinline__ void p3_mixers(Frame& F, int sub) {
    constexpr int NHG = 64;
    if ((int)blockIdx.x < NHG) { if (sub & 1) { for (int u = blockIdx.x; u < BATCH * 4; u += NHG) hg::run(F, u >> 2, u & 3); } }
    else { const int na = F.G - NHG; if (sub & 2) { for (int u = (int)blockIdx.x - NHG; u < BATCH * 2 * 16; u += na) att::unit(F, u >> 5, (u >> 4) & 1, u & 15); }
        moe_weight_copies(F, ((int)blockIdx.x - NHG) * NWAVES + F.wave, na * NWAVES); }
}

struct Args { const void* in[22]; float* out; unsigned char* ws; int ph_lo, ph_hi, one, sub; };
__global__ void __launch_bounds__(NWAVES * 64, 2) skel_fwd(Args args) {
    extern __shared__ __attribute__((aligned(16))) unsigned char lds[];
    Frame F;
    F.lds = (LAS unsigned char*)lds; F.MISC = (volatile LAS unsigned*)(F.lds + MISC_OFF);
    F.tid = threadIdx.x; F.lane = F.tid & 63; F.wave = __builtin_amdgcn_readfirstlane(F.tid >> 6); F.G = gridDim.x;
    F.x = (const float*)args.in[0]; F.c = (const float*)args.in[1]; F.pos = (const int*)args.in[2]; F.w_ada = (const float*)args.in[3]; F.b_ada = (const float*)args.in[4];
    F.n1g = (const float*)args.in[5]; F.w_in = (const float*)args.in[6]; F.lbl = (const float*)args.in[7]; F.hgg = (const float*)args.in[8]; F.w_hg = (const float*)args.in[9];
    F.qg = (const float*)args.in[10]; F.kg = (const float*)args.in[11]; F.sinks = (const float*)args.in[12]; F.w_att = (const float*)args.in[13]; F.w_out = (const float*)args.in[14];
    F.n2g = (const float*)args.in[15]; F.w_r = (const float*)args.in[16]; F.b_r = (const float*)args.in[17]; F.w_up = (const float*)args.in[18]; F.b_up = (const float*)args.in[19];
    F.w_dn = (const float*)args.in[20]; F.b_dn = (const float*)args.in[21]; F.out = args.out; F.ws = args.ws; F.ctl = (gu32*)(args.ws + WS_CTL);
    for (int u = F.tid; u < (LDS_BYTES - LDSCTL_OFF) / 4; u += NWAVES * 64) ((LAS unsigned*)(F.lds + LDSCTL_OFF))[u] = 0u;
    __syncthreads();
    XcdBarrier bar; bar.bar = (unsigned*)(F.ctl + CW_BAR); bar.x = 0; bar.st = nullptr;
    if (args.one) bar = xcd_barrier_post((unsigned*)(F.ctl + CW_BAR), F.MISC + 8);
    const int lo = args.ph_lo, hi = args.ph_hi;
#define IN(k) (lo <= (k) && (k) < hi)
#ifndef PROBE_MASK
#define PROBE_MASK 0
#endif
#define REP(k) for (int rep_ = 0; rep_ < (((PROBE_MASK >> (k)) & 1) ? 2 : 1); ++rep_)
#define RSEAM() do { if (rep_ == 0 && ((PROBE_MASK) != 0)) { if (args.one) xcd_barrier(bar); } } while (0)
#define SEAM(k) do { if (IN(k) && IN((k) + 1)) xcd_barrier(bar); } while (0)
    unsigned char* ws = args.ws;
    if (IN(0)) { REP(0) { p0_prologue(F); if ((PROBE_MASK >> 0) & 1) RSEAM(); } SEAM(0); }
    if (IN(1)) { REP(1) { p1_xn(F); if ((PROBE_MASK >> 1) & 1) RSEAM(); } SEAM(1); }
    if (IN(2)) REP(2) {
        pg8::Gemm g{(const bf16*)(ws + WS_XN), (const bf16*)(ws + WS_WIN), T, INW, 1024, nullptr, 0, 1024}; pg8::StaticOrder S; S.init(T, INW, F.G, (int)blockIdx.x);
        EpiIn E{ws}; pg8::gemm_phase<EpiIn, pg8::StaticOrder, true, false>(F.lds, g, S, E); if ((PROBE_MASK >> 2) & 1) RSEAM();
    }
    SEAM(2);
    if (IN(3)) { REP(3) { p3_mixers(F, args.sub); if ((PROBE_MASK >> 3) & 1) RSEAM(); } SEAM(3); }
    if (IN(4)) REP(4) {
        pg8::StaticOrder S; S.init(T, 1024, F.G, (int)blockIdx.x);
        { pg8::Gemm g{(const bf16*)(ws + WS_HOAO), (const bf16*)(ws + WS_WHG), T, 1024, 512, nullptr, 0, 1024}; EpiMrg<false> E{(bf16*)(ws + WS_MRG), (const bf16*)(ws + WS_SGH)};
          pg8::gemm_phase<EpiMrg<false>, pg8::StaticOrder, true, false>(F.lds, g, S, E); }
        { pg8::Gemm g{(const bf16*)(ws + WS_HOAO) + 512, (const bf16*)(ws + WS_WATT), T, 1024, 512, nullptr, 0, 1024}; EpiMrg<true> E{(bf16*)(ws + WS_MRG), (const bf16*)(ws + WS_SGA)};
          pg8::gemm_phase<EpiMrg<true>, pg8::StaticOrder, true, false>(F.lds, g, S, E); }
        if ((PROBE_MASK >> 4) & 1) RSEAM();
    }
    SEAM(4);
    if (IN(5)) REP(5) {
        pg8::Gemm g{(const bf16*)(ws + WS_MRG), (const bf16*)(ws + WS_WOUT), T, 1024, 1024, nullptr, 0, 1024}; pg8::StaticOrder S; S.init(T, 1024, F.G, (int)blockIdx.x);
        EpiOut E{F.x, (const float*)(ws + WS_MOD), F.out}; pg8::gemm_phase<EpiOut, pg8::StaticOrder, true, false>(F.lds, g, S, E); if ((PROBE_MASK >> 5) & 1) RSEAM();
    }
    SEAM(5);
    if (IN(6)) { p6_route(F); SEAM(6); }
    if (IN(7)) REP(7) {
        moe_tables(F);
        pg8::Gemm g{(const bf16*)(ws + WS_H2), (const bf16*)(ws + WS_WUP), T, NEXP * 2048, 1024, (const int*)(ws + WS_TOKL), T, 1024}; MoeOrder<8> S{F.MISC, F.G, (int)blockIdx.x};
        EpiUp E{(bf16*)(ws + WS_ACT), (const float*)(ws + WS_BUPP)}; pg8::gemm_phase<EpiUp, MoeOrder<8>, true, true>(F.lds, g, S, E); if ((PROBE_MASK >> 7) & 1) RSEAM();
    }
    SEAM(7);
    if (IN(8)) REP(8) {
        moe_tables(F);
        pg8::Gemm g{(const bf16*)(ws + WS_ACT), (const bf16*)(ws + WS_WDN), T, NEXP * 1024, 1024, nullptr, 0, 1024}; MoeOrder<4> S{F.MISC, F.G, (int)blockIdx.x};
        EpiDn E{(bf16*)(ws + WS_Y), F.b_dn, (const int*)(ws + WS_TOKL), (const float*)(ws + WS_GATL)}; pg8::gemm_phase<EpiDn, MoeOrder<4>, true, false>(F.lds, g, S, E); if ((PROBE_MASK >> 8) & 1) RSEAM();
    }
    SEAM(8);
    if (IN(9)) { p9_final(F); }
#undef IN
#undef SEAM
}

#ifndef DEV_MASK
#define DEV_MASK 0x3ff
#ifndef DEV_SUB
#define DEV_SUB 3
#endif
#endif
extern "C" void kernel_launch(void* const* d_in, const int* in_sizes, int n_in, void* d_out, int out_size, void* d_ws, size_t ws_size, hipStream_t stream) {
    static int grid = 0;
    if (grid == 0) {
        if (n_in != 22 || ws_size < WS_END || out_size != T * DM) { fprintf(stderr, "kernel_launch: unexpected shapes n_in %d ws %zu out %d\n", n_in, ws_size, out_size); grid = -1; return; }
        int dev = 0, cus = 0;
        if (hipGetDevice(&dev) != hipSuccess || hipDeviceGetAttribute(&cus, hipDeviceAttributeMultiprocessorCount, dev) != hipSuccess) { grid = -1; return; }
        if (hipFuncSetAttribute((const void*)skel_fwd, hipFuncAttributeMaxDynamicSharedMemorySize, LDS_BYTES) != hipSuccess) { fprintf(stderr, "kernel_launch: hipFuncSetAttribute failed\n"); grid = -1; return; }
        int per_cu = 0;
        if (hipOccupancyMaxActiveBlocksPerMultiprocessor(&per_cu, (const void*)skel_fwd, NWAVES * 64, LDS_BYTES) != hipSuccess || per_cu < 1) { fprintf(stderr, "kernel_launch: occupancy query says %d workgroups per CU; nothing launched\n", per_cu); grid = -1; return; }
        (void)hipGetLastError();
        grid = cus;
    }
    if (grid < 0) return;
    unsigned char* ws = (unsigned char*)d_ws; float* out = (float*)d_out;
#if DEV_ORACLE
    const float* x = (const float*)d_in[0]; const int* pos = (const int*)d_in[2];
    const float* hgg = (const float*)d_in[8]; const float* qg = (const float*)d_in[10]; const float* kg = (const float*)d_in[11];
    const float* sinks = (const float*)d_in[12]; const float* n2g = (const float*)d_in[15]; const float* w_r = (const float*)d_in[16]; const float* b_r = (const float*)d_in[17];
    const float* w_up = (const float*)d_in[18]; const float* b_up = (const float*)d_in[19]; const float* w_dn = (const float*)d_in[20]; const float* b_dn = (const float*)d_in[21];
    float* MOD = (float*)(ws + WS_MOD); float* LB = (float*)(ws + WS_LB);
    bf16* XN = (bf16*)(ws + WS_XN); bf16* QH = (bf16*)(ws + WS_QH); float* LF = (float*)(ws + WS_LF); bf16* VH = (bf16*)(ws + WS_VH); bf16* GH = (bf16*)(ws + WS_GH);
    bf16* AQ = (bf16*)(ws + WS_AQ); bf16* AKV = (bf16*)(ws + WS_AKV); bf16* SGH = (bf16*)(ws + WS_SGH); bf16* SGA = (bf16*)(ws + WS_SGA);
    bf16* HOAO = (bf16*)(ws + WS_HOAO); bf16* MRG = (bf16*)(ws + WS_MRG); bf16* H2 = (bf16*)(ws + WS_H2); bf16* Y = (bf16*)(ws + WS_Y);
    int* TOPI = (int*)(ws + WS_TOPI); float* TOPW = (float*)(ws + WS_TOPW);
    float* OTMP = (float*)(ws + WS_OTMP); float* QN = (float*)(ws + WS_QN); float* KN = (float*)(ws + WS_KN);
#endif
    (void)hipMemsetAsync(ws + WS_CTL, 0, CTL_ZERO_BYTES, stream);
    Args a{}; for (int i = 0; i < 22; ++i) a.in[i] = d_in[i];
    a.out = out; a.ws = ws; a.one = 0;
#if DEV_ORACLE
#ifndef DEV_REP
#define DEV_REP 0
#endif
#define SK(p) do { a.ph_lo = (p); a.ph_hi = (p) + 1; for (int r_ = 0; r_ < (((DEV_REP >> (p)) & 1) ? 2 : 1); ++r_) hipLaunchKernelGGL(skel_fwd, dim3(grid), dim3(NWAVES * 64), LDS_BYTES, stream, a); } while (0)
#define ON(p) ((DEV_MASK >> (p)) & 1)
    if (ON(0)) SK(0); else { n_mod<<<dim3(24, 16), 256, 0, stream>>>((const float*)d_in[1], (const float*)d_in[3], (const float*)d_in[4], MOD); n_misc<<<4, 256, 0, stream>>>((const float*)d_in[7], LB, H2); }
    if (ON(1)) SK(1); else k_normmod<<<T / 4, 256, 0, stream>>>(x, (const float*)d_in[5], MOD, 0, 1024, XN);
    if (ON(2)) SK(2); else n_gemm<EpiInN><<<dim3(INW / 64, T / 64), 256, 0, stream>>>(XN, 1024, (const float*)d_in[6], INW, 1024, EpiInN{QH, LF, VH, GH, AQ, AKV, SGH, SGA, LB});
    a.sub = ON(3) ? DEV_SUB : 0;
    if (a.sub) SK(3);
    if (!(a.sub & 1)) { n_hgrn<<<128, 64, 0, stream>>>(QH, LF, VH, OTMP); n_hgrn_norm<<<T, 256, 0, stream>>>(OTMP, hgg, GH, HOAO); }
    if (!(a.sub & 2)) { n_qkn<<<(T * 10 + 255) / 256, 256, 0, stream>>>(AQ, AKV, pos, qg, kg, QN, KN); n_attn<<<T * 8 / 256, 256, 0, stream>>>(QN, KN, AKV, sinks, HOAO); }
    if (ON(4)) SK(4); else {
        n_gemm<EpiM1N><<<dim3(16, T / 64), 256, 0, stream>>>(HOAO, 1024, (const float*)d_in[9], 1024, 512, EpiM1N{MRG, SGH});
        n_gemm<EpiM2N><<<dim3(16, T / 64), 256, 0, stream>>>(HOAO + 512, 1024, (const float*)d_in[13], 1024, 512, EpiM2N{MRG, SGA});
    }
    if (ON(5)) SK(5); else n_gemm<EpiOutN><<<dim3(16, T / 64), 256, 0, stream>>>(MRG, 1024, (const float*)d_in[14], 1024, 1024, EpiOutN{x, MOD, out});
    if (ON(6)) SK(6); else n_route<<<T / 4, 256, 0, stream>>>(out, n2g, MOD, w_r, b_r, H2, TOPI, TOPW);
    if (ON(7) && ON(8)) { SK(7); SK(8); } else n_moe<<<T * 4, 256, 0, stream>>>(H2, TOPI, TOPW, w_up, b_up, w_dn, b_dn, Y);
    if (ON(9)) SK(9); else k_final<<<T / 4, 256, 0, stream>>>(out, MOD, Y);
#else
    a.one = 1; a.sub = 3; a.ph_lo = 0; a.ph_hi = 10;
    hipLaunchKernelGGL(skel_fwd, dim3(grid), dim3(NWAVES * 64), LDS_BYTES, stream, a);
#endif
}
```

```cpp
#include <hip/hip_runtime.h>
#include <cstdio>
#include <cstdint>
#include <cmath>

typedef unsigned short bf16;
constexpr int BATCH = 16, SEQ = 2048, DM = 1024, T = BATCH * SEQ;
constexpr int INW = 4864, NEXP = 32, TOPK = 4, DEXP = 1024;
constexpr float EPS = 1e-6f;

constexpr size_t MiB = 1u << 20;
constexpr size_t WS_CTL = 0;
constexpr size_t WS_MOD = 1 * MiB;
constexpr size_t WS_LB = 1 * MiB + 512 * 1024;
constexpr size_t WS_IDT = 1 * MiB + 768 * 1024;
constexpr size_t WS_BUPP = 2 * MiB;
constexpr size_t WS_TOKL = 4 * MiB;
constexpr size_t WS_GATL = 8 * MiB;
constexpr size_t WS_TOPI = 12 * MiB;
constexpr size_t WS_TOPW = 13 * MiB;
constexpr size_t WS_WIN = 16 * MiB, WS_WHG = 26 * MiB, WS_WATT = 27 * MiB, WS_WOUT = 28 * MiB, WS_WUP = 32 * MiB, WS_WDN = 160 * MiB;
constexpr size_t WS_H2 = 224 * MiB;
constexpr size_t WS_R = 290 * MiB;
constexpr size_t WS_XN = WS_R, WS_QH = WS_R + 64 * MiB, WS_LF = WS_R + 96 * MiB, WS_VH = WS_R + 160 * MiB, WS_GH = WS_R + 192 * MiB,
                 WS_AQ = WS_R + 224 * MiB, WS_AKV = WS_R + 256 * MiB, WS_SGH = WS_R + 272 * MiB, WS_SGA = WS_R + 336 * MiB,
                 WS_HOAO = WS_R + 400 * MiB, WS_MRG = WS_R + 464 * MiB;
constexpr size_t WS_ACT = WS_R, WS_Y = WS_R + 272 * MiB;
constexpr size_t WS_TMP = 820 * MiB;
constexpr size_t WS_OTMP = WS_TMP, WS_QN = WS_TMP + 64 * MiB, WS_KN = WS_TMP + 128 * MiB;
constexpr size_t WS_END = 964 * MiB;

__device__ __forceinline__ float bf2f(bf16 v) { return __uint_as_float((unsigned)v << 16); }
typedef float f32x2_t __attribute__((ext_vector_type(2))); typedef __bf16 bf16x2_t __attribute__((ext_vector_type(2)));
__device__ __forceinline__ unsigned cvtpk_s(float lo, float hi) { f32x2_t v = {lo, hi}; bf16x2_t b = __builtin_convertvector(v, bf16x2_t); return __builtin_bit_cast(unsigned, b); }
__device__ __forceinline__ bf16 f2bf(float f) { return (bf16)(cvtpk_s(f, f) & 0xffffu); }
__device__ __forceinline__ float silu_f(float x) { return x / (1.f + __expf(-x)); }
__device__ __forceinline__ float sigm_f(float x) { return 1.f / (1.f + __expf(-x)); }
__device__ __forceinline__ float wave_sum(float v) {
#pragma unroll
    for (int o = 1; o < 64; o <<= 1) v += __shfl_xor(v, o);
    return v;
}

__device__ __forceinline__ void rope_cs(int pos, int i, float& cs, float& sn) {
    const float invf = exp2f(-(float)i * 0.125f * 18.931568569324174f);
    double a = (double)pos * (double)invf * 0.15915494309189535; a -= floor(a);
    sn = __builtin_amdgcn_sinf((float)a); cs = __builtin_amdgcn_cosf((float)a);
}
#ifndef DEV_ORACLE
#define DEV_ORACLE 0
#endif
#if DEV_ORACLE
__global__ void n_mod(const float* c, const float* w_ada, const float* b_ada, float* MOD) {
    const int n = blockIdx.x * 256 + threadIdx.x, b = blockIdx.y;
    __shared__ float cond[1024];
    for (int k = threadIdx.x; k < 1024; k += 256) cond[k] = silu_f(c[b * 1024 + k]);
    __syncthreads();
    float acc = 0.f;
    for (int k = 0; k < 1024; ++k) acc += cond[k] * w_ada[(size_t)k * 6144 + n];
    MOD[b * 6144 + n] = acc + b_ada[n];
}
__global__ void n_misc(const float* lbl, float* LB, bf16* H2) {
    const int i = blockIdx.x * 256 + threadIdx.x;
    if (i < 512) LB[i] = 1.f / (1.f + __expf(lbl[512 + i] - lbl[i]));
    if (i < 1024) H2[(size_t)T * 1024 + i] = 0;
}
__global__ void k_normmod(const float* x, const float* gain, const float* MOD, int sh_off, int sc_off, bf16* out) {
    const int lane = threadIdx.x & 63, row = blockIdx.x * 4 + (threadIdx.x >> 6), b = row / SEQ;
    const float4* xr = (const float4*)(x + (size_t)row * DM) + lane;
    float4 v[4]; float s = 0.f;
#pragma unroll
    for (int j = 0; j < 4; ++j) { v[j] = xr[64 * j]; s += v[j].x * v[j].x + v[j].y * v[j].y + v[j].z * v[j].z + v[j].w * v[j].w; }
    const float rstd = rsqrtf(wave_sum(s) * (1.f / DM) + EPS);
    const float* mb = MOD + (size_t)b * 6144;
#pragma unroll
    for (int j = 0; j < 4; ++j) {
        const int c = 4 * lane + 256 * j;
        const float4 g = *(const float4*)(gain + c), sc = *(const float4*)(mb + sc_off + c), sh = *(const float4*)(mb + sh_off + c);
        ushort4 o;
        o.x = f2bf(v[j].x * rstd * g.x * (1.f + sc.x) + sh.x); o.y = f2bf(v[j].y * rstd * g.y * (1.f + sc.y) + sh.y);
        o.z = f2bf(v[j].z * rstd * g.z * (1.f + sc.z) + sh.z); o.w = f2bf(v[j].w * rstd * g.w * (1.f + sc.w) + sh.w);
        *(ushort4*)(out + (size_t)row * DM + c) = o;
    }
}
template <class Epi> __global__ void n_gemm(const bf16* A, int lda, const float* W, int N, int K, Epi epi) {
    __shared__ float As[16][65], Ws[16][65];
    const int tx = threadIdx.x & 15, ty = threadIdx.x >> 4, m0 = blockIdx.y * 64, n0 = blockIdx.x * 64;
    float acc[4][4];
#pragma unroll
    for (int i = 0; i < 4; ++i)
#pragma unroll
        for (int j = 0; j < 4; ++j) acc[i][j] = 0.f;
    for (int k0 = 0; k0 < K; k0 += 16) {
        for (int i = threadIdx.x; i < 1024; i += 256) { const int r = i >> 4, kk = i & 15; As[kk][r] = bf2f(A[(size_t)(m0 + r) * lda + k0 + kk]); }
        for (int i = threadIdx.x; i < 1024; i += 256) { const int kk = i >> 6, cc = i & 63; Ws[kk][cc] = W[(size_t)(k0 + kk) * N + n0 + cc]; }
        __syncthreads();
#pragma unroll
        for (int kk = 0; kk < 16; ++kk) {
            float a[4], b[4];
#pragma unroll
            for (int i = 0; i < 4; ++i) { a[i] = As[kk][ty * 4 + i]; b[i] = Ws[kk][tx * 4 + i]; }
#pragma unroll
            for (int i = 0; i < 4; ++i)
#pragma unroll
                for (int j = 0; j < 4; ++j) acc[i][j] += a[i] * b[j];
        }
        __syncthreads();
    }
#pragma unroll
    for (int i = 0; i < 4; ++i)
#pragma unroll
        for (int j = 0; j < 4; ++j) epi(m0 + ty * 4 + i, n0 + tx * 4 + j, acc[i][j]);
}
struct EpiInN {
    bf16* QH; float* LF; bf16 *VH, *GH, *AQ, *AKV, *SGH, *SGA; const float* LB;
    __device__ void operator()(int r, int c, float v) const {
        if (c < 512) QH[(size_t)r * 512 + c] = f2bf(silu_f(v));
        else if (c < 1024) { const int cc = c - 512; const float lb = LB[cc]; LF[(size_t)r * 512 + cc] = __logf(lb + (1.f - lb) * sigm_f(v)); }
        else if (c < 1536) VH[(size_t)r * 512 + (c - 1024)] = f2bf(v);
        else if (c < 2048) GH[(size_t)r * 512 + (c - 1536)] = f2bf(silu_f(v));
        else if (c < 2560) AQ[(size_t)r * 512 + (c - 2048)] = f2bf(v);
        else if (c < 2816) AKV[(size_t)r * 256 + (c - 2560)] = f2bf(v);
        else if (c < 3840) SGH[(size_t)r * 1024 + (c - 2816)] = f2bf(sigm_f(v));
        else SGA[(size_t)r * 1024 + (c - 3840)] = f2bf(sigm_f(v));
    }
};
struct EpiM1N { bf16* MRG; const bf16* SG; __device__ void operator()(int r, int c, float v) const { MRG[(size_t)r * 1024 + c] = f2bf(bf2f(SG[(size_t)r * 1024 + c]) * v); } };
struct EpiM2N { bf16* MRG; const bf16* SG; __device__ void operator()(int r, int c, float v) const { MRG[(size_t)r * 1024 + c] = f2bf(bf2f(MRG[(size_t)r * 1024 + c]) + bf2f(SG[(size_t)r * 1024 + c]) * v); } };
struct EpiOutN { const float* x; const float* MOD; float* out; __device__ void operator()(int r, int c, float v) const { out[(size_t)r * 1024 + c] = x[(size_t)r * 1024 + c] + MOD[(size_t)(r / SEQ) * 6144 + 2048 + c] * v; } };

__global__ void n_hgrn(const bf16* QH, const float* LF, const bf16* VH, float* OTMP) {
    const int bh = blockIdx.x >> 1, vh = blockIdx.x & 1, b = bh >> 2, h = bh & 3, v = threadIdx.x;
    __shared__ float S[128 * 64];
    __shared__ float sq[128], sf[128], sk[128];
    for (int i = v; i < 128 * 64; i += 64) S[i] = 0.f;
    for (int t = 0; t < SEQ; ++t) {
        const size_t row = (size_t)b * SEQ + t;
        __syncthreads();
        for (int k = v; k < 128; k += 64) { const float lf = LF[row * 512 + h * 128 + k]; const float f = __expf(lf); sf[k] = f; sk[k] = 1.f - f; sq[k] = bf2f(QH[row * 512 + h * 128 + k]); }
        __syncthreads();
        const float vv = bf2f(VH[row * 512 + h * 128 + vh * 64 + v]);
        float o = 0.f;
        for (int k = 0; k < 128; ++k) { float s = S[k * 64 + v]; s = sf[k] * s + sk[k] * vv; S[k * 64 + v] = s; o += s * sq[k]; }
        OTMP[row * 512 + h * 128 + vh * 64 + v] = o;
    }
}
__global__ void n_hgrn_norm(const float* OTMP, const float* gain, const bf16* GH, bf16* HOAO) {
    const int lane = threadIdx.x & 63, idx = blockIdx.x * 4 + (threadIdx.x >> 6), t = idx >> 2, h = idx & 3;
    const float a = OTMP[(size_t)t * 512 + h * 128 + lane], b = OTMP[(size_t)t * 512 + h * 128 + 64 + lane];
    const float rstd = rsqrtf(wave_sum(a * a + b * b) * (1.f / 128.f) + EPS);
    HOAO[(size_t)t * 1024 + h * 128 + lane] = f2bf(a * rstd * gain[lane] * bf2f(GH[(size_t)t * 512 + h * 128 + lane]));
    HOAO[(size_t)t * 1024 + h * 128 + 64 + lane] = f2bf(b * rstd * gain[64 + lane] * bf2f(GH[(size_t)t * 512 + h * 128 + 64 + lane]));
}
__global__ void n_qkn(const bf16* AQ, const bf16* AKV, const int* pos, const float* qg, const float* kg, float* QN, float* KN) {
    const int idx = blockIdx.x * 256 + threadIdx.x, t = idx / 10, j = idx % 10;
    if (t >= T) return;
    const bf16* src = j < 8 ? AQ + (size_t)t * 512 + j * 64 : AKV + (size_t)t * 256 + (j - 8) * 64;
    const float* g = j < 8 ? qg : kg;
    float* dst = j < 8 ? QN + (size_t)t * 512 + j * 64 : KN + (size_t)t * 128 + (j - 8) * 64;
    float ss = 0.f;
    for (int d = 0; d < 64; ++d) { const float v = bf2f(src[d]); ss += v * v; }
    const float rstd = rsqrtf(ss * (1.f / 64.f) + EPS);
    const int p = pos[t];
    for (int d = 0; d < 64; ++d) {
        float v = bf2f(src[d]) * rstd * g[d];
        if (d < 16) {
            const int i = d & 7; float cs, sn; rope_cs(p, i, cs, sn);
            const float x1 = bf2f(src[i]) * rstd * g[i], x2 = bf2f(src[i + 8]) * rstd * g[i + 8];
            v = d < 8 ? x1 * cs - x2 * sn : x2 * cs + x1 * sn;
        }
        dst[d] = v;
    }
}
__global__ void __launch_bounds__(256) n_attn(const float* QN, const float* KN, const bf16* AKV, const float* sinks, bf16* HOAO) {
    const int idx = blockIdx.x * 256 + threadIdx.x, t = idx >> 3, hq = idx & 7, kvh = hq >> 2, ts = t % SEQ, b0 = t - ts;
    float q[64], acc[64];
#pragma unroll
    for (int d = 0; d < 64; ++d) { q[d] = QN[(size_t)t * 512 + hq * 64 + d] * 0.125f; acc[d] = 0.f; }
    float m = sinks[hq], l = 1.f;
    for (int kt = (ts >= 127 ? ts - 127 : 0); kt <= ts; ++kt) {
        const float* kr = KN + (size_t)(b0 + kt) * 128 + kvh * 64; const bf16* vr = AKV + (size_t)(b0 + kt) * 256 + 128 + kvh * 64;
        float s = 0.f;
#pragma unroll
        for (int d = 0; d < 64; ++d) s += q[d] * kr[d];
        const float mn = fmaxf(m, s), sc = __expf(m - mn), p = __expf(s - mn);
        l = l * sc + p; m = mn;
#pragma unroll
        for (int d = 0; d < 64; ++d) acc[d] = acc[d] * sc + p * bf2f(vr[d]);
    }
    const float il = 1.f / l;
#pragma unroll
    for (int d = 0; d < 64; ++d) HOAO[(size_t)t * 1024 + 512 + hq * 64 + d] = f2bf(acc[d] * il);
}
__global__ void __launch_bounds__(256) n_route(const float* x1, const float* gain, const float* MOD, const float* wr, const float* br, bf16* H2, int* TOPI, float* TOPW) {
    const int lane = threadIdx.x & 63, row = blockIdx.x * 4 + (threadIdx.x >> 6), b = row / SEQ;
    const float4* xr = (const float4*)(x1 + (size_t)row * DM) + lane;
    float4 v[4]; float s = 0.f;
#pragma unroll
    for (int j = 0; j < 4; ++j) { v[j] = xr[64 * j]; s += v[j].x * v[j].x + v[j].y * v[j].y + v[j].z * v[j].z + v[j].w * v[j].w; }
    const float rstd = rsqrtf(wave_sum(s) * (1.f / DM) + EPS);
    const float* mb = MOD + (size_t)b * 6144;
    float hv[16];
#pragma unroll
    for (int j = 0; j < 4; ++j) {
        const int c = 4 * lane + 256 * j;
        const float4 g = *(const float4*)(gain + c), sc = *(const float4*)(mb + 4096 + c), sh = *(const float4*)(mb + 3072 + c);
        hv[4 * j + 0] = v[j].x * rstd * g.x * (1.f + sc.x) + sh.x; hv[4 * j + 1] = v[j].y * rstd * g.y * (1.f + sc.y) + sh.y;
        hv[4 * j + 2] = v[j].z * rstd * g.z * (1.f + sc.z) + sh.z; hv[4 * j + 3] = v[j].w * rstd * g.w * (1.f + sc.w) + sh.w;
        ushort4 o; o.x = f2bf(hv[4 * j]); o.y = f2bf(hv[4 * j + 1]); o.z = f2bf(hv[4 * j + 2]); o.w = f2bf(hv[4 * j + 3]);
        *(ushort4*)(H2 + (size_t)row * DM + c) = o;
    }
    float lg[32];
#pragma unroll
    for (int e = 0; e < 32; ++e) {
        float p = 0.f;
#pragma unroll
        for (int j = 0; j < 4; ++j)
#pragma unroll
            for (int i = 0; i < 4; ++i) p += hv[4 * j + i] * wr[(size_t)(4 * lane + 256 * j + i) * 32 + e];
        lg[e] = wave_sum(p) + br[e];
    }
    unsigned used = 0u; float tv[4]; int ti[4];
#pragma unroll
    for (int k = 0; k < 4; ++k) {
        float best = -INFINITY; int bi = 0;
#pragma unroll
        for (int e = 0; e < 32; ++e) { const bool ok = !((used >> e) & 1u) && lg[e] > best; best = ok ? lg[e] : best; bi = ok ? e : bi; }
        used |= 1u << bi; tv[k] = best; ti[k] = bi;
    }
    const float e1 = __expf(tv[1] - tv[0]), e2 = __expf(tv[2] - tv[0]), e3 = __expf(tv[3] - tv[0]), inv = 1.f / (1.f + e1 + e2 + e3);
    if (lane == 0) {
        TOPI[row * 4 + 0] = ti[0]; TOPI[row * 4 + 1] = ti[1]; TOPI[row * 4 + 2] = ti[2]; TOPI[row * 4 + 3] = ti[3];
        TOPW[row * 4 + 0] = inv; TOPW[row * 4 + 1] = e1 * inv; TOPW[row * 4 + 2] = e2 * inv; TOPW[row * 4 + 3] = e3 * inv;
    }
}
__global__ void n_moe(const bf16* H2, const int* TOPI, const float* TOPW, const float* w_up, const float* b_up, const float* w_dn, const float* b_dn, bf16* Y) {
    const int a = blockIdx.x, t = a >> 2, tid = threadIdx.x, e = TOPI[a];
    const float gate = TOPW[a];
    __shared__ float hr[1024], av[1024];
    for (int k = tid; k < 1024; k += 256) hr[k] = bf2f(H2[(size_t)t * 1024 + k]);
    __syncthreads();
    const float* wu = w_up + (size_t)e * 1024 * 2048; const float* bu = b_up + (size_t)e * 2048;
    float ag[4], al[4];
#pragma unroll
    for (int j = 0; j < 4; ++j) { ag[j] = 0.f; al[j] = 0.f; }
    for (int k = 0; k < 1024; ++k) {
        const float h = hr[k];
#pragma unroll
        for (int j = 0; j < 4; ++j) { const float2 w = *(const float2*)(wu + (size_t)k * 2048 + 2 * (tid + 256 * j)); ag[j] += h * w.x; al[j] += h * w.y; }
    }
#pragma unroll
    for (int j = 0; j < 4; ++j) {
        const int o = tid + 256 * j;
        const float g = fminf(ag[j] + bu[2 * o], 7.f), li = fminf(fmaxf(al[j] + bu[2 * o + 1], -7.f), 7.f);
        av[o] = g * sigm_f(1.702f * g) * (li + 1.f);
    }
    __syncthreads();
    const float* wd = w_dn + (size_t)e * 1024 * 1024; const float* bd = b_dn + (size_t)e * 1024;
    float y[4];
#pragma unroll
    for (int j = 0; j < 4; ++j) y[j] = 0.f;
    for (int k = 0; k < 1024; ++k) {
        const float h = av[k];
#pragma unroll
        for (int j = 0; j < 4; ++j) y[j] += h * wd[(size_t)k * 1024 + tid + 256 * j];
    }
#pragma unroll
    for (int j = 0; j < 4; ++j) Y[(size_t)a * 1024 + tid + 256 * j] = f2bf(gate * (y[j] + bd[tid + 256 * j]));
}
__global__ void k_final(float* out, const float* MOD, const bf16* Y) {
    const int lane = threadIdx.x & 63, row = blockIdx.x * 4 + (threadIdx.x >> 6), b = row / SEQ;
    const float* g2 = MOD + (size_t)b * 6144 + 5120;
#pragma unroll
    for (int j = 0; j < 4; ++j) {
        const int c = 4 * lane + 256 * j;
        float4 x = *(float4*)(out + (size_t)row * DM + c); const float4 g = *(const float4*)(g2 + c);
        float s0 = 0.f, s1 = 0.f, s2 = 0.f, s3 = 0.f;
#pragma unroll
        for (int k = 0; k < 4; ++k) { const ushort4 y = *(const ushort4*)(Y + ((size_t)row * 4 + k) * DM + c); s0 += bf2f(y.x); s1 += bf2f(y.y); s2 += bf2f(y.z); s3 += bf2f(y.w); }
        x.x += g.x * s0; x.y += g.y * s1; x.z += g.z * s2; x.w += g.w * s3;
        *(float4*)(out + (size_t)row * DM + c) = x;
    }
}

#endif

namespace pg8 {
#define PG8_LAS __attribute__((address_space(3)))
typedef unsigned short bf16_t;
typedef short bf16x8 __attribute__((ext_vector_type(8)));
typedef float f32x4 __attribute__((ext_vector_type(4)));
typedef unsigned u32x4 __attribute__((ext_vector_type(4)));
constexpr int BM = 256, BK = 64, HALF = 128, HTB = HALF * BK * 2  , STAGE_BYTES = 8 * HTB, NXCD = 8, WGM = 8;

__host__ __device__ __forceinline__ int lds_byte(int r, int c) { const int st = (r >> 4) * 2 + (c >> 5), rr = r & 15, cc = c & 31, ob = rr * 64 + cc * 2; return st * 1024 + (ob ^ (((ob >> 9) & 1) << 5)); }
__host__ __device__ __forceinline__ void stage_rc(int b, int& R, int& C) { const int st = b / 1024, sb = b % 1024, swz = sb ^ (((sb >> 9) & 1) << 5); R = (st >> 1) * 16 + swz / 64; C = (st & 1) * 32 + (swz % 64) / 2; }
__host__ __device__ __forceinline__ int perm32(int rho) { const int n = rho >> 4, i = rho & 15; return 8 * (i >> 2) + 4 * n + (i & 3); }

struct Unit { int pm, pn, arow0, nvalid; unsigned abase; };
struct Gemm { const bf16_t* A; const bf16_t* Bt; int M, N, K; const int* rowidx; int zero_row; int lda; };

struct StaticOrder {
    int nM, nN, nwg, G, c;
    __host__ __device__ void init(int M, int N, int G_, int c_) { nM = M / BM; nN = N / BM; nwg = nM * nN; G = G_; c = c_; }
    __host__ __device__ bool next(int i, Unit& u) const {
        const long L = (long)i * G + c; if (L >= nwg) return false;
        int wgid = (int)L; { const int q = nwg / NXCD, r = nwg % NXCD, xcd = wgid % NXCD, off = wgid / NXCD; wgid = (xcd < r ? xcd * (q + 1) : r * (q + 1) + (xcd - r) * q) + off; }
        const int nig = WGM * nN, gid = wgid / nig, fm = gid * WGM, gsz = (nM - fm) < WGM ? (nM - fm) : WGM;
        u.pm = fm + ((wgid % nig) % gsz); u.pn = (wgid % nig) / gsz; u.arow0 = 0; u.nvalid = 0; u.abase = 0u; return true;
    }
};
__device__ __forceinline__ unsigned cvt_pk_bf16(float lo, float hi) { unsigned r; asm volatile("v_cvt_pk_bf16_f32 %0, %1, %2" : "=v"(r) : "v"(lo), "v"(hi)); return r; }

typedef int v8i32 __attribute__((ext_vector_type(8))); typedef int v4i32 __attribute__((ext_vector_type(4)));
template <class Epi, class Sched, bool ALIGN_EPI, int GATHER, int EB = 2>
__device__ __forceinline__ void gemm_phase(PG8_LAS unsigned char* lds, const Gemm g, const Sched& S, const Epi& E) {
    const int tid = threadIdx.x, wid = __builtin_amdgcn_readfirstlane(tid >> 6), lane = tid & 63, wr = wid >> 2, wc = wid & 3, fr = lane & 15, fq = lane >> 4;
    const int K = g.K, nt = K * EB / (BK * 2), lda = g.lda;
    unsigned voffA[2], voffB[2];
#pragma unroll
    for (int i = 0; i < 2; ++i) { int R, C; stage_rc(tid * 16 + i * 8192, R, C); const int Rb = Epi::PERM ? ((R & ~31) + perm32(R & 31)) : R;
        voffA[i] = (unsigned)(R * lda * EB + C * 2); voffB[i] = (unsigned)(Rb * K * EB + C * 2); }
    unsigned tokP[2], cpk = 0, abase = 0;
    const size_t kstep = (size_t)(BK * 2);
    const size_t hstep = (size_t)HALF * K * EB;
    const size_t hstepA = GATHER ? 0 : (size_t)HALF * lda * EB; const size_t tstepA = (size_t)BM * lda * EB;
    const size_t tstep = 2 * hstep;
    const unsigned ldsw = (unsigned)wid * 1024u;
    const int aoff = lds_byte(wr * 64 + fr, fq * 8), boff = lds_byte(wc * 32 + fr, fq * 8);
#define PG8_SA(b, h) (((b) * 2 + (h)) * HTB)
#define PG8_SB(b, h) ((4 + (b) * 2 + (h)) * HTB)
#define PG8_STAGE(bufoff, gbase, voff) do { _Pragma("unroll") for (int _i = 0; _i < 2; ++_i) \
        __builtin_amdgcn_global_load_lds((const unsigned*)((const char*)(gbase) + (voff)[_i]), (PG8_LAS unsigned*)(lds + (bufoff) + ldsw + _i * 8192), 16, 0, 0); } while (0)
#define PG8_STAGE_A(b, h, gbase) do { if constexpr (GATHER) { _Pragma("unroll") for (int _i = 0; _i < 2; ++_i) { const unsigned off_ = ((tokP[_i] >> (16 * (h))) & 0xffffu) * (unsigned)(lda * EB) + ((cpk >> (8 * _i)) & 0xffu) + abase; \
        __builtin_amdgcn_global_load_lds((const unsigned*)((const char*)(gbase) + off_), (PG8_LAS unsigned*)(lds + PG8_SA(b, h) + ldsw + _i * 8192), 16, 0, 0); } } else { PG8_STAGE(PG8_SA(b, h), (gbase) + (h) * hstepA, voffA); } } while (0)
#define PG8_GOFF(dst, u) do { _Pragma("unroll") for (int _i = 0; _i < 2; ++_i) { int R_, C_; stage_rc(tid * 16 + _i * 8192, R_, C_); \
        int t0_, t1_; if constexpr (GATHER == 1) { t0_ = (R_ < (u).nvalid) ? (g.rowidx[(u).arow0 + R_] >> 2) : g.zero_row; t1_ = (HALF + R_ < (u).nvalid) ? (g.rowidx[(u).arow0 + HALF + R_] >> 2) : g.zero_row; } else { t0_ = R_; t1_ = HALF + R_; } \
        dst[_i] = (unsigned)t0_ | ((unsigned)t1_ << 16); } } while (0)
#define PG8_LD8(addr) __builtin_shufflevector(*(const PG8_LAS v4i32*)(addr), *(const PG8_LAS v4i32*)((addr) + 1024), 0, 1, 2, 3, 4, 5, 6, 7)
#define PG8_LDA(dst, b, h) do { if constexpr (EB == 2) { _Pragma("unroll") for (int m = 0; m < 4; ++m) _Pragma("unroll") for (int k = 0; k < 2; ++k) dst[m][k] = *(const PG8_LAS bf16x8*)(lds + PG8_SA(b, h) + aoff + m * 2048 + k * 1024); } \
        else { _Pragma("unroll") for (int m = 0; m < 4; ++m) dst##8[m] = PG8_LD8(lds + PG8_SA(b, h) + aoff + m * 2048); } } while (0)
#define PG8_LDB(dst, b, h) do { if constexpr (EB == 2) { _Pragma("unroll") for (int n = 0; n < 2; ++n) _Pragma("unroll") for (int k = 0; k < 2; ++k) dst[n][k] = *(const PG8_LAS bf16x8*)(lds + PG8_SB(b, h) + boff + n * 2048 + k * 1024); } \
        else { _Pragma("unroll") for (int n = 0; n < 2; ++n) dst##8[n] = PG8_LD8(lds + PG8_SB(b, h) + boff + n * 2048); } } while (0)
#define PG8_MMA(ai, bj, At, Bt) do { __builtin_amdgcn_s_setprio(1); if constexpr (EB == 2) { _Pragma("unroll") for (int m = 0; m < 4; ++m) _Pragma("unroll") for (int n = 0; n < 2; ++n) _Pragma("unroll") for (int k = 0; k < 2; ++k) \
        acc[ai][bj][m][n] = __builtin_amdgcn_mfma_f32_16x16x32_bf16(Bt[n][k], At[m][k], acc[ai][bj][m][n], 0, 0, 0); } else { _Pragma("unroll") for (int m = 0; m < 4; ++m) _Pragma("unroll") for (int n = 0; n < 2; ++n) \
        acc[ai][bj][m][n] = __builtin_amdgcn_mfma_scale_f32_16x16x128_f8f6f4(Bt##8[n], At##8[m], acc[ai][bj][m][n], 0, 0, 0, 0x7F7F7F7F, 0, 0x7F7F7F7F); } __builtin_amdgcn_s_setprio(0); } while (0)
#define PG8_WAIT_V(n) asm volatile("s_waitcnt vmcnt(" #n ")" ::: "memory")
#define PG8_WAIT_L(n) asm volatile("s_waitcnt lgkmcnt(" #n ")" ::: "memory")
#define PG8_BAR __builtin_amdgcn_s_barrier()
#define PG8_SCHED __builtin_amdgcn_sched_barrier(0)
    Unit cur, nxt; int ui = 0;
    if (!S.next(0, cur)) return;
    f32x4 acc[2][2][4][2];
#pragma unroll
    for (int a = 0; a < 2; ++a)
#pragma unroll
        for (int b = 0; b < 2; ++b)
#pragma unroll
            for (int m = 0; m < 4; ++m)
#pragma unroll
                for (int n = 0; n < 2; ++n) acc[a][b][m][n] = (f32x4){0.f, 0.f, 0.f, 0.f};
    bf16x8 At[4][2], B0[2][2], B1[2][2]; v8i32 At8[4], B08[2], B18[2];
    const char* cA = GATHER ? (const char*)g.A : (const char*)g.A + (size_t)cur.pm * tstepA; const char* cB = (const char*)g.Bt + (size_t)cur.pn * tstep;
    if constexpr (GATHER != 0) abase = cur.abase;
    if constexpr (GATHER) { PG8_GOFF(tokP, cur); int R0_, C0_, R1_, C1_; stage_rc(tid * 16, R0_, C0_); stage_rc(tid * 16 + 8192, R1_, C1_); cpk = (unsigned)(C0_ * 2) | ((unsigned)(C1_ * 2) << 8); }
    PG8_STAGE(PG8_SB(0, 0), cB, voffB); PG8_STAGE(PG8_SB(0, 1), cB + hstep, voffB); PG8_STAGE_A(0, 0, cA); PG8_STAGE_A(0, 1, cA);
    if (wr == 1) PG8_BAR;
    PG8_WAIT_V(2); PG8_BAR;
    PG8_STAGE(PG8_SB(1, 0), cB + kstep, voffB); PG8_STAGE_A(1, 0, cA + kstep); PG8_STAGE(PG8_SB(1, 1), cB + hstep + kstep, voffB);
    PG8_WAIT_V(6); PG8_BAR;
    for (;;) {
        const bool has_next = S.next(ui + 1, nxt);
        if constexpr (GATHER == 1) { if (has_next) { unsigned tokN[2]; PG8_GOFF(tokN, nxt); *(PG8_LAS unsigned long long*)(lds + STAGE_BYTES + tid * 8) = (unsigned long long)tokN[0] | ((unsigned long long)tokN[1] << 32); } }
        const char* nA = GATHER ? cA : (has_next ? (const char*)g.A + (size_t)nxt.pm * tstepA : cA); const char* nB = has_next ? (const char*)g.Bt + (size_t)nxt.pn * tstep : cB;
#pragma nounroll
        for (int t = 0; t < nt; t += 2) {
            const bool last = (t == nt - 2);
            if constexpr (GATHER != 0) asm volatile("" : "+v"(tokP[0]), "+v"(tokP[1]), "+v"(cpk));
            const char* a1 = cA + (size_t)(t + 1) * kstep;
            const char* a2 = last ? nA : cA + (size_t)(t + 2) * kstep; const char* b2 = last ? nB : cB + (size_t)(t + 2) * kstep;
            const char* a3 = a2 + kstep; const char* b3 = b2 + kstep;
            PG8_LDB(B0, 0, 0); PG8_LDB(B1, 0, 1); PG8_SCHED; PG8_LDA(At, 0, 0); PG8_STAGE_A(1, 1, a1);
            PG8_WAIT_V(8); PG8_WAIT_L(0); PG8_BAR; PG8_MMA(0, 0, At, B0); PG8_MMA(0, 1, At, B1); PG8_BAR; PG8_SCHED;
            if constexpr (GATHER != 0) { if (last && has_next) abase = nxt.abase; }
            if constexpr (GATHER == 1) { if (last && has_next) { const unsigned long long tn_ = *(const PG8_LAS unsigned long long*)(lds + STAGE_BYTES + tid * 8); tokP[0] = (unsigned)tn_; tokP[1] = (unsigned)(tn_ >> 32); } }
            PG8_LDA(At, 0, 1); PG8_STAGE(PG8_SB(0, 0), b2, voffB); PG8_STAGE(PG8_SB(0, 1), b2 + hstep, voffB); PG8_STAGE_A(0, 0, a2);
            PG8_WAIT_V(8); PG8_WAIT_L(0); PG8_BAR; PG8_MMA(1, 0, At, B0); PG8_MMA(1, 1, At, B1); PG8_BAR; PG8_SCHED;
            PG8_LDB(B0, 1, 0); PG8_LDB(B1, 1, 1); PG8_SCHED; PG8_LDA(At, 1, 0); PG8_STAGE_A(0, 1, a2);
            PG8_WAIT_V(8); PG8_WAIT_L(0); PG8_BAR; PG8_MMA(0, 0, At, B0); PG8_MMA(0, 1, At, B1); PG8_BAR; PG8_SCHED;
            PG8_LDA(At, 1, 1); PG8_STAGE(PG8_SB(1, 0), b3, voffB); PG8_STAGE(PG8_SB(1, 1), b3 + hstep, voffB); PG8_STAGE_A(1, 0, a3);
            PG8_WAIT_V(8); PG8_WAIT_L(0); PG8_BAR; PG8_MMA(1, 0, At, B0); PG8_MMA(1, 1, At, B1); PG8_BAR; PG8_SCHED;
        }
        if constexpr (ALIGN_EPI) { if (wr == 0) PG8_BAR; }
        E(acc, cur, wr, wc, fr, fq);
        if (!has_next) break;
#pragma unroll
        for (int a = 0; a < 2; ++a)
#pragma unroll
            for (int b = 0; b < 2; ++b)
#pragma unroll
                for (int m = 0; m < 4; ++m)
#pragma unroll
                    for (int n = 0; n < 2; ++n) acc[a][b][m][n] = (f32x4){0.f, 0.f, 0.f, 0.f};
        cur = nxt; cA = nA; cB = nB; ++ui;
        if constexpr (ALIGN_EPI) { if (wr == 1) PG8_BAR; }
    }
    PG8_WAIT_V(0);
    if constexpr (!ALIGN_EPI) { if (wr == 0) PG8_BAR; }
    PG8_BAR;
#undef PG8_SA
#undef PG8_SB
#undef PG8_STAGE
#undef PG8_STAGE_A
#undef PG8_GOFF
#undef PG8_LDA
#undef PG8_LDB
#undef PG8_MMA
#undef PG8_LD8
#undef PG8_WAIT_V
#undef PG8_WAIT_L
#undef PG8_BAR
#undef PG8_SCHED
}
}

constexpr int NWAVES = 8;
constexpr int LDS_BYTES = 163840;
constexpr int LDSCTL_OFF = 162816;
constexpr int MISC_OFF = LDSCTL_OFF;
constexpr int CW_BAR = 4096;
constexpr int CW_CNT = 64;
constexpr size_t CTL_ZERO_BYTES = 64 * 1024;

#define GAS __attribute__((address_space(1)))
#define LAS __attribute__((address_space(3)))
typedef unsigned v4u __attribute__((ext_vector_type(4)));
typedef float f32x4 __attribute__((ext_vector_type(4)));
typedef short bf16x8 __attribute__((ext_vector_type(8)));
typedef GAS unsigned gu32;
#define RLX_AGENT __ATOMIC_RELAXED, __HIP_MEMORY_SCOPE_AGENT
#define LDS_WAIT() asm volatile("s_waitcnt lgkmcnt(0)" ::: "memory")
#define VM_WAIT() asm volatile("s_waitcnt vmcnt(0)" ::: "memory")
__device__ __forceinline__ unsigned pk2(float lo, float hi) { return cvtpk_s(lo, hi); }
__device__ __forceinline__ float fsigm(float x) { return __builtin_amdgcn_rcpf(1.f + __expf(-x)); }

#define XB_TMO      128
#define XB_XCNT(j)  (256  + 64 * (j))
#define XB_XSUB(j)  (1280 + 64 * (j))
#define XB_XGEN(j)  (2304 + 64 * (j))
#define XB_TOP      3328
#define XB_TOPGEN   3392
#define XCD_BAR_WORDS 3456
#define XB_SPIN_CAP (1u << 18)

__device__ __forceinline__ unsigned xb_ld(unsigned* p)              { return __hip_atomic_load(p, __ATOMIC_RELAXED, __HIP_MEMORY_SCOPE_AGENT); }
__device__ __forceinline__ unsigned xb_add(unsigned* p, unsigned v) { return __hip_atomic_fetch_add(p, v, __ATOMIC_RELAXED, __HIP_MEMORY_SCOPE_AGENT); }
__device__ __forceinline__ unsigned xb_xcc_id() { return (unsigned)__builtin_amdgcn_s_getreg((3 << 11) | 20) & 0xFu; }
#define XB_SPIN(cond, bar) do { unsigned _sp = 0; while (cond) { __builtin_amdgcn_s_sleep(1); \
    if ((++_sp & 255u) == 0u) { if (xb_ld(&(bar)[XB_TMO])) break; if (_sp > XB_SPIN_CAP) { atomicAdd(&(bar)[XB_TMO], 1u); break; } } } } while (0)

struct XcdBarrier {
    unsigned* bar; unsigned x;
    volatile LAS unsigned* st;
};

__device__ __forceinline__ XcdBarrier xcd_barrier_post(unsigned* bar, volatile LAS unsigned* st) {
    XcdBarrier b; b.bar = bar; b.x = xb_xcc_id(); b.st = st;
    if (threadIdx.x == 0) (void)xb_add(&bar[XB_XCNT(b.x)], 1u);
    return b;
}
__device__ __forceinline__ void xcd_barrier_complete(unsigned* bar, unsigned x, unsigned& nloc, unsigned& nx) {
    const unsigned G = gridDim.x * gridDim.y * gridDim.z;
    unsigned sum, cnt, mine, sp = 0u;
    for (;;) {
        sum = 0u; cnt = 0u; mine = 0u;
#pragma unroll
        for (unsigned j = 0; j < 16; ++j) { const unsigned c = xb_ld(&bar[XB_XCNT(j)]); sum += c; cnt += (c > 0u) ? 1u : 0u; mine = (j == x) ? c : mine; }
        if (sum == G) break;
        __builtin_amdgcn_s_sleep(1);
        if ((++sp & 255u) == 0u) { if (xb_ld(&bar[XB_TMO])) break; if (sp > XB_SPIN_CAP) { atomicAdd(&bar[XB_TMO], 1u); break; } }
    }
    nloc = mine > 0u ? mine : 1u; nx = cnt > 0u ? cnt : 1u;
}

__device__ __forceinline__ void xcd_barrier(const XcdBarrier& b) {
    asm volatile("s_waitcnt vmcnt(0)" ::: "memory");
    __syncthreads();
    if (threadIdx.x == 0) {
        unsigned* bar = b.bar;
        __builtin_amdgcn_s_waitcnt(0);
        unsigned nloc = b.st[0], nx = b.st[1];
        if (nloc == 0u) { xcd_barrier_complete(bar, b.x, nloc, nx); b.st[0] = nloc; b.st[1] = nx; }
        const unsigned old = xb_add(&bar[XB_XSUB(b.x)], 1u);
        const unsigned gen = old / nloc;
        if (old + 1u == (gen + 1u) * nloc) {
            __builtin_amdgcn_fence(__ATOMIC_RELEASE, "agent");
            asm volatile("s_waitcnt vmcnt(0)" ::: "memory");
            const unsigned og = xb_add(&bar[XB_TOP], 1u);
            const unsigned tg = og / nx;
            if (og + 1u == (tg + 1u) * nx) xb_add(&bar[XB_TOPGEN], 1u);
            else XB_SPIN(xb_ld(&bar[XB_TOPGEN]) == tg, bar);
            __builtin_amdgcn_fence(__ATOMIC_ACQUIRE, "agent");
            xb_add(&bar[XB_XGEN(b.x)], 1u);
            asm volatile("s_waitcnt vmcnt(0)" ::: "memory");
        } else {
            XB_SPIN(xb_ld(&bar[XB_XGEN(b.x)]) == gen, bar);
            __builtin_amdgcn_fence(__ATOMIC_ACQUIRE, "agent");
            asm volatile("s_waitcnt vmcnt(0)" ::: "memory");
        }
    }
    __syncthreads();
}

struct Frame {
    LAS unsigned char* lds; volatile LAS unsigned* MISC; gu32* ctl; int tid, lane, wave, G;
    const float *x, *c; const int* pos; const float *w_ada, *b_ada, *n1g, *w_in, *lbl, *hgg, *w_hg, *qg, *kg, *sinks, *w_att, *w_out, *n2g, *w_r, *b_r, *w_up, *b_up, *w_dn, *b_dn;
    float* out; unsigned char* ws;
};
__device__ __forceinline__ int up_vrow(int c) { const int o = c >> 1; return 256 * (o >> 7) + 128 * (c & 1) + (o & 127); }

template <int MAP> __device__ __forceinline__ void p0_item(const float* W, int K, int N, bf16* WT, LAS float* scr, int kb, int nb, int lane) {
    const int k0 = 64 * kb, n0 = 64 * nb;
#pragma unroll 4
    for (int i = 0; i < 16; ++i) { const int kk = 4 * i + (lane >> 4); const f32x4 v = *(const GAS f32x4*)(W + (size_t)(k0 + kk) * N + n0 + 4 * (lane & 15));
        LAS float* d = scr + kk * 65 + 4 * (lane & 15); d[0] = v.x; d[1] = v.y; d[2] = v.z; d[3] = v.w; }
    LDS_WAIT(); asm volatile("" ::: "memory");
    const int c = lane >> 3;
#pragma unroll
    for (int j = 0; j < 8; ++j) { const int n = (lane & 7) + 8 * j; const LAS float* s = scr + (8 * c) * 65 + n;
        v4u o; o.x = pk2(s[0], s[65]); o.y = pk2(s[130], s[195]); o.z = pk2(s[260], s[325]); o.w = pk2(s[390], s[455]);
        const int col = n0 + n, row = MAP ? up_vrow(col) : col;
        *(GAS v4u*)(WT + (size_t)row * K + k0 + 8 * c) = o; }
    LDS_WAIT(); asm volatile("" ::: "memory");
}
__device__ __forceinline__ unsigned pk4_fp8(float a, float b, float c, float d) { int w = 0; w = __builtin_amdgcn_cvt_pk_fp8_f32(a, b, w, false); w = __builtin_amdgcn_cvt_pk_fp8_f32(c, d, w, true); return (unsigned)w; }
constexpr float W8_SCALE = 32.f, W8_INV = 1.f / 32.f;
template <int MAP> __device__ __forceinline__ void p0_item8(const float* W, int K, int N, unsigned char* WT, LAS float* scr, int kb, int nb, int lane) {
    const int k0 = 64 * kb, n0 = 64 * nb;
#pragma unroll 4
    for (int i = 0; i < 16; ++i) { const int kk = 4 * i + (lane >> 4); const f32x4 v = *(const GAS f32x4*)(W + (size_t)(k0 + kk) * N + n0 + 4 * (lane & 15));
        LAS float* d = scr + kk * 65 + 4 * (lane & 15); d[0] = v.x; d[1] = v.y; d[2] = v.z; d[3] = v.w; }
    LDS_WAIT(); asm volatile("" ::: "memory");
    const int c = lane >> 4;
#pragma unroll
    for (int j = 0; j < 4; ++j) { const int n = (lane & 15) + 16 * j; const LAS float* s = scr + (16 * c) * 65 + n;
        v4u o; o.x = pk4_fp8(s[0] * W8_SCALE, s[65] * W8_SCALE, s[130] * W8_SCALE, s[195] * W8_SCALE); o.y = pk4_fp8(s[260] * W8_SCALE, s[325] * W8_SCALE, s[390] * W8_SCALE, s[455] * W8_SCALE);
        o.z = pk4_fp8(s[520] * W8_SCALE, s[585] * W8_SCALE, s[650] * W8_SCALE, s[715] * W8_SCALE); o.w = pk4_fp8(s[780] * W8_SCALE, s[845] * W8_SCALE, s[910] * W8_SCALE, s[975] * W8_SCALE);
        const int col = n0 + n, row = MAP ? up_vrow(col) : col;
        *(GAS v4u*)(WT + (size_t)row * K + k0 + 16 * c) = o; }
    LDS_WAIT(); asm volatile("" ::: "memory");
}
__device__ __forceinline__ void p0_mod(Frame& F) {
    LAS float* cT = (LAS float*)F.lds;
    LAS float* red = (LAS float*)(F.lds + 69632);
    const int wg = blockIdx.x;
    for (int i = F.tid; i < 16 * 1024; i += 512) { const int b = i >> 10, k = i & 1023; cT[k * 16 + (k >> 4) * 4 + b] = silu_f(F.c[i]); }
    __syncthreads();
    const int ks = F.tid >> 3, c4 = F.tid & 7, col = wg * 32 + 4 * c4;
    float acc[16][4];
#pragma unroll
    for (int b = 0; b < 16; ++b)
#pragma unroll
        for (int j = 0; j < 4; ++j) acc[b][j] = 0.f;
#pragma unroll 4
    for (int r = 0; r < 16; ++r) {
        const int k = ks * 16 + r; const f32x4 w = *(const GAS f32x4*)(F.w_ada + (size_t)k * 6144 + col);
        const LAS f32x4* cp = (const LAS f32x4*)(cT + k * 16 + (k >> 4) * 4);
#pragma unroll
        for (int q = 0; q < 4; ++q) { const f32x4 cv = cp[q];
#pragma unroll
            for (int j = 0; j < 4; ++j) { acc[4 * q + j][0] += cv[j] * w.x; acc[4 * q + j][1] += cv[j] * w.y; acc[4 * q + j][2] += cv[j] * w.z; acc[4 * q + j][3] += cv[j] * w.w; } }
    }
#pragma unroll
    for (int b = 0; b < 16; ++b)
#pragma unroll
        for (int j = 0; j < 4; ++j) { float v = acc[b][j]; v += __shfl_xor(v, 8); v += __shfl_xor(v, 16); v += __shfl_xor(v, 32); acc[b][j] = v; }
    if (F.lane < 8) {
#pragma unroll
        for (int b = 0; b < 16; ++b)
#pragma unroll
            for (int j = 0; j < 4; ++j) red[(F.wave * 16 + b) * 32 + 4 * c4 + j] = acc[b][j];
    }
    __syncthreads();
    { const int b = F.tid >> 5, cc = F.tid & 31; float s = 0.f;
#pragma unroll
      for (int w = 0; w < 8; ++w) s += red[(w * 16 + b) * 32 + cc];
      ((float*)(F.ws + WS_MOD))[b * 6144 + wg * 32 + cc] = s + F.b_ada[wg * 32 + cc]; }
    __syncthreads();
}
__device__ __forceinline__ void p0_prologue(Frame& F) {
    if (blockIdx.x < 192) p0_mod(F);
    else {
        const int i = ((int)blockIdx.x - 192) * 512 + F.tid;
        float* BUPP = (float*)(F.ws + WS_BUPP);
#pragma unroll
        for (int q = 0; q < 2; ++q) { const int idx = i * 2 + q, e = idx >> 11, c = idx & 2047; BUPP[e * 2048 + up_vrow(c)] = F.b_up[idx]; }
        if (i < 512) ((float*)(F.ws + WS_LB))[i] = 1.f / (1.f + __expf(F.lbl[512 + i] - F.lbl[i]));
        if (i >= 1024 && i < 1280) ((unsigned*)(F.ws + WS_H2))[(size_t)T * 256 + (i - 1024)] = 0u;
        if (i >= 2048 && i < 2304) ((int*)(F.ws + WS_IDT))[i - 2048] = (i - 2048) << 2;
    }
    LAS float* scr = (LAS float*)(F.lds + F.wave * 16640);
    const int gw = (int)blockIdx.x * NWAVES + F.wave, NGW = F.G * NWAVES;
    constexpr int I_IN = 16 * 76, I_HG = 8 * 16, I_OUT = 16 * 16;
    constexpr int NITEMS = I_IN + 2 * I_HG + I_OUT;
    for (int it = gw; it < NITEMS; it += NGW) {
        int r = it;
        if (r < I_IN) { p0_item<0>(F.w_in, 1024, INW, (bf16*)(F.ws + WS_WIN), scr, r / 76, r % 76, F.lane); continue; } r -= I_IN;
        if (r < I_HG) { p0_item<0>(F.w_hg, 512, 1024, (bf16*)(F.ws + WS_WHG), scr, r / 16, r % 16, F.lane); continue; } r -= I_HG;
        if (r < I_HG) { p0_item<0>(F.w_att, 512, 1024, (bf16*)(F.ws + WS_WATT), scr, r / 16, r % 16, F.lane); continue; } r -= I_HG;
        p0_item<0>(F.w_out, 1024, 1024, (bf16*)(F.ws + WS_WOUT), scr, r / 16, r % 16, F.lane);
    }
}
__device__ __forceinline__ void moe_weight_copies(Frame& F, int gw, int NGW) {
    LAS float* scr = (LAS float*)(F.lds + F.wave * 16640);
    constexpr int I_UP = 16 * 32, I_DN = 16 * 16;
    for (int it = gw; it < 32 * (I_UP + I_DN); it += NGW) {
        int r = it;
        if (r < 32 * I_UP) { const int e = r / I_UP, q = r % I_UP; p0_item8<1>(F.w_up + (size_t)e * 1024 * 2048, 1024, 2048, F.ws + WS_WUP + (size_t)e * 2048 * 1024, scr, q / 32, q % 32, F.lane); continue; } r -= 32 * I_UP;
        { const int e = r / I_DN, q = r % I_DN; p0_item8<0>(F.w_dn + (size_t)e * 1024 * 1024, 1024, 1024, F.ws + WS_WDN + (size_t)e * 1024 * 1024, scr, q / 16, q % 16, F.lane); }
    }
}
__device__ __forceinline__ void normmod_row(const float* xrow, const float* gain, const float* sh, const float* sc, bf16* orow, int lane) {
    const GAS f32x4* xr = (const GAS f32x4*)xrow + lane;
    f32x4 v[4]; float s = 0.f;
#pragma unroll
    for (int j = 0; j < 4; ++j) { v[j] = xr[64 * j]; s += (v[j].x * v[j].x + v[j].y * v[j].y) + (v[j].z * v[j].z + v[j].w * v[j].w); }
    const float rstd = rsqrtf(wave_sum(s) * (1.f / DM) + EPS);
#pragma unroll
    for (int j = 0; j < 4; ++j) {
        const int c = 4 * lane + 256 * j;
        const f32x4 g = *(const GAS f32x4*)(gain + c), a = *(const GAS f32x4*)(sc + c), b = *(const GAS f32x4*)(sh + c);
        const unsigned lo = pk2(v[j].x * rstd * g.x * (1.f + a.x) + b.x, v[j].y * rstd * g.y * (1.f + a.y) + b.y), hi = pk2(v[j].z * rstd * g.z * (1.f + a.z) + b.z, v[j].w * rstd * g.w * (1.f + a.w) + b.w);
        *(GAS unsigned long long*)(orow + c) = (unsigned long long)lo | ((unsigned long long)hi << 32);
    }
}
__device__ __forceinline__ void p1_xn(Frame& F) {
    const int gw = (int)blockIdx.x * NWAVES + F.wave, NGW = F.G * NWAVES; const float* MOD = (const float*)(F.ws + WS_MOD); bf16* XN = (bf16*)(F.ws + WS_XN);
    for (int m = gw; m < T; m += NGW) { const float* mb = MOD + (size_t)(m / SEQ) * 6144; normmod_row(F.x + (size_t)m * DM, F.n1g, mb, mb + 1024, XN + (size_t)m * DM, F.lane); }
}

__device__ __forceinline__ float bflo(unsigned u) { return __uint_as_float(u << 16); }
__device__ __forceinline__ float bfhi(unsigned u) { return __uint_as_float(u & 0xffff0000u); }
struct EpiIn {
    static constexpr bool PERM = true; unsigned char* ws;
    __device__ __forceinline__ void operator()(const f32x4 (&acc)[2][2][4][2], const pg8::Unit& u, int wr, int wc, int fr, int fq) const {
        const int pn = u.pn, row0 = u.pm * 256 + wr * 64 + fr, cl = wc * 32 + 8 * fq;
        if (pn == 2 || pn == 3) {
            float* LF = (float*)(ws + WS_LF); const float* LB = (const float*)(ws + WS_LB); const int cb = (pn - 2) * 256;
#pragma unroll
            for (int bj = 0; bj < 2; ++bj) { const int col = cb + 128 * bj + cl; const f32x4 l0 = *(const f32x4*)(LB + col), l1 = *(const f32x4*)(LB + col + 4);
#pragma unroll
                for (int ai = 0; ai < 2; ++ai)
#pragma unroll
                    for (int m = 0; m < 4; ++m) { float* rp = LF + (size_t)(row0 + 128 * ai + 16 * m) * 512 + col; const f32x4 v0 = acc[ai][bj][m][0], v1 = acc[ai][bj][m][1]; f32x4 o0, o1;
#pragma unroll
                        for (int j = 0; j < 4; ++j) { o0[j] = __logf(l0[j] + (1.f - l0[j]) * fsigm(v0[j])); o1[j] = __logf(l1[j] + (1.f - l1[j]) * fsigm(v1[j])); }
                        *(f32x4*)rp = o0; *(f32x4*)(rp + 4) = o1; } }
            return;
        }
        bf16* dst; int ld = 512, cb, act = 0;
        if (pn < 2) { dst = (bf16*)(ws + WS_QH); cb = pn * 256; act = 1; }
        else if (pn < 6) { dst = (bf16*)(ws + WS_VH); cb = (pn - 4) * 256; }
        else if (pn < 8) { dst = (bf16*)(ws + WS_GH); cb = (pn - 6) * 256; act = 1; }
        else if (pn < 10) { dst = (bf16*)(ws + WS_AQ); cb = (pn - 8) * 256; }
        else if (pn == 10) { dst = (bf16*)(ws + WS_AKV); cb = 0; ld = 256; }
        else if (pn < 15) { dst = (bf16*)(ws + WS_SGH); cb = (pn - 11) * 256; ld = 1024; act = 2; }
        else { dst = (bf16*)(ws + WS_SGA); cb = (pn - 15) * 256; ld = 1024; act = 2; }
#pragma unroll
        for (int ai = 0; ai < 2; ++ai)
#pragma unroll
            for (int m = 0; m < 4; ++m) { bf16* rp = dst + (size_t)(row0 + 128 * ai + 16 * m) * ld + cb + cl;
#pragma unroll
                for (int bj = 0; bj < 2; ++bj) { f32x4 v0 = acc[ai][bj][m][0], v1 = acc[ai][bj][m][1];
                    if (act == 1) {
#pragma unroll
                        for (int j = 0; j < 4; ++j) { v0[j] *= fsigm(v0[j]); v1[j] *= fsigm(v1[j]); } }
                    else if (act == 2) {
#pragma unroll
                        for (int j = 0; j < 4; ++j) { v0[j] = fsigm(v0[j]); v1[j] = fsigm(v1[j]); } }
                    v4u w; w.x = pg8::cvt_pk_bf16(v0[0], v0[1]); w.y = pg8::cvt_pk_bf16(v0[2], v0[3]); w.z = pg8::cvt_pk_bf16(v1[0], v1[1]); w.w = pg8::cvt_pk_bf16(v1[2], v1[3]);
                    *(v4u*)(rp + 128 * bj) = w; } }
    }
};
template <bool SECOND> struct EpiMrg {
    static constexpr bool PERM = true; bf16* MRG; const bf16* SG;
    __device__ __forceinline__ void operator()(const f32x4 (&acc)[2][2][4][2], const pg8::Unit& u, int wr, int wc, int fr, int fq) const {
        const int row0 = u.pm * 256 + wr * 64 + fr, col0 = u.pn * 256 + wc * 32 + 8 * fq;
#pragma unroll
        for (int ai = 0; ai < 2; ++ai)
#pragma unroll
            for (int m = 0; m < 4; ++m) { const size_t off = (size_t)(row0 + 128 * ai + 16 * m) * 1024 + col0;
#pragma unroll
                for (int bj = 0; bj < 2; ++bj) { const v4u s = *(const v4u*)(SG + off + 128 * bj); const f32x4 v0 = acc[ai][bj][m][0], v1 = acc[ai][bj][m][1];
                    float o[8] = {bflo(s.x) * v0[0], bfhi(s.x) * v0[1], bflo(s.y) * v0[2], bfhi(s.y) * v0[3], bflo(s.z) * v1[0], bfhi(s.z) * v1[1], bflo(s.w) * v1[2], bfhi(s.w) * v1[3]};
                    if (SECOND) { const v4u p = *(const v4u*)(MRG + off + 128 * bj); o[0] += bflo(p.x); o[1] += bfhi(p.x); o[2] += bflo(p.y); o[3] += bfhi(p.y); o[4] += bflo(p.z); o[5] += bfhi(p.z); o[6] += bflo(p.w); o[7] += bfhi(p.w); }
                    v4u w; w.x = pg8::cvt_pk_bf16(o[0], o[1]); w.y = pg8::cvt_pk_bf16(o[2], o[3]); w.z = pg8::cvt_pk_bf16(o[4], o[5]); w.w = pg8::cvt_pk_bf16(o[6], o[7]);
                    *(v4u*)(MRG + off + 128 * bj) = w; } }
    }
};
struct EpiOut {
    static constexpr bool PERM = false; const float* x; const float* MOD; float* out;
    __device__ __forceinline__ void operator()(const f32x4 (&acc)[2][2][4][2], const pg8::Unit& u, int wr, int wc, int fr, int fq) const {
        const int row0 = u.pm * 256 + wr * 64 + fr, col0 = u.pn * 256 + wc * 32 + 4 * fq; const float* g1 = MOD + (size_t)(u.pm >> 3) * 6144 + 2048;
        f32x4 gv[2][2];
#pragma unroll
        for (int bj = 0; bj < 2; ++bj)
#pragma unroll
            for (int n = 0; n < 2; ++n) gv[bj][n] = *(const f32x4*)(g1 + col0 + 128 * bj + 16 * n);
#pragma unroll
        for (int ai = 0; ai < 2; ++ai)
#pragma unroll
            for (int m = 0; m < 4; ++m) { const size_t off = (size_t)(row0 + 128 * ai + 16 * m) * 1024 + col0;
#pragma unroll
                for (int bj = 0; bj < 2; ++bj)
#pragma unroll
                    for (int n = 0; n < 2; ++n) *(f32x4*)(out + off + 128 * bj + 16 * n) = *(const f32x4*)(x + off + 128 * bj + 16 * n) + gv[bj][n] * acc[ai][bj][m][n]; }
    }
};

typedef float f32x16 __attribute__((ext_vector_type(16)));
constexpr int RT_PITCH = 2064;
constexpr int R_TILE = 0, R_PART = 66048, R_LOG = 99840, R_REC = 104064, R_HIST = 112256;
__device__ __forceinline__ void p6_route(Frame& F) {
    const float* MOD = (const float*)(F.ws + WS_MOD); unsigned* H2 = (unsigned*)(F.ws + WS_H2);
    int* TOKL = (int*)(F.ws + WS_TOKL); int* SLOT = (int*)(F.ws + WS_GATL); int* TOPI = (int*)(F.ws + WS_TOPI); float* TOPW = (float*)(F.ws + WS_TOPW);
    LAS float* PART = (LAS float*)(F.lds + R_PART); LAS float* LOG = (LAS float*)(F.lds + R_LOG);
    LAS int* REC_E = (LAS int*)(F.lds + R_REC); LAS int* REC_TK = REC_E + 512; LAS float* REC_G = (LAS float*)(REC_E + 1024); LAS int* REC_RK = REC_E + 1536;
    LAS int* HIST = (LAS int*)(F.lds + R_HIST); LAS int* BASE = HIST + 32;
    const int lane = F.lane, wave = F.wave, r32 = lane & 31, hi = lane >> 5;
    bf16x8 wB[8];
#pragma unroll
    for (int s = 0; s < 8; ++s) { const int k0 = 128 * wave + 16 * s + 8 * hi; unsigned p[4];
#pragma unroll
        for (int j = 0; j < 4; ++j) p[j] = pk2(F.w_r[(size_t)(k0 + 2 * j) * 32 + r32], F.w_r[(size_t)(k0 + 2 * j + 1) * 32 + r32]);
        v4u q = {p[0], p[1], p[2], p[3]}; wB[s] = __builtin_bit_cast(bf16x8, q); }
    if (F.tid < 32) HIST[F.tid] = 0;
    __syncthreads();
    for (int tb = (int)blockIdx.x * 4; tb < T / 32; tb += F.G * 4) {
        const int ntile = (T / 32 - tb) < 4 ? (T / 32 - tb) : 4;
        for (int tl = 0; tl < ntile; ++tl) {
            const int t0 = (tb + tl) * 32;
#pragma unroll 1
            for (int rr = 0; rr < 4; ++rr) {
                const int row = t0 + 4 * wave + rr; const float* mb = MOD + (size_t)(row / SEQ) * 6144;
                const GAS f32x4* xr = (const GAS f32x4*)(F.out + (size_t)row * DM) + lane;
                f32x4 v[4]; float s = 0.f;
#pragma unroll
                for (int j = 0; j < 4; ++j) { v[j] = xr[64 * j]; s += (v[j].x * v[j].x + v[j].y * v[j].y) + (v[j].z * v[j].z + v[j].w * v[j].w); }
                const float rstd = rsqrtf(wave_sum(s) * (1.f / DM) + EPS);
#pragma unroll
                for (int j = 0; j < 4; ++j) {
                    const int c = 4 * lane + 256 * j;
                    const f32x4 g = *(const GAS f32x4*)(F.n2g + c), a = *(const GAS f32x4*)(mb + 4096 + c), b = *(const GAS f32x4*)(mb + 3072 + c);
                    const float h0 = v[j].x * rstd * g.x * (1.f + a.x) + b.x, h1 = v[j].y * rstd * g.y * (1.f + a.y) + b.y, h2v = v[j].z * rstd * g.z * (1.f + a.z) + b.z, h3 = v[j].w * rstd * g.w * (1.f + a.w) + b.w;
                    const unsigned lo = pk2(h0, h1), hh = pk2(h2v, h3);
                    const unsigned long long pk = (unsigned long long)lo | ((unsigned long long)hh << 32);
                    *(GAS unsigned*)(H2 + (size_t)row * 256 + (c >> 2)) = pk4_fp8(h0, h1, h2v, h3);
                    *(LAS unsigned long long*)(F.lds + R_TILE + (4 * wave + rr) * RT_PITCH + c * 2) = pk;
                }
            }
            __syncthreads();
            f32x16 acc = {};
#pragma unroll
            for (int s = 0; s < 8; ++s) { const bf16x8 af = *(const LAS bf16x8*)(F.lds + R_TILE + r32 * RT_PITCH + (128 * wave + 16 * s + 8 * hi) * 2);
                acc = __builtin_amdgcn_mfma_f32_32x32x16_bf16(af, wB[s], acc, 0, 0, 0); }
#pragma unroll
            for (int r = 0; r < 16; ++r) { const int tok = (r & 3) + 8 * (r >> 2) + 4 * hi; PART[(wave * 32 + tok) * 33 + r32] = acc[r]; }
            __syncthreads();
#pragma unroll
            for (int q = 0; q < 2; ++q) { const int idx = F.tid + 512 * q, tok = idx >> 5, e = idx & 31; float s = F.b_r[e];
#pragma unroll
                for (int w = 0; w < 8; ++w) s += PART[(w * 32 + tok) * 33 + e];
                LOG[tok * 33 + e] = s; }
            __syncthreads();
            if (F.tid < 32) {
                float lg[32];
#pragma unroll
                for (int e = 0; e < 32; ++e) lg[e] = LOG[F.tid * 33 + e];
                unsigned used = 0u; float tv[4]; int ti[4];
#pragma unroll
                for (int k = 0; k < 4; ++k) { float best = -INFINITY; int bi = 0;
#pragma unroll
                    for (int e = 0; e < 32; ++e) { const bool ok = !((used >> e) & 1u) && lg[e] > best; best = ok ? lg[e] : best; bi = ok ? e : bi; }
                    used |= 1u << bi; tv[k] = best; ti[k] = bi; }
                const float e1 = __expf(tv[1] - tv[0]), e2 = __expf(tv[2] - tv[0]), e3 = __expf(tv[3] - tv[0]), inv = 1.f / (1.f + e1 + e2 + e3);
                const float gw[4] = {inv, e1 * inv, e2 * inv, e3 * inv};
                const int t = t0 + F.tid;
#pragma unroll
                for (int k = 0; k < 4; ++k) { const int slot = tl * 128 + F.tid * 4 + k; REC_E[slot] = ti[k]; REC_TK[slot] = t * 4 + k; REC_G[slot] = gw[k];
                    REC_RK[slot] = __hip_atomic_fetch_add(&HIST[ti[k]], 1, __ATOMIC_RELAXED, __HIP_MEMORY_SCOPE_WORKGROUP);
                    TOPI[t * 4 + k] = ti[k]; TOPW[t * 4 + k] = gw[k]; }
            }
        }
        __syncthreads();
        if (F.tid < 32) BASE[F.tid] = (int)__hip_atomic_fetch_add(F.ctl + CW_CNT + F.tid, (unsigned)HIST[F.tid], RLX_AGENT);
        __syncthreads();
        for (int slot = F.tid; slot < ntile * 128; slot += 512) { const int e = REC_E[slot], p = BASE[e] + REC_RK[slot]; const int tk = REC_TK[slot]; TOKL[(size_t)e * T + p] = tk; SLOT[tk] = (e << 16) | p; }
        __syncthreads();
        if (F.tid < 32) HIST[F.tid] = 0;
        __syncthreads();
    }
}

__device__ __forceinline__ void moe_tables(Frame& F) {
    if (F.tid < 32) F.MISC[64 + F.tid] = __hip_atomic_load(F.ctl + CW_CNT + F.tid, RLX_AGENT);
    __syncthreads();
    if (F.tid == 0) { unsigned s = 0; for (int e = 0; e < 32; ++e) { F.MISC[16 + e] = s; s += (F.MISC[64 + e] + 255u) >> 8; } F.MISC[48] = s; }
    __syncthreads();
}
template <int NC> struct MoeOrder {
    volatile LAS unsigned* MISC; int G, c;
    __device__ __forceinline__ bool next(int i, pg8::Unit& u) const {
        const int total = (int)MISC[48]; int rt, pl;
        if ((G & 7) == 0 && ((G >> 3) % NC) == 0) { const int rpr = G / NC, perx = rpr >> 3, xcd = c & 7, s = c >> 3; rt = i * rpr + xcd * perx + s / NC; pl = s % NC; }
        else { const int L = i * G + c; rt = L / NC; pl = L % NC; }
        if (rt >= total) return false;
        int e = 0;
        for (int q = 1; q < 32; ++q) e += ((int)MISC[16 + q] <= rt) ? 1 : 0;
        const int j = rt - (int)MISC[16 + e];
        u.pm = rt; u.pn = e * NC + pl;
        if (NC == 8) { u.arow0 = e * T + 256 * j; u.nvalid = (int)MISC[64 + e] - 256 * j; u.abase = 0u; }
        else { u.arow0 = 0; u.nvalid = 256; u.abase = (unsigned)rt * (256u * 1024u); }
        return true;
    }
};
struct EpiUp {
    static constexpr bool PERM = true; unsigned char* ACT; const float* BUPP;
    __device__ __forceinline__ void operator()(const f32x4 (&acc)[2][2][4][2], const pg8::Unit& u, int wr, int wc, int fr, int fq) const {
        const int e = u.pn >> 3, pl = u.pn & 7, row0 = u.pm * 256 + wr * 64 + fr, cl = wc * 32 + 8 * fq;
        const float* bp = BUPP + e * 2048 + 256 * pl + cl;
        const f32x4 bg0 = *(const f32x4*)bp, bg1 = *(const f32x4*)(bp + 4), bl0 = *(const f32x4*)(bp + 128), bl1 = *(const f32x4*)(bp + 132);
#pragma unroll
        for (int ai = 0; ai < 2; ++ai)
#pragma unroll
            for (int m = 0; m < 4; ++m) { unsigned char* rp = ACT + (size_t)(row0 + 128 * ai + 16 * m) * 1024 + 128 * pl + cl;
                const f32x4 g0 = acc[ai][0][m][0] * W8_INV + bg0, g1 = acc[ai][0][m][1] * W8_INV + bg1, l0 = acc[ai][1][m][0] * W8_INV + bl0, l1 = acc[ai][1][m][1] * W8_INV + bl1; float o[8];
#pragma unroll
                for (int j = 0; j < 4; ++j) { const float ga = fminf(g0[j], 7.f), la = fminf(fmaxf(l0[j], -7.f), 7.f), gb = fminf(g1[j], 7.f), lb = fminf(fmaxf(l1[j], -7.f), 7.f);
                    o[j] = ga * fsigm(1.702f * ga) * (la + 1.f); o[4 + j] = gb * fsigm(1.702f * gb) * (lb + 1.f); }
                *(unsigned long long*)rp = (unsigned long long)pk4_fp8(o[0], o[1], o[2], o[3]) | ((unsigned long long)pk4_fp8(o[4], o[5], o[6], o[7]) << 32); }
    }
};
struct EpiDn {
    static constexpr bool PERM = true; bf16* Y; const float* b_dn;
    __device__ __forceinline__ void operator()(const f32x4 (&acc)[2][2][4][2], const pg8::Unit& u, int wr, int wc, int fr, int fq) const {
        const int e = u.pn >> 2, pl = u.pn & 3, row0 = u.pm * 256 + wr * 64 + fr, cl = wc * 32 + 8 * fq; const float* bp = b_dn + e * 1024 + 256 * pl + cl;
        f32x4 bv[2][2];
#pragma unroll
        for (int bj = 0; bj < 2; ++bj) { bv[bj][0] = *(const f32x4*)(bp + 128 * bj); bv[bj][1] = *(const f32x4*)(bp + 128 * bj + 4); }
#pragma unroll
        for (int ai = 0; ai < 2; ++ai)
#pragma unroll
            for (int m = 0; m < 4; ++m) { bf16* rp = Y + (size_t)(row0 + 128 * ai + 16 * m) * 1024 + 256 * pl + cl;
#pragma unroll
                for (int bj = 0; bj < 2; ++bj) { const f32x4 v0 = acc[ai][bj][m][0] * W8_INV + bv[bj][0], v1 = acc[ai][bj][m][1] * W8_INV + bv[bj][1];
                    v4u w; w.x = pg8::cvt_pk_bf16(v0[0], v0[1]); w.y = pg8::cvt_pk_bf16(v0[2], v0[3]); w.z = pg8::cvt_pk_bf16(v1[0], v1[1]); w.w = pg8::cvt_pk_bf16(v1[2], v1[3]);
                    *(v4u*)(rp + 128 * bj) = w; } }
    }
};
__device__ __forceinline__ void p9_final(Frame& F) {
    moe_tables(F);
    const int gw = (int)blockIdx.x * NWAVES + F.wave, NGW = F.G * NWAVES; const float* MOD = (const float*)(F.ws + WS_MOD); const bf16* Y = (const bf16*)(F.ws + WS_Y);
    const int* SLOT = (const int*)(F.ws + WS_GATL); const float* TOPW = (const float*)(F.ws + WS_TOPW);
    for (int row = gw; row < T; row += NGW) {
        const float* g2 = MOD + (size_t)(row / SEQ) * 6144 + 5120;
        const v4u sl = *(const GAS v4u*)(SLOT + row * 4); const f32x4 gt = *(const GAS f32x4*)(TOPW + row * 4);
        const unsigned slv[4] = {sl.x, sl.y, sl.z, sl.w}; const float gtv[4] = {gt.x, gt.y, gt.z, gt.w}; const bf16* yr[4];
#pragma unroll
        for (int k = 0; k < 4; ++k) yr[k] = Y + ((size_t)F.MISC[16 + (slv[k] >> 16)] * 256 + (slv[k] & 0xffffu)) * DM;
#pragma unroll
        for (int j = 0; j < 4; ++j) {
            const int c = 4 * F.lane + 256 * j;
            f32x4 xv = *(const GAS f32x4*)(F.out + (size_t)row * DM + c); const f32x4 g = *(const GAS f32x4*)(g2 + c);
            float s0 = 0.f, s1 = 0.f, s2 = 0.f, s3 = 0.f;
#pragma unroll
            for (int k = 0; k < 4; ++k) { const unsigned long long y = *(const GAS unsigned long long*)(yr[k] + c); const unsigned ylo = (unsigned)y, yhi = (unsigned)(y >> 32);
                s0 += gtv[k] * bflo(ylo); s1 += gtv[k] * bfhi(ylo); s2 += gtv[k] * bflo(yhi); s3 += gtv[k] * bfhi(yhi); }
            xv.x += g.x * s0; xv.y += g.y * s1; xv.z += g.z * s2; xv.w += g.w * s3;
            *(GAS f32x4*)(F.out + (size_t)row * DM + c) = xv;
        }
    }
}
typedef short v4i16_t __attribute__((ext_vector_type(4)));
namespace att {
constexpr int L_K = 0, L_V = 32768, L_OST = 65536, L_WSF = 98304;
constexpr float SC2 = 0.125f * 1.4426950408889634f;
__device__ __forceinline__ int crow(int r, int hi) { return (r & 3) + 8 * (r >> 2) + 4 * hi; }
__device__ __forceinline__ bf16x8 vtr2(LAS const unsigned char* p) {
    const v4i16_t lo = __builtin_amdgcn_ds_read_tr16_b64_v4i16((LAS v4i16_t*)p), hi = __builtin_amdgcn_ds_read_tr16_b64_v4i16((LAS v4i16_t*)(p + 512));
    return (bf16x8){lo[0], lo[1], lo[2], lo[3], hi[0], hi[1], hi[2], hi[3]};
}
__device__ __forceinline__ void unit(Frame& F, int b, int kvh, int qb) {
    const bf16* AQ = (const bf16*)(F.ws + WS_AQ); const bf16* AKV = (const bf16*)(F.ws + WS_AKV); bf16* HOAO = (bf16*)(F.ws + WS_HOAO);
    const int tid = F.tid, lane = F.lane, wave = F.wave, r32 = lane & 31, hi = lane >> 5;
    const int tq0 = b * SEQ + qb * 128, tk0 = tq0 - 128;
    {
        const int key = tid >> 1, half = tid & 1; const bool valid = (qb > 0) || (key >= 128); const int token = valid ? tk0 + key : tq0;
        const bf16* kp = AKV + (size_t)token * 256 + kvh * 64 + half * 32;
        v4u kr[4], vr[4];
#pragma unroll
        for (int q = 0; q < 4; ++q) { kr[q] = *(const GAS v4u*)(kp + 8 * q); vr[q] = *(const GAS v4u*)(kp + 128 + 8 * q); }
        float x[32]; float ss = 0.f;
#pragma unroll
        for (int q = 0; q < 4; ++q) { x[8 * q + 0] = bflo(kr[q].x); x[8 * q + 1] = bfhi(kr[q].x); x[8 * q + 2] = bflo(kr[q].y); x[8 * q + 3] = bfhi(kr[q].y);
            x[8 * q + 4] = bflo(kr[q].z); x[8 * q + 5] = bfhi(kr[q].z); x[8 * q + 6] = bflo(kr[q].w); x[8 * q + 7] = bfhi(kr[q].w); }
#pragma unroll
        for (int d = 0; d < 32; ++d) ss += x[d] * x[d];
        ss += __shfl_xor(ss, 1);
        const float rstd = valid ? rsqrtf(ss * (1.f / 64.f) + EPS) : 0.f;
#pragma unroll
        for (int q = 0; q < 8; ++q) { const f32x4 g = *(const GAS f32x4*)(F.kg + half * 32 + 4 * q); x[4 * q] *= rstd * g.x; x[4 * q + 1] *= rstd * g.y; x[4 * q + 2] *= rstd * g.z; x[4 * q + 3] *= rstd * g.w; }
        if (half == 0) { const int p = F.pos[token];
#pragma unroll
            for (int i = 0; i < 8; ++i) { float cs, sn; rope_cs(p, i, cs, sn); const float x1 = x[i], x2 = x[i + 8]; x[i] = x1 * cs - x2 * sn; x[i + 8] = x2 * cs + x1 * sn; } }
#pragma unroll
        for (int q = 0; q < 4; ++q) { v4u w; w.x = pk2(x[8 * q], x[8 * q + 1]); w.y = pk2(x[8 * q + 2], x[8 * q + 3]); w.z = pk2(x[8 * q + 4], x[8 * q + 5]); w.w = pk2(x[8 * q + 6], x[8 * q + 7]);
            *(LAS v4u*)(F.lds + L_K + (half * 4 + q) * 4096 + key * 16) = w; }
        const int kk = key & 63; LAS unsigned char* vd = F.lds + L_V + (key >> 6) * 8192 + half * 4096 + (kk >> 4) * 1024 + (kk & 15) * 64;
#pragma unroll
        for (int q = 0; q < 4; ++q) { v4u w = vr[q]; if (!valid) w = (v4u){0u, 0u, 0u, 0u}; *(LAS v4u*)(vd + 16 * q) = w; }
    }
    __syncthreads();
    LAS float* wsf = (LAS float*)(F.lds + L_WSF) + wave * 64;
    LAS bf16* stg = (LAS bf16*)(F.lds + L_OST + wave * 4096);
    LAS const unsigned char* vbase = F.lds + L_V + ((lane >> 4) & 1) * 32 + (lane & 3) * 8 + (4 * hi + ((lane & 15) >> 2)) * 64;
#pragma unroll 1
    for (int sbi = 0; sbi < 2; ++sbi) {
        const int sb = wave * 2 + sbi, g = sb >> 2, r0 = (sb & 3) * 32, hq = kvh * 4 + g, tq = tq0 + r0 + r32;
        bf16x8 qr[4];
        {
            const bf16* qp = AQ + (size_t)tq * 512 + hq * 64 + 8 * hi; float x[4][8]; float ss = 0.f;
#pragma unroll
            for (int d0 = 0; d0 < 4; ++d0) { const v4u r = *(const GAS v4u*)(qp + 16 * d0); x[d0][0] = bflo(r.x); x[d0][1] = bfhi(r.x); x[d0][2] = bflo(r.y); x[d0][3] = bfhi(r.y); x[d0][4] = bflo(r.z); x[d0][5] = bfhi(r.z); x[d0][6] = bflo(r.w); x[d0][7] = bfhi(r.w); }
#pragma unroll
            for (int d0 = 0; d0 < 4; ++d0)
#pragma unroll
                for (int j = 0; j < 8; ++j) ss += x[d0][j] * x[d0][j];
            ss += __shfl_xor(ss, 32);
            const float rs = rsqrtf(ss * (1.f / 64.f) + EPS) * SC2;
#pragma unroll
            for (int d0 = 0; d0 < 4; ++d0) { const f32x4 g0 = *(const GAS f32x4*)(F.qg + 16 * d0 + 8 * hi), g1 = *(const GAS f32x4*)(F.qg + 16 * d0 + 8 * hi + 4);
                x[d0][0] *= rs * g0.x; x[d0][1] *= rs * g0.y; x[d0][2] *= rs * g0.z; x[d0][3] *= rs * g0.w; x[d0][4] *= rs * g1.x; x[d0][5] *= rs * g1.y; x[d0][6] *= rs * g1.z; x[d0][7] *= rs * g1.w; }
            const int p = F.pos[tq];
#pragma unroll
            for (int j = 0; j < 8; ++j) { float cs, sn; rope_cs(p, j, cs, sn); const float mine = x[0][j], oth = __shfl_xor(mine, 32); x[0][j] = mine * cs + (hi ? oth : -oth) * sn; }
#pragma unroll
            for (int d0 = 0; d0 < 4; ++d0) { v4u w; w.x = pk2(x[d0][0], x[d0][1]); w.y = pk2(x[d0][2], x[d0][3]); w.z = pk2(x[d0][4], x[d0][5]); w.w = pk2(x[d0][6], x[d0][7]); qr[d0] = __builtin_bit_cast(bf16x8, w); }
        }
        const int kt0 = r0 >> 5, qi = r0 + r32;
        f32x16 p[5];
#pragma unroll
        for (int t = 0; t < 5; ++t) {
            f32x16 a = {};
#pragma unroll
            for (int d0 = 0; d0 < 4; ++d0) { const bf16x8 kf = *(const LAS bf16x8*)(F.lds + L_K + (2 * d0 + hi) * 4096 + (32 * (kt0 + t) + r32) * 16); a = __builtin_amdgcn_mfma_f32_32x32x16_bf16(kf, qr[d0], a, 0, 0, 0); }
#pragma unroll
            for (int r = 0; r < 16; ++r) { const int kk = 32 * (kt0 + t) + crow(r, hi); const bool ok = (kk > qi) && (kk <= qi + 128) && (qb > 0 || kk >= 128); a[r] = ok ? a[r] : -INFINITY; }
            p[t] = a;
        }
        const float sink2 = F.sinks[hq] * 1.4426950408889634f;
        float m = sink2;
#pragma unroll
        for (int t = 0; t < 5; ++t)
#pragma unroll
            for (int r = 0; r < 16; ++r) m = fmaxf(m, p[t][r]);
        m = fmaxf(m, __shfl_xor(m, 32));
        float l = 0.f;
#pragma unroll
        for (int t = 0; t < 5; ++t)
#pragma unroll
            for (int r = 0; r < 16; ++r) { const float e = __builtin_amdgcn_exp2f(p[t][r] - m); p[t][r] = e; l += e; }
        l += __shfl_xor(l, 32);
        l += __builtin_amdgcn_exp2f(sink2 - m);
        f32x16 o[2]; o[0] = (f32x16){}; o[1] = (f32x16){};
#pragma unroll
        for (int t = 0; t < 5; ++t) {
            const int kt = kt0 + t; LAS const unsigned char* vs = vbase + (kt >> 1) * 8192 + (2 * (kt & 1)) * 1024;
#pragma unroll
            for (int s = 0; s < 2; ++s) {
                v4u w; w.x = pk2(p[t][8 * s], p[t][8 * s + 1]); w.y = pk2(p[t][8 * s + 2], p[t][8 * s + 3]); w.z = pk2(p[t][8 * s + 4], p[t][8 * s + 5]); w.w = pk2(p[t][8 * s + 6], p[t][8 * s + 7]);
                const bf16x8 pa = __builtin_bit_cast(bf16x8, w);
#pragma unroll
                for (int d0 = 0; d0 < 2; ++d0) { const bf16x8 vf = vtr2(vs + d0 * 4096 + s * 1024); o[d0] = __builtin_amdgcn_mfma_f32_32x32x16_bf16(pa, vf, o[d0], 0, 0, 0); }
            }
        }
        if (hi == 0) wsf[r32] = l;
        LDS_WAIT(); asm volatile("" ::: "memory");
#pragma unroll
        for (int r = 0; r < 16; ++r) { const int orow = crow(r, hi); const float rl = __builtin_amdgcn_rcpf(wsf[orow]);
#pragma unroll
            for (int d0 = 0; d0 < 2; ++d0) stg[orow * 64 + d0 * 32 + r32] = f2bf(o[d0][r] * rl); }
        LDS_WAIT(); asm volatile("" ::: "memory");
#pragma unroll
        for (int i = 0; i < 4; ++i) { const int row = i * 8 + (lane >> 3), ch = lane & 7; const v4u v = *(const LAS v4u*)(stg + row * 64 + ch * 8);
            *(GAS v4u*)(HOAO + (size_t)(tq0 + r0 + row) * 1024 + 512 + hq * 64 + ch * 8) = v; }
        LDS_WAIT(); asm volatile("" ::: "memory");
    }
    __syncthreads();
}
}

namespace hg {
typedef float f32x2v __attribute__((ext_vector_type(2)));
constexpr int PK = 272, PJ = 144;
constexpr int L_QE = 0, L_KE = 17408, L_KDT = 34816, L_VT = 53248, L_P = 71680, L_ST = 80896, L_OST = 115712, L_SEGP = 149504, L_DK = 153600;
constexpr int OP = 132;
__device__ __forceinline__ void run(Frame& F, int b, int h) {
    const bf16* QH = (const bf16*)(F.ws + WS_QH); const float* LF = (const float*)(F.ws + WS_LF); const bf16* VH = (const bf16*)(F.ws + WS_VH); const bf16* GH = (const bf16*)(F.ws + WS_GH);
    bf16* HOAO = (bf16*)(F.ws + WS_HOAO);
    const int tid = F.tid, lane = F.lane, wave = F.wave, r32 = lane & 31, hi = lane >> 5;
    LAS unsigned char* L = F.lds;
    LAS float* SEGP = (LAS float*)(L + L_SEGP); LAS float* DK = (LAS float*)(L + L_DK); LAS float* OST = (LAS float*)(L + L_OST);
    for (int i = tid; i < (L_OST - L_P) / 16; i += 512) *(LAS v4u*)(L + L_P + i * 16) = (v4u){0u, 0u, 0u, 0u};
    f32x16 st[2]; st[0] = (f32x16){}; st[1] = (f32x16){};
    const int kp2 = 2 * lane;
    const size_t rowb = (size_t)b * SEQ;
    float fv[8][2]; unsigned qv[8], vv[8];
    const int oi = tid >> 3, os = tid & 7;
    float gn[16];
#pragma unroll
    for (int q = 0; q < 4; ++q) { const f32x4 g = *(const GAS f32x4*)(F.hgg + 16 * os + 4 * q); gn[4 * q] = g.x; gn[4 * q + 1] = g.y; gn[4 * q + 2] = g.z; gn[4 * q + 3] = g.w; }
#define HG_LOAD(c) do { _Pragma("unroll") for (int jj = 0; jj < 8; ++jj) { const size_t row = rowb + (size_t)(c) * 64 + 8 * wave + jj; \
        const f32x2v lf = *(const GAS f32x2v*)(LF + row * 512 + h * 128 + kp2); fv[jj][0] = lf.x; fv[jj][1] = lf.y; \
        qv[jj] = *(const GAS unsigned*)(QH + row * 512 + h * 128 + kp2); vv[jj] = *(const GAS unsigned*)(VH + row * 512 + h * 128 + kp2); } } while (0)
#define HG_A1() do { float p0 = 1.f, p1 = 1.f; _Pragma("unroll") for (int jj = 0; jj < 8; ++jj) { fv[jj][0] = __expf(fv[jj][0]); fv[jj][1] = __expf(fv[jj][1]); p0 *= fv[jj][0]; p1 *= fv[jj][1]; } \
        *(LAS f32x2v*)(SEGP + wave * 128 + kp2) = (f32x2v){p0, p1}; } while (0)
    HG_LOAD(0); HG_A1();
    __syncthreads();
#pragma unroll 1
    for (int c = 0; c < SEQ / 64; ++c) {
        {
            float pre0 = 1.f, pre1 = 1.f, all0 = 1.f, all1 = 1.f;
#pragma unroll
            for (int s = 0; s < 8; ++s) { const f32x2v sp = *(const LAS f32x2v*)(SEGP + s * 128 + kp2); all0 *= sp.x; all1 *= sp.y; if (s < wave) { pre0 *= sp.x; pre1 *= sp.y; } }
            if (wave == 0) *(LAS f32x2v*)(DK + kp2) = (f32x2v){all0, all1};
            float e0 = pre0, e1 = pre1; unsigned kd0[4], kd1[4], vt0[4], vt1[4]; float kdp0 = 0.f, kdp1 = 0.f;
#pragma unroll
            for (int jj = 0; jj < 8; ++jj) {
                e0 *= fv[jj][0]; e1 *= fv[jj][1];
                const float k0 = 1.f - fv[jj][0], k1 = 1.f - fv[jj][1];
                const float ke0 = k0 * __builtin_amdgcn_rcpf(e0), ke1 = k1 * __builtin_amdgcn_rcpf(e1);
                const int j = 8 * wave + jj;
                *(LAS unsigned*)(L + L_QE + j * PK + kp2 * 2) = pk2(bflo(qv[jj]) * e0, bfhi(qv[jj]) * e1);
                *(LAS unsigned*)(L + L_KE + j * PK + kp2 * 2) = pk2(ke0, ke1);
                const float d0 = ke0 * all0, d1 = ke1 * all1;
                if (jj & 1) { kd0[jj >> 1] = pk2(kdp0, d0); kd1[jj >> 1] = pk2(kdp1, d1); vt0[jj >> 1] = (vv[jj - 1] & 0xffffu) | (vv[jj] << 16); vt1[jj >> 1] = (vv[jj - 1] >> 16) | (vv[jj] & 0xffff0000u); }
                else { kdp0 = d0; kdp1 = d1; }
            }
            *(LAS v4u*)(L + L_KDT + kp2 * PJ + 16 * wave) = (v4u){kd0[0], kd0[1], kd0[2], kd0[3]};
            *(LAS v4u*)(L + L_KDT + (kp2 + 1) * PJ + 16 * wave) = (v4u){kd1[0], kd1[1], kd1[2], kd1[3]};
            *(LAS v4u*)(L + L_VT + kp2 * PJ + 16 * wave) = (v4u){vt0[0], vt0[1], vt0[2], vt0[3]};
            *(LAS v4u*)(L + L_VT + (kp2 + 1) * PJ + 16 * wave) = (v4u){vt1[0], vt1[1], vt1[2], vt1[3]};
        }
        if (c + 1 < SEQ / 64) HG_LOAD(c + 1);
        const size_t orow = rowb + (size_t)c * 64 + oi;
        const v4u gg0 = *(const GAS v4u*)(GH + orow * 512 + h * 128 + 16 * os), gg1 = *(const GAS v4u*)(GH + orow * 512 + h * 128 + 16 * os + 8);
        __syncthreads();
        for (int tl = wave; tl < 10; tl += 8) {
            int ib = 0, rem = tl; while (rem > ib) { rem -= ib + 1; ++ib; } const int jb = rem;
            typedef float f32x4v __attribute__((ext_vector_type(4)));
            f32x4v a = {0.f, 0.f, 0.f, 0.f}; const int l15 = lane & 15, l4 = lane >> 4;
#pragma unroll
            for (int s = 0; s < 4; ++s) { const bf16x8 af = *(const LAS bf16x8*)(L + L_QE + (16 * ib + l15) * PK + (32 * s + 8 * l4) * 2), bfr = *(const LAS bf16x8*)(L + L_KE + (16 * jb + l15) * PK + (32 * s + 8 * l4) * 2);
                a = __builtin_amdgcn_mfma_f32_16x16x32_bf16(af, bfr, a, 0, 0, 0); }
#pragma unroll
            for (int r = 0; r < 4; ++r) { const int i = 16 * ib + 4 * l4 + r, j = 16 * jb + l15; const float v = (j <= i) ? a[r] : 0.f; *(LAS bf16*)(L + L_P + i * PJ + j * 2) = f2bf(v); }
        }
        const int ib = wave >> 2, vb = wave & 3;
        f32x16 o = {};
#pragma unroll
        for (int s = 0; s < 8; ++s) { const bf16x8 af = *(const LAS bf16x8*)(L + L_QE + (32 * ib + r32) * PK + (16 * s + 8 * hi) * 2), bfr = *(const LAS bf16x8*)(L + L_ST + (32 * vb + r32) * PK + (16 * s + 8 * hi) * 2);
            o = __builtin_amdgcn_mfma_f32_32x32x16_bf16(af, bfr, o, 0, 0, 0); }
#pragma unroll
        for (int q = 0; q < 2; ++q) { const int kb = 2 * (wave >> 2) + q; const float dk = DK[32 * kb + r32];
#pragma unroll
            for (int r = 0; r < 16; ++r) st[q][r] *= dk;
#pragma unroll
            for (int s = 0; s < 4; ++s) { const bf16x8 af = *(const LAS bf16x8*)(L + L_VT + (32 * vb + r32) * PJ + (16 * s + 8 * hi) * 2), bfr = *(const LAS bf16x8*)(L + L_KDT + (32 * kb + r32) * PJ + (16 * s + 8 * hi) * 2);
                st[q] = __builtin_amdgcn_mfma_f32_32x32x16_bf16(af, bfr, st[q], 0, 0, 0); } }
        __syncthreads();
#pragma unroll
        for (int s = 0; s < 4; ++s) { const bf16x8 af = *(const LAS bf16x8*)(L + L_P + (32 * ib + r32) * PJ + (16 * s + 8 * hi) * 2), bfr = *(const LAS bf16x8*)(L + L_VT + (32 * vb + r32) * PJ + (16 * s + 8 * hi) * 2);
            o = __builtin_amdgcn_mfma_f32_32x32x16_bf16(af, bfr, o, 0, 0, 0); }
#pragma unroll
        for (int r = 0; r < 16; ++r) OST[(32 * ib + att::crow(r, hi)) * OP + 32 * vb + r32] = o[r];
#pragma unroll
        for (int q = 0; q < 2; ++q) { const int kb = 2 * (wave >> 2) + q;
#pragma unroll
            for (int r = 0; r < 16; ++r) *(LAS bf16*)(L + L_ST + (32 * vb + att::crow(r, hi)) * PK + (32 * kb + r32) * 2) = f2bf(st[q][r]); }
        if (c + 1 < SEQ / 64) HG_A1();
        __syncthreads();
        {
            float ov[16]; float ss = 0.f;
#pragma unroll
            for (int q = 0; q < 4; ++q) { const f32x4 t = *(const LAS f32x4*)(OST + oi * OP + 16 * os + 4 * q); ov[4 * q] = t.x; ov[4 * q + 1] = t.y; ov[4 * q + 2] = t.z; ov[4 * q + 3] = t.w; ss += (t.x * t.x + t.y * t.y) + (t.z * t.z + t.w * t.w); }
            ss += __shfl_xor(ss, 1); ss += __shfl_xor(ss, 2); ss += __shfl_xor(ss, 4);
            const float rstd = rsqrtf(ss * (1.f / 128.f) + EPS);
            const unsigned gw[8] = {gg0.x, gg0.y, gg0.z, gg0.w, gg1.x, gg1.y, gg1.z, gg1.w}; unsigned ow[8];
#pragma unroll
            for (int q = 0; q < 8; ++q) ow[q] = pk2(ov[2 * q] * rstd * gn[2 * q] * bflo(gw[q]), ov[2 * q + 1] * rstd * gn[2 * q + 1] * bfhi(gw[q]));
            bf16* op = HOAO + orow * 1024 + h * 128 + 16 * os;
            *(GAS v4u*)op = (v4u){ow[0], ow[1], ow[2], ow[3]}; *(GAS v4u*)(op + 8) = (v4u){ow[4], ow[5], ow[6], ow[7]};
        }
    }
#undef HG_LOAD
#undef HG_A1
    __syncthreads();
}
}
__device__ __forceinline__ void p3_mixers(Frame& F, int sub) {
    constexpr int NHG = 64;
    if ((int)blockIdx.x < NHG) { if (sub & 1) { for (int u = blockIdx.x; u < BATCH * 4; u += NHG) hg::run(F, u >> 2, u & 3); } }
    else { const int na = F.G - NHG; if (sub & 2) { for (int u = (int)blockIdx.x - NHG; u < BATCH * 2 * 16; u += na) att::unit(F, u >> 5, (u >> 4) & 1, u & 15); }
        if (sub & 4) moe_weight_copies(F, ((int)blockIdx.x - NHG) * NWAVES + F.wave, na * NWAVES); }
}

struct Args { const void* in[22]; float* out; unsigned char* ws; int ph_lo, ph_hi, one, sub; };
__global__ void __launch_bounds__(NWAVES * 64, 2) skel_fwd(Args args) {
    extern __shared__ __attribute__((aligned(16))) unsigned char lds[];
    Frame F;
    F.lds = (LAS unsigned char*)lds; F.MISC = (volatile LAS unsigned*)(F.lds + MISC_OFF);
    F.tid = threadIdx.x; F.lane = F.tid & 63; F.wave = __builtin_amdgcn_readfirstlane(F.tid >> 6); F.G = gridDim.x;
    F.x = (const float*)args.in[0]; F.c = (const float*)args.in[1]; F.pos = (const int*)args.in[2]; F.w_ada = (const float*)args.in[3]; F.b_ada = (const float*)args.in[4];
    F.n1g = (const float*)args.in[5]; F.w_in = (const float*)args.in[6]; F.lbl = (const float*)args.in[7]; F.hgg = (const float*)args.in[8]; F.w_hg = (const float*)args.in[9];
    F.qg = (const float*)args.in[10]; F.kg = (const float*)args.in[11]; F.sinks = (const float*)args.in[12]; F.w_att = (const float*)args.in[13]; F.w_out = (const float*)args.in[14];
    F.n2g = (const float*)args.in[15]; F.w_r = (const float*)args.in[16]; F.b_r = (const float*)args.in[17]; F.w_up = (const float*)args.in[18]; F.b_up = (const float*)args.in[19];
    F.w_dn = (const float*)args.in[20]; F.b_dn = (const float*)args.in[21]; F.out = args.out; F.ws = args.ws; F.ctl = (gu32*)(args.ws + WS_CTL);
    for (int u = F.tid; u < (LDS_BYTES - LDSCTL_OFF) / 4; u += NWAVES * 64) ((LAS unsigned*)(F.lds + LDSCTL_OFF))[u] = 0u;
    __syncthreads();
    XcdBarrier bar; bar.bar = (unsigned*)(F.ctl + CW_BAR); bar.x = 0; bar.st = nullptr;
    if (args.one) bar = xcd_barrier_post((unsigned*)(F.ctl + CW_BAR), F.MISC + 8);
    const int lo = args.ph_lo, hi = args.ph_hi;
#define IN(k) (lo <= (k) && (k) < hi)
#ifndef PROBE_MASK
#define PROBE_MASK 0
#endif
#define REP(k) for (int rep_ = 0; rep_ < (((PROBE_MASK >> (k)) & 1) ? 2 : 1); ++rep_)
#define RSEAM() do { if (rep_ == 0 && ((PROBE_MASK) != 0)) { if (args.one) xcd_barrier(bar); } } while (0)
#define SEAM(k) do { if (IN(k) && IN((k) + 1)) xcd_barrier(bar); } while (0)
    unsigned char* ws = args.ws;
    if (IN(0)) { REP(0) { p0_prologue(F); if ((PROBE_MASK >> 0) & 1) RSEAM(); } SEAM(0); }
    if (IN(1)) { REP(1) { p1_xn(F); if ((PROBE_MASK >> 1) & 1) RSEAM(); } SEAM(1); }
    if (IN(2)) REP(2) {
        pg8::Gemm g{(const bf16*)(ws + WS_XN), (const bf16*)(ws + WS_WIN), T, INW, 1024, nullptr, 0, 1024}; pg8::StaticOrder S; S.init(T, INW, F.G, (int)blockIdx.x);
        EpiIn E{ws}; pg8::gemm_phase<EpiIn, pg8::StaticOrder, true, 0>(F.lds, g, S, E); if ((PROBE_MASK >> 2) & 1) RSEAM();
    }
    SEAM(2);
    if (IN(3)) { REP(3) { p3_mixers(F, args.sub); if ((PROBE_MASK >> 3) & 1) RSEAM(); } SEAM(3); }
    if (IN(4)) REP(4) {
        pg8::StaticOrder S; S.init(T, 1024, F.G, (int)blockIdx.x);
        { pg8::Gemm g{(const bf16*)(ws + WS_HOAO), (const bf16*)(ws + WS_WHG), T, 1024, 512, nullptr, 0, 1024}; EpiMrg<false> E{(bf16*)(ws + WS_MRG), (const bf16*)(ws + WS_SGH)};
          pg8::gemm_phase<EpiMrg<false>, pg8::StaticOrder, true, 0>(F.lds, g, S, E); }
        { pg8::Gemm g{(const bf16*)(ws + WS_HOAO) + 512, (const bf16*)(ws + WS_WATT), T, 1024, 512, nullptr, 0, 1024}; EpiMrg<true> E{(bf16*)(ws + WS_MRG), (const bf16*)(ws + WS_SGA)};
          pg8::gemm_phase<EpiMrg<true>, pg8::StaticOrder, true, 0>(F.lds, g, S, E); }
        if ((PROBE_MASK >> 4) & 1) RSEAM();
    }
    SEAM(4);
    if (IN(5)) REP(5) {
        pg8::Gemm g{(const bf16*)(ws + WS_MRG), (const bf16*)(ws + WS_WOUT), T, 1024, 1024, nullptr, 0, 1024}; pg8::StaticOrder S; S.init(T, 1024, F.G, (int)blockIdx.x);
        EpiOut E{F.x, (const float*)(ws + WS_MOD), F.out}; pg8::gemm_phase<EpiOut, pg8::StaticOrder, true, 0>(F.lds, g, S, E); if ((PROBE_MASK >> 5) & 1) RSEAM();
    }
    SEAM(5);
    if (IN(6)) { p6_route(F); SEAM(6); }
    if (IN(7)) REP(7) {
        moe_tables(F);
        pg8::Gemm g{(const bf16*)(ws + WS_H2), (const bf16*)(ws + WS_WUP), T, NEXP * 2048, 1024, (const int*)(ws + WS_TOKL), T, 1024}; MoeOrder<8> S{F.MISC, F.G, (int)blockIdx.x};
        EpiUp E{ws + WS_ACT, (const float*)(ws + WS_BUPP)}; pg8::gemm_phase<EpiUp, MoeOrder<8>, true, 1, 1>(F.lds, g, S, E); if ((PROBE_MASK >> 7) & 1) RSEAM();
    }
    SEAM(7);
    if (IN(8)) REP(8) {
        moe_tables(F);
        pg8::Gemm g{(const bf16*)(ws + WS_ACT), (const bf16*)(ws + WS_WDN), T, NEXP * 1024, 1024, (const int*)(ws + WS_IDT), 0, 1024}; MoeOrder<4> S{F.MISC, F.G, (int)blockIdx.x};
        EpiDn E{(bf16*)(ws + WS_Y), F.b_dn}; pg8::gemm_phase<EpiDn, MoeOrder<4>, true, 1, 1>(F.lds, g, S, E); if ((PROBE_MASK >> 8) & 1) RSEAM();
    }
    SEAM(8);
    if (IN(9)) { p9_final(F); }
#undef IN
#undef SEAM
}

#ifndef DEV_MASK
#define DEV_MASK 0x3ff
#ifndef DEV_SUB
#define DEV_SUB 7
#endif
#endif
extern "C" void kernel_launch(void* const* d_in, const int* in_sizes, int n_in, void* d_out, int out_size, void* d_ws, size_t ws_size, hipStream_t stream) {
    static int grid = 0;
    if (grid == 0) {
        if (n_in != 22 || ws_size < WS_END || out_size != T * DM) { fprintf(stderr, "kernel_launch: unexpected shapes n_in %d ws %zu out %d\n", n_in, ws_size, out_size); grid = -1; return; }
        int dev = 0, cus = 0;
        if (hipGetDevice(&dev) != hipSuccess || hipDeviceGetAttribute(&cus, hipDeviceAttributeMultiprocessorCount, dev) != hipSuccess) { grid = -1; return; }
        if (hipFuncSetAttribute((const void*)skel_fwd, hipFuncAttributeMaxDynamicSharedMemorySize, LDS_BYTES) != hipSuccess) { fprintf(stderr, "kernel_launch: hipFuncSetAttribute failed\n"); grid = -1; return; }
        int per_cu = 0;
        if (hipOccupancyMaxActiveBlocksPerMultiprocessor(&per_cu, (const void*)skel_fwd, NWAVES * 64, LDS_BYTES) != hipSuccess || per_cu < 1) { fprintf(stderr, "kernel_launch: occupancy query says %d workgroups per CU; nothing launched\n", per_cu); grid = -1; return; }
        (void)hipGetLastError();
        grid = cus;
    }
    if (grid < 0) return;
    unsigned char* ws = (unsigned char*)d_ws; float* out = (float*)d_out;
#if DEV_ORACLE
    const float* x = (const float*)d_in[0]; const int* pos = (const int*)d_in[2];
    const float* hgg = (const float*)d_in[8]; const float* qg = (const float*)d_in[10]; const float* kg = (const float*)d_in[11];
    const float* sinks = (const float*)d_in[12]; const float* n2g = (const float*)d_in[15]; const float* w_r = (const float*)d_in[16]; const float* b_r = (const float*)d_in[17];
    const float* w_up = (const float*)d_in[18]; const float* b_up = (const float*)d_in[19]; const float* w_dn = (const float*)d_in[20]; const float* b_dn = (const float*)d_in[21];
    float* MOD = (float*)(ws + WS_MOD); float* LB = (float*)(ws + WS_LB);
    bf16* XN = (bf16*)(ws + WS_XN); bf16* QH = (bf16*)(ws + WS_QH); float* LF = (float*)(ws + WS_LF); bf16* VH = (bf16*)(ws + WS_VH); bf16* GH = (bf16*)(ws + WS_GH);
    bf16* AQ = (bf16*)(ws + WS_AQ); bf16* AKV = (bf16*)(ws + WS_AKV); bf16* SGH = (bf16*)(ws + WS_SGH); bf16* SGA = (bf16*)(ws + WS_SGA);
    bf16* HOAO = (bf16*)(ws + WS_HOAO); bf16* MRG = (bf16*)(ws + WS_MRG); bf16* H2 = (bf16*)(ws + WS_H2); bf16* Y = (bf16*)(ws + WS_Y);
    int* TOPI = (int*)(ws + WS_TOPI); float* TOPW = (float*)(ws + WS_TOPW);
    float* OTMP = (float*)(ws + WS_OTMP); float* QN = (float*)(ws + WS_QN); float* KN = (float*)(ws + WS_KN);
#endif
    (void)hipMemsetAsync(ws + WS_CTL, 0, CTL_ZERO_BYTES, stream);
    Args a{}; for (int i = 0; i < 22; ++i) a.in[i] = d_in[i];
    a.out = out; a.ws = ws; a.one = 0;
#if DEV_ORACLE
#ifndef DEV_REP
#define DEV_REP 0
#endif
#define SK(p) do { a.ph_lo = (p); a.ph_hi = (p) + 1; for (int r_ = 0; r_ < (((DEV_REP >> (p)) & 1) ? 2 : 1); ++r_) hipLaunchKernelGGL(skel_fwd, dim3(grid), dim3(NWAVES * 64), LDS_BYTES, stream, a); } while (0)
#define ON(p) ((DEV_MASK >> (p)) & 1)
    if (ON(0)) SK(0); else { n_mod<<<dim3(24, 16), 256, 0, stream>>>((const float*)d_in[1], (const float*)d_in[3], (const float*)d_in[4], MOD); n_misc<<<4, 256, 0, stream>>>((const float*)d_in[7], LB, H2); }
    if (ON(1)) SK(1); else k_normmod<<<T / 4, 256, 0, stream>>>(x, (const float*)d_in[5], MOD, 0, 1024, XN);
    if (ON(2)) SK(2); else n_gemm<EpiInN><<<dim3(INW / 64, T / 64), 256, 0, stream>>>(XN, 1024, (const float*)d_in[6], INW, 1024, EpiInN{QH, LF, VH, GH, AQ, AKV, SGH, SGA, LB});
    a.sub = ON(3) ? DEV_SUB : 0;
    if (a.sub) { a.ph_lo = 3; a.ph_hi = 4; hipLaunchKernelGGL(skel_fwd, dim3(grid), dim3(NWAVES * 64), LDS_BYTES, stream, a);
#ifdef DEV_SUB2
        a.sub = DEV_SUB2; hipLaunchKernelGGL(skel_fwd, dim3(grid), dim3(NWAVES * 64), LDS_BYTES, stream, a); a.sub = DEV_SUB;
#endif
    }
    if (!(a.sub & 1)) { n_hgrn<<<128, 64, 0, stream>>>(QH, LF, VH, OTMP); n_hgrn_norm<<<T, 256, 0, stream>>>(OTMP, hgg, GH, HOAO); }
    if (!(a.sub & 2)) { n_qkn<<<(T * 10 + 255) / 256, 256, 0, stream>>>(AQ, AKV, pos, qg, kg, QN, KN); n_attn<<<T * 8 / 256, 256, 0, stream>>>(QN, KN, AKV, sinks, HOAO); }
    if (ON(4)) SK(4); else {
        n_gemm<EpiM1N><<<dim3(16, T / 64), 256, 0, stream>>>(HOAO, 1024, (const float*)d_in[9], 1024, 512, EpiM1N{MRG, SGH});
        n_gemm<EpiM2N><<<dim3(16, T / 64), 256, 0, stream>>>(HOAO + 512, 1024, (const float*)d_in[13], 1024, 512, EpiM2N{MRG, SGA});
    }
    if (ON(5)) SK(5); else n_gemm<EpiOutN><<<dim3(16, T / 64), 256, 0, stream>>>(MRG, 1024, (const float*)d_in[14], 1024, 1024, EpiOutN{x, MOD, out});
    if (ON(6)) SK(6); else n_route<<<T / 4, 256, 0, stream>>>(out, n2g, MOD, w_r, b_r, H2, TOPI, TOPW);
    if (ON(7) && ON(8)) { SK(7); SK(8); } else n_moe<<<T * 4, 256, 0, stream>>>(H2, TOPI, TOPW, w_up, b_up, w_dn, b_dn, Y);
    if (ON(9)) SK(9); else k_final<<<T / 4, 256, 0, stream>>>(out, MOD, Y);
#else
    a.one = 1; a.sub = 7; a.ph_lo = 0; a.ph_hi = 10;
    hipLaunchKernelGGL(skel_fwd, dim3(grid), dim3(NWAVES * 64), LDS_BYTES, stream, a);
#endif
}
```

```cpp
#include <hip/hip_runtime.h>
#include <cstdio>
#include <cstdint>
#include <cmath>

typedef unsigned short bf16;
constexpr int BATCH = 16, SEQ = 2048, DM = 1024, T = BATCH * SEQ;
constexpr int INW = 4864, NEXP = 32, TOPK = 4, DEXP = 1024;
constexpr float EPS = 1e-6f;

constexpr size_t MiB = 1u << 20;
constexpr size_t WS_CTL = 0;
constexpr size_t WS_MOD = 1 * MiB;
constexpr size_t WS_LB = 1 * MiB + 512 * 1024;
constexpr size_t WS_IDT = 1 * MiB + 768 * 1024;
constexpr size_t WS_BUPP = 2 * MiB;
constexpr size_t WS_TOKL = 4 * MiB;
constexpr size_t WS_GATL = 8 * MiB;
constexpr size_t WS_TOPI = 12 * MiB;
constexpr size_t WS_TOPW = 13 * MiB;
constexpr size_t WS_WIN = 16 * MiB, WS_WHG = 26 * MiB, WS_WATT = 27 * MiB, WS_WOUT = 28 * MiB, WS_WUP = 32 * MiB, WS_WDN = 160 * MiB;
constexpr size_t WS_H2 = 224 * MiB;
constexpr size_t WS_R = 290 * MiB;
constexpr size_t WS_XN = WS_R, WS_QH = WS_R + 64 * MiB, WS_LF = WS_R + 96 * MiB, WS_VH = WS_R + 160 * MiB, WS_GH = WS_R + 192 * MiB,
                 WS_AQ = WS_R + 224 * MiB, WS_AKV = WS_R + 256 * MiB, WS_SGH = WS_R + 272 * MiB, WS_SGA = WS_R + 336 * MiB,
                 WS_HOAO = WS_R + 400 * MiB, WS_MRG = WS_R + 464 * MiB;
constexpr size_t WS_ACT = WS_R, WS_Y = WS_R + 272 * MiB;
constexpr size_t WS_TMP = 820 * MiB;
constexpr size_t WS_OTMP = WS_TMP, WS_QN = WS_TMP + 64 * MiB, WS_KN = WS_TMP + 128 * MiB;
constexpr size_t WS_M1 = 904 * MiB;
constexpr size_t WS_X1B = 840 * MiB;
constexpr size_t WS_END = 968 * MiB;

__device__ __forceinline__ float bf2f(bf16 v) { return __uint_as_float((unsigned)v << 16); }
typedef float f32x2_t __attribute__((ext_vector_type(2))); typedef __bf16 bf16x2_t __attribute__((ext_vector_type(2)));
__device__ __forceinline__ unsigned cvtpk_s(float lo, float hi) { f32x2_t v = {lo, hi}; bf16x2_t b = __builtin_convertvector(v, bf16x2_t); return __builtin_bit_cast(unsigned, b); }
__device__ __forceinline__ bf16 f2bf(float f) { return (bf16)(cvtpk_s(f, f) & 0xffffu); }
__device__ __forceinline__ float silu_f(float x) { return x / (1.f + __expf(-x)); }
__device__ __forceinline__ float sigm_f(float x) { return 1.f / (1.f + __expf(-x)); }
__device__ __forceinline__ float wave_sum(float v) {
#pragma unroll
    for (int o = 1; o < 64; o <<= 1) v += __shfl_xor(v, o);
    return v;
}

__device__ __forceinline__ void rope_cs(int pos, int i, float& cs, float& sn) {
    const float invf = exp2f(-(float)i * 0.125f * 18.931568569324174f);
    double a = (double)pos * (double)invf * 0.15915494309189535; a -= floor(a);
    sn = __builtin_amdgcn_sinf((float)a); cs = __builtin_amdgcn_cosf((float)a);
}
#ifndef DEV_ORACLE
#define DEV_ORACLE 0
#endif
#if DEV_ORACLE
__global__ void n_mod(const float* c, const float* w_ada, const float* b_ada, float* MOD) {
    const int n = blockIdx.x * 256 + threadIdx.x, b = blockIdx.y;
    __shared__ float cond[1024];
    for (int k = threadIdx.x; k < 1024; k += 256) cond[k] = silu_f(c[b * 1024 + k]);
    __syncthreads();
    float acc = 0.f;
    for (int k = 0; k < 1024; ++k) acc += cond[k] * w_ada[(size_t)k * 6144 + n];
    MOD[b * 6144 + n] = acc + b_ada[n];
}
__global__ void n_misc(const float* lbl, float* LB, bf16* H2) {
    const int i = blockIdx.x * 256 + threadIdx.x;
    if (i < 512) LB[i] = 1.f / (1.f + __expf(lbl[512 + i] - lbl[i]));
    if (i < 1024) H2[(size_t)T * 1024 + i] = 0;
}
__global__ void k_normmod(const float* x, const float* gain, const float* MOD, int sh_off, int sc_off, bf16* out) {
    const int lane = threadIdx.x & 63, row = blockIdx.x * 4 + (threadIdx.x >> 6), b = row / SEQ;
    const float4* xr = (const float4*)(x + (size_t)row * DM) + lane;
    float4 v[4]; float s = 0.f;
#pragma unroll
    for (int j = 0; j < 4; ++j) { v[j] = xr[64 * j]; s += v[j].x * v[j].x + v[j].y * v[j].y + v[j].z * v[j].z + v[j].w * v[j].w; }
    const float rstd = rsqrtf(wave_sum(s) * (1.f / DM) + EPS);
    const float* mb = MOD + (size_t)b * 6144;
#pragma unroll
    for (int j = 0; j < 4; ++j) {
        const int c = 4 * lane + 256 * j;
        const float4 g = *(const float4*)(gain + c), sc = *(const float4*)(mb + sc_off + c), sh = *(const float4*)(mb + sh_off + c);
        ushort4 o;
        o.x = f2bf(v[j].x * rstd * g.x * (1.f + sc.x) + sh.x); o.y = f2bf(v[j].y * rstd * g.y * (1.f + sc.y) + sh.y);
        o.z = f2bf(v[j].z * rstd * g.z * (1.f + sc.z) + sh.z); o.w = f2bf(v[j].w * rstd * g.w * (1.f + sc.w) + sh.w);
        *(ushort4*)(out + (size_t)row * DM + c) = o;
    }
}
template <class Epi> __global__ void n_gemm(const bf16* A, int lda, const float* W, int N, int K, Epi epi) {
    __shared__ float As[16][65], Ws[16][65];
    const int tx = threadIdx.x & 15, ty = threadIdx.x >> 4, m0 = blockIdx.y * 64, n0 = blockIdx.x * 64;
    float acc[4][4];
#pragma unroll
    for (int i = 0; i < 4; ++i)
#pragma unroll
        for (int j = 0; j < 4; ++j) acc[i][j] = 0.f;
    for (int k0 = 0; k0 < K; k0 += 16) {
        for (int i = threadIdx.x; i < 1024; i += 256) { const int r = i >> 4, kk = i & 15; As[kk][r] = bf2f(A[(size_t)(m0 + r) * lda + k0 + kk]); }
        for (int i = threadIdx.x; i < 1024; i += 256) { const int kk = i >> 6, cc = i & 63; Ws[kk][cc] = W[(size_t)(k0 + kk) * N + n0 + cc]; }
        __syncthreads();
#pragma unroll
        for (int kk = 0; kk < 16; ++kk) {
            float a[4], b[4];
#pragma unroll
            for (int i = 0; i < 4; ++i) { a[i] = As[kk][ty * 4 + i]; b[i] = Ws[kk][tx * 4 + i]; }
#pragma unroll
            for (int i = 0; i < 4; ++i)
#pragma unroll
                for (int j = 0; j < 4; ++j) acc[i][j] += a[i] * b[j];
        }
        __syncthreads();
    }
#pragma unroll
    for (int i = 0; i < 4; ++i)
#pragma unroll
        for (int j = 0; j < 4; ++j) epi(m0 + ty * 4 + i, n0 + tx * 4 + j, acc[i][j]);
}
struct EpiInN {
    bf16* QH; float* LF; bf16 *VH, *GH, *AQ, *AKV, *SGH, *SGA; const float* LB;
    __device__ void operator()(int r, int c, float v) const {
        if (c < 512) QH[(size_t)r * 512 + c] = f2bf(silu_f(v));
        else if (c < 1024) { const int cc = c - 512; const float lb = LB[cc]; LF[(size_t)r * 512 + cc] = __logf(lb + (1.f - lb) * sigm_f(v)); }
        else if (c < 1536) VH[(size_t)r * 512 + (c - 1024)] = f2bf(v);
        else if (c < 2048) GH[(size_t)r * 512 + (c - 1536)] = f2bf(silu_f(v));
        else if (c < 2560) AQ[(size_t)r * 512 + (c - 2048)] = f2bf(v);
        else if (c < 2816) AKV[(size_t)r * 256 + (c - 2560)] = f2bf(v);
        else if (c < 3840) SGH[(size_t)r * 1024 + (c - 2816)] = f2bf(sigm_f(v));
        else SGA[(size_t)r * 1024 + (c - 3840)] = f2bf(sigm_f(v));
    }
};
struct EpiM1N { bf16* MRG; const bf16* SG; __device__ void operator()(int r, int c, float v) const { MRG[(size_t)r * 1024 + c] = f2bf(bf2f(SG[(size_t)r * 1024 + c]) * v); } };
struct EpiM2N { bf16* MRG; const bf16* SG; __device__ void operator()(int r, int c, float v) const { MRG[(size_t)r * 1024 + c] = f2bf(bf2f(MRG[(size_t)r * 1024 + c]) + bf2f(SG[(size_t)r * 1024 + c]) * v); } };
struct EpiOutN { const float* x; const float* MOD; float* out; __device__ void operator()(int r, int c, float v) const { out[(size_t)r * 1024 + c] = x[(size_t)r * 1024 + c] + MOD[(size_t)(r / SEQ) * 6144 + 2048 + c] * v; } };

__global__ void n_hgrn(const bf16* QH, const float* LF, const bf16* VH, float* OTMP) {
    const int bh = blockIdx.x >> 1, vh = blockIdx.x & 1, b = bh >> 2, h = bh & 3, v = threadIdx.x;
    __shared__ float S[128 * 64];
    __shared__ float sq[128], sf[128], sk[128];
    for (int i = v; i < 128 * 64; i += 64) S[i] = 0.f;
    for (int t = 0; t < SEQ; ++t) {
        const size_t row = (size_t)b * SEQ + t;
        __syncthreads();
        for (int k = v; k < 128; k += 64) { const float lf = LF[row * 512 + h * 128 + k]; const float f = __expf(lf); sf[k] = f; sk[k] = 1.f - f; sq[k] = bf2f(QH[row * 512 + h * 128 + k]); }
        __syncthreads();
        const float vv = bf2f(VH[row * 512 + h * 128 + vh * 64 + v]);
        float o = 0.f;
        for (int k = 0; k < 128; ++k) { float s = S[k * 64 + v]; s = sf[k] * s + sk[k] * vv; S[k * 64 + v] = s; o += s * sq[k]; }
        OTMP[row * 512 + h * 128 + vh * 64 + v] = o;
    }
}
__global__ void n_hgrn_norm(const float* OTMP, const float* gain, const bf16* GH, bf16* HOAO) {
    const int lane = threadIdx.x & 63, idx = blockIdx.x * 4 + (threadIdx.x >> 6), t = idx >> 2, h = idx & 3;
    const float a = OTMP[(size_t)t * 512 + h * 128 + lane], b = OTMP[(size_t)t * 512 + h * 128 + 64 + lane];
    const float rstd = rsqrtf(wave_sum(a * a + b * b) * (1.f / 128.f) + EPS);
    HOAO[(size_t)t * 1024 + h * 128 + lane] = f2bf(a * rstd * gain[lane] * bf2f(GH[(size_t)t * 512 + h * 128 + lane]));
    HOAO[(size_t)t * 1024 + h * 128 + 64 + lane] = f2bf(b * rstd * gain[64 + lane] * bf2f(GH[(size_t)t * 512 + h * 128 + 64 + lane]));
}
__global__ void n_qkn(const bf16* AQ, const bf16* AKV, const int* pos, const float* qg, const float* kg, float* QN, float* KN) {
    const int idx = blockIdx.x * 256 + threadIdx.x, t = idx / 10, j = idx % 10;
    if (t >= T) return;
    const bf16* src = j < 8 ? AQ + (size_t)t * 512 + j * 64 : AKV + (size_t)t * 256 + (j - 8) * 64;
    const float* g = j < 8 ? qg : kg;
    float* dst = j < 8 ? QN + (size_t)t * 512 + j * 64 : KN + (size_t)t * 128 + (j - 8) * 64;
    float ss = 0.f;
    for (int d = 0; d < 64; ++d) { const float v = bf2f(src[d]); ss += v * v; }
    const float rstd = rsqrtf(ss * (1.f / 64.f) + EPS);
    const int p = pos[t];
    for (int d = 0; d < 64; ++d) {
        float v = bf2f(src[d]) * rstd * g[d];
        if (d < 16) {
            const int i = d & 7; float cs, sn; rope_cs(p, i, cs, sn);
            const float x1 = bf2f(src[i]) * rstd * g[i], x2 = bf2f(src[i + 8]) * rstd * g[i + 8];
            v = d < 8 ? x1 * cs - x2 * sn : x2 * cs + x1 * sn;
        }
        dst[d] = v;
    }
}
__global__ void __launch_bounds__(256) n_attn(const float* QN, const float* KN, const bf16* AKV, const float* sinks, bf16* HOAO) {
    const int idx = blockIdx.x * 256 + threadIdx.x, t = idx >> 3, hq = idx & 7, kvh = hq >> 2, ts = t % SEQ, b0 = t - ts;
    float q[64], acc[64];
#pragma unroll
    for (int d = 0; d < 64; ++d) { q[d] = QN[(size_t)t * 512 + hq * 64 + d] * 0.125f; acc[d] = 0.f; }
    float m = sinks[hq], l = 1.f;
    for (int kt = (ts >= 127 ? ts - 127 : 0); kt <= ts; ++kt) {
        const float* kr = KN + (size_t)(b0 + kt) * 128 + kvh * 64; const bf16* vr = AKV + (size_t)(b0 + kt) * 256 + 128 + kvh * 64;
        float s = 0.f;
#pragma unroll
        for (int d = 0; d < 64; ++d) s += q[d] * kr[d];
        const float mn = fmaxf(m, s), sc = __expf(m - mn), p = __expf(s - mn);
        l = l * sc + p; m = mn;
#pragma unroll
        for (int d = 0; d < 64; ++d) acc[d] = acc[d] * sc + p * bf2f(vr[d]);
    }
    const float il = 1.f / l;
#pragma unroll
    for (int d = 0; d < 64; ++d) HOAO[(size_t)t * 1024 + 512 + hq * 64 + d] = f2bf(acc[d] * il);
}
__global__ void __launch_bounds__(256) n_route(const float* x1, const float* gain, const float* MOD, const float* wr, const float* br, bf16* H2, int* TOPI, float* TOPW) {
    const int lane = threadIdx.x & 63, row = blockIdx.x * 4 + (threadIdx.x >> 6), b = row / SEQ;
    const float4* xr = (const float4*)(x1 + (size_t)row * DM) + lane;
    float4 v[4]; float s = 0.f;
#pragma unroll
    for (int j = 0; j < 4; ++j) { v[j] = xr[64 * j]; s += v[j].x * v[j].x + v[j].y * v[j].y + v[j].z * v[j].z + v[j].w * v[j].w; }
    const float rstd = rsqrtf(wave_sum(s) * (1.f / DM) + EPS);
    const float* mb = MOD + (size_t)b * 6144;
    float hv[16];
#pragma unroll
    for (int j = 0; j < 4; ++j) {
        const int c = 4 * lane + 256 * j;
        const float4 g = *(const float4*)(gain + c), sc = *(const float4*)(mb + 4096 + c), sh = *(const float4*)(mb + 3072 + c);
        hv[4 * j + 0] = v[j].x * rstd * g.x * (1.f + sc.x) + sh.x; hv[4 * j + 1] = v[j].y * rstd * g.y * (1.f + sc.y) + sh.y;
        hv[4 * j + 2] = v[j].z * rstd * g.z * (1.f + sc.z) + sh.z; hv[4 * j + 3] = v[j].w * rstd * g.w * (1.f + sc.w) + sh.w;
        ushort4 o; o.x = f2bf(hv[4 * j]); o.y = f2bf(hv[4 * j + 1]); o.z = f2bf(hv[4 * j + 2]); o.w = f2bf(hv[4 * j + 3]);
        *(ushort4*)(H2 + (size_t)row * DM + c) = o;
    }
    float lg[32];
#pragma unroll
    for (int e = 0; e < 32; ++e) {
        float p = 0.f;
#pragma unroll
        for (int j = 0; j < 4; ++j)
#pragma unroll
            for (int i = 0; i < 4; ++i) p += hv[4 * j + i] * wr[(size_t)(4 * lane + 256 * j + i) * 32 + e];
        lg[e] = wave_sum(p) + br[e];
    }
    unsigned used = 0u; float tv[4]; int ti[4];
#pragma unroll
    for (int k = 0; k < 4; ++k) {
        float best = -INFINITY; int bi = 0;
#pragma unroll
        for (int e = 0; e < 32; ++e) { const bool ok = !((used >> e) & 1u) && lg[e] > best; best = ok ? lg[e] : best; bi = ok ? e : bi; }
        used |= 1u << bi; tv[k] = best; ti[k] = bi;
    }
    const float e1 = __expf(tv[1] - tv[0]), e2 = __expf(tv[2] - tv[0]), e3 = __expf(tv[3] - tv[0]), inv = 1.f / (1.f + e1 + e2 + e3);
    if (lane == 0) {
        TOPI[row * 4 + 0] = ti[0]; TOPI[row * 4 + 1] = ti[1]; TOPI[row * 4 + 2] = ti[2]; TOPI[row * 4 + 3] = ti[3];
        TOPW[row * 4 + 0] = inv; TOPW[row * 4 + 1] = e1 * inv; TOPW[row * 4 + 2] = e2 * inv; TOPW[row * 4 + 3] = e3 * inv;
    }
}
__global__ void n_moe(const bf16* H2, const int* TOPI, const float* TOPW, const float* w_up, const float* b_up, const float* w_dn, const float* b_dn, bf16* Y) {
    const int a = blockIdx.x, t = a >> 2, tid = threadIdx.x, e = TOPI[a];
    const float gate = TOPW[a];
    __shared__ float hr[1024], av[1024];
    for (int k = tid; k < 1024; k += 256) hr[k] = bf2f(H2[(size_t)t * 1024 + k]);
    __syncthreads();
    const float* wu = w_up + (size_t)e * 1024 * 2048; const float* bu = b_up + (size_t)e * 2048;
    float ag[4], al[4];
#pragma unroll
    for (int j = 0; j < 4; ++j) { ag[j] = 0.f; al[j] = 0.f; }
    for (int k = 0; k < 1024; ++k) {
        const float h = hr[k];
#pragma unroll
        for (int j = 0; j < 4; ++j) { const float2 w = *(const float2*)(wu + (size_t)k * 2048 + 2 * (tid + 256 * j)); ag[j] += h * w.x; al[j] += h * w.y; }
    }
#pragma unroll
    for (int j = 0; j < 4; ++j) {
        const int o = tid + 256 * j;
        const float g = fminf(ag[j] + bu[2 * o], 7.f), li = fminf(fmaxf(al[j] + bu[2 * o + 1], -7.f), 7.f);
        av[o] = g * sigm_f(1.702f * g) * (li + 1.f);
    }
    __syncthreads();
    const float* wd = w_dn + (size_t)e * 1024 * 1024; const float* bd = b_dn + (size_t)e * 1024;
    float y[4];
#pragma unroll
    for (int j = 0; j < 4; ++j) y[j] = 0.f;
    for (int k = 0; k < 1024; ++k) {
        const float h = av[k];
#pragma unroll
        for (int j = 0; j < 4; ++j) y[j] += h * wd[(size_t)k * 1024 + tid + 256 * j];
    }
#pragma unroll
    for (int j = 0; j < 4; ++j) Y[(size_t)a * 1024 + tid + 256 * j] = f2bf(gate * (y[j] + bd[tid + 256 * j]));
}
__global__ void k_final(float* out, const float* MOD, const bf16* Y) {
    const int lane = threadIdx.x & 63, row = blockIdx.x * 4 + (threadIdx.x >> 6), b = row / SEQ;
    const float* g2 = MOD + (size_t)b * 6144 + 5120;
#pragma unroll
    for (int j = 0; j < 4; ++j) {
        const int c = 4 * lane + 256 * j;
        float4 x = *(float4*)(out + (size_t)row * DM + c); const float4 g = *(const float4*)(g2 + c);
        float s0 = 0.f, s1 = 0.f, s2 = 0.f, s3 = 0.f;
#pragma unroll
        for (int k = 0; k < 4; ++k) { const ushort4 y = *(const ushort4*)(Y + ((size_t)row * 4 + k) * DM + c); s0 += bf2f(y.x); s1 += bf2f(y.y); s2 += bf2f(y.z); s3 += bf2f(y.w); }
        x.x += g.x * s0; x.y += g.y * s1; x.z += g.z * s2; x.w += g.w * s3;
        *(float4*)(out + (size_t)row * DM + c) = x;
    }
}

#endif

namespace pg8 {
#define PG8_LAS __attribute__((address_space(3)))
typedef unsigned short bf16_t;
typedef short bf16x8 __attribute__((ext_vector_type(8)));
typedef float f32x4 __attribute__((ext_vector_type(4)));
typedef unsigned u32x4 __attribute__((ext_vector_type(4))); typedef int v4i32_t __attribute__((ext_vector_type(4)));
constexpr int BM = 256, BK = 64, HALF = 128, HTB = HALF * BK * 2  , STAGE_BYTES = 8 * HTB, NXCD = 8, WGM = 8, MAXU = 24  ;

__host__ __device__ __forceinline__ int lds_byte(int r, int c) { const int st = (r >> 4) * 2 + (c >> 5), rr = r & 15, cc = c & 31, ob = rr * 64 + cc * 2; return st * 1024 + (ob ^ (((ob >> 9) & 1) << 5)); }
__host__ __device__ __forceinline__ void stage_rc(int b, int& R, int& C) { const int st = b / 1024, sb = b % 1024, swz = sb ^ (((sb >> 9) & 1) << 5); R = (st >> 1) * 16 + swz / 64; C = (st & 1) * 32 + (swz % 64) / 2; }
__host__ __device__ __forceinline__ int perm32(int rho) { const int n = rho >> 4, i = rho & 15; return 8 * (i >> 2) + 4 * n + (i & 3); }

struct Unit { int pm, pn, arow0, nvalid; unsigned abase; };
struct Gemm { const bf16_t* A; const bf16_t* Bt; int M, N, K; const int* rowidx; int zero_row; int lda; };

struct StaticOrder {
    int nM, nN, nwg, G, c; unsigned abase_per_pm;
    __host__ __device__ void init(int M, int N, int G_, int c_) { nM = M / BM; nN = N / BM; nwg = nM * nN; G = G_; c = c_; abase_per_pm = 0u; }
    __host__ __device__ bool next(int i, Unit& u) const {
        const long L = (long)i * G + c; if (L >= nwg) return false;
        int wgid = (int)L; { const int q = nwg / NXCD, r = nwg % NXCD, xcd = wgid % NXCD, off = wgid / NXCD; wgid = (xcd < r ? xcd * (q + 1) : r * (q + 1) + (xcd - r) * q) + off; }
        const int nig = WGM * nN, gid = wgid / nig, fm = gid * WGM, gsz = (nM - fm) < WGM ? (nM - fm) : WGM;
        u.pm = fm + ((wgid % nig) % gsz); u.pn = (wgid % nig) / gsz; u.arow0 = 0; u.nvalid = 0; u.abase = (unsigned)u.pm * abase_per_pm; return true;
    }
};
constexpr int UT_OFF = STAGE_BYTES + MAXU * 512;
struct CachedOrder {
    const PG8_LAS int* tab; int n;
    template <class Sched> __device__ __forceinline__ void build(PG8_LAS unsigned char* lds, const Sched& S) {
        PG8_LAS int* t = (PG8_LAS int*)(lds + UT_OFF);
        if (threadIdx.x < 64) { Unit u; u.pm = 0; u.pn = 0; u.arow0 = 0; u.nvalid = 0; u.abase = 0u; const int i = threadIdx.x; const bool ok = (i < MAXU) && S.next(i, u);
            if (ok) { t[8 * i] = u.pm; t[8 * i + 1] = u.pn; t[8 * i + 2] = u.arow0; t[8 * i + 3] = u.nvalid; t[8 * i + 4] = (int)u.abase; }
            const unsigned long long m = __ballot(ok); if (i == 0) t[8 * MAXU] = __popcll(m); }
        __syncthreads();
        tab = t; n = __builtin_amdgcn_readfirstlane(t[8 * MAXU]);
    }
    __device__ __forceinline__ bool next(int i, Unit& u) const {
        if (i >= n) return false;
        const v4i32_t a = *(const PG8_LAS v4i32_t*)(tab + 8 * i); u.pm = __builtin_amdgcn_readfirstlane(a.x); u.pn = __builtin_amdgcn_readfirstlane(a.y); u.arow0 = __builtin_amdgcn_readfirstlane(a.z); u.nvalid = __builtin_amdgcn_readfirstlane(a.w);
        u.abase = (unsigned)__builtin_amdgcn_readfirstlane(tab[8 * i + 4]); return true;
    }
};
__device__ __forceinline__ unsigned cvt_pk_bf16(float lo, float hi) { unsigned r; asm volatile("v_cvt_pk_bf16_f32 %0, %1, %2" : "=v"(r) : "v"(lo), "v"(hi)); return r; }

__host__ __device__ __forceinline__ int tk_pos(int r) { return (r & 63) * 4 + ((r >> 7) & 1) + 2 * ((r >> 6) & 1); }
typedef int v8i32 __attribute__((ext_vector_type(8))); typedef int v4i32 __attribute__((ext_vector_type(4)));
template <class Epi, class Sched, bool ALIGN_EPI, int GATHER, int EB = 2, int PROBE = 0, int STAMP = 0>
__device__ __forceinline__ void gemm_phase(PG8_LAS unsigned char* lds, const Gemm g, const Sched& S, const Epi& E, unsigned long long* dbg = nullptr) {
    unsigned long long st_all = 0, st_k = 0, st_e = 0, st_t = 0; if constexpr (STAMP) st_all = __builtin_amdgcn_s_memrealtime();
    const int tid = threadIdx.x, wid = __builtin_amdgcn_readfirstlane(tid >> 6), lane = tid & 63, wr = wid >> 2, wc = wid & 3, fr = lane & 15, fq = lane >> 4;
    const int K = g.K, nt = K * EB / (BK * 2), lda = g.lda;
    unsigned voffA[2], voffB[2];
#pragma unroll
    for (int i = 0; i < 2; ++i) { int R, C; stage_rc(tid * 16 + i * 8192, R, C); const int Rb = Epi::PERM ? ((R & ~31) + perm32(R & 31)) : R;
        voffA[i] = (unsigned)(R * lda * EB + C * 2); voffB[i] = (unsigned)(Rb * K * EB + C * 2); }
    unsigned tokP[2], cpk = 0, abase = 0;
    const size_t kstep = (size_t)(BK * 2);
    const size_t hstep = (size_t)HALF * K * EB;
    const size_t hstepA = GATHER ? 0 : (size_t)HALF * lda * EB; const size_t tstepA = (size_t)BM * lda * EB;
    const size_t tstep = 2 * hstep;
    const unsigned ldsw = (unsigned)wid * 1024u;
    const int aoff = lds_byte(wr * 64 + fr, fq * 8), boff = lds_byte(wc * 32 + fr, fq * 8);
#define PG8_SA(b, h) (((b) * 2 + (h)) * HTB)
#define PG8_SB(b, h) ((4 + (b) * 2 + (h)) * HTB)
#define PG8_STAGE(bufoff, gbase, voff) do { _Pragma("unroll") for (int _i = 0; _i < 2; ++_i) \
        __builtin_amdgcn_global_load_lds((const unsigned*)((const char*)(gbase) + (voff)[_i]), (PG8_LAS unsigned*)(lds + (bufoff) + ldsw + _i * 8192), 16, 0, 0); } while (0)
#define PG8_STAGE_A(b, h, gbase) do { if constexpr (PROBE == 2) { PG8_STAGE(PG8_SA(b, h), cB, voffB); } else if constexpr (GATHER) { _Pragma("unroll") for (int _i = 0; _i < 2; ++_i) { const unsigned off_ = ((tokP[_i] >> (16 * (h))) & 0xffffu) * (unsigned)(lda * EB) + ((cpk >> (8 * _i)) & 0xffu) + abase; \
        __builtin_amdgcn_global_load_lds((const unsigned*)((const char*)(gbase) + off_), (PG8_LAS unsigned*)(lds + PG8_SA(b, h) + ldsw + _i * 8192), 16, 0, 0); } } else { PG8_STAGE(PG8_SA(b, h), (gbase) + (h) * hstepA, voffA); } } while (0)
#define PG8_GOFF(dst, uo) do { if constexpr (GATHER == 1) { int R_, C_; stage_rc(tid * 16, R_, C_); const unsigned long long tn_ = *(const PG8_LAS unsigned long long*)(lds + STAGE_BYTES + (uo) * 512 + R_ * 8); dst[0] = (unsigned)tn_; dst[1] = (unsigned)(tn_ >> 32); } \
        else { int R_, C_; stage_rc(tid * 16, R_, C_); dst[0] = (unsigned)R_ | ((unsigned)(HALF + R_) << 16); dst[1] = (unsigned)(R_ + 64) | ((unsigned)(HALF + 64 + R_) << 16); } } while (0)
#define PG8_LD8(addr) __builtin_shufflevector(*(const PG8_LAS v4i32*)(addr), *(const PG8_LAS v4i32*)((addr) + 1024), 0, 1, 2, 3, 4, 5, 6, 7)
#define PG8_LDA(dst, b, h) do { if constexpr (EB == 2) { _Pragma("unroll") for (int m = 0; m < 4; ++m) _Pragma("unroll") for (int k = 0; k < 2; ++k) dst[m][k] = *(const PG8_LAS bf16x8*)(lds + PG8_SA(b, h) + aoff + m * 2048 + k * 1024); } \
        else { _Pragma("unroll") for (int m = 0; m < 4; ++m) dst##8[m] = PG8_LD8(lds + PG8_SA(b, h) + aoff + m * 2048); } } while (0)
#define PG8_LDB(dst, b, h) do { if constexpr (EB == 2) { _Pragma("unroll") for (int n = 0; n < 2; ++n) _Pragma("unroll") for (int k = 0; k < 2; ++k) dst[n][k] = *(const PG8_LAS bf16x8*)(lds + PG8_SB(b, h) + boff + n * 2048 + k * 1024); } \
        else { _Pragma("unroll") for (int n = 0; n < 2; ++n) dst##8[n] = PG8_LD8(lds + PG8_SB(b, h) + boff + n * 2048); } } while (0)
#define PG8_MMA(ai, bj, At, Bt) do { __builtin_amdgcn_s_setprio(1); if constexpr (EB == 2) { _Pragma("unroll") for (int m = 0; m < 4; ++m) _Pragma("unroll") for (int n = 0; n < 2; ++n) _Pragma("unroll") for (int k = 0; k < 2; ++k) \
        acc[ai][bj][m][n] = __builtin_amdgcn_mfma_f32_16x16x32_bf16(Bt[n][k], At[m][k], acc[ai][bj][m][n], 0, 0, 0); } else { _Pragma("unroll") for (int m = 0; m < 4; ++m) _Pragma("unroll") for (int n = 0; n < 2; ++n) \
        acc[ai][bj][m][n] = __builtin_amdgcn_mfma_scale_f32_16x16x128_f8f6f4(Bt##8[n], At##8[m], acc[ai][bj][m][n], 0, 0, 0, 0x7F7F7F7F, 0, 0x7F7F7F7F); } __builtin_amdgcn_s_setprio(0); } while (0)
#define PG8_WAIT_V(n) asm volatile("s_waitcnt vmcnt(" #n ")" ::: "memory")
#define PG8_WAIT_VX(flag) do { if constexpr (Epi::NST > 0) { asm volatile("s_cmp_lg_u32 %0, 0\n\ts_cbranch_scc1 .LWX%=\n\ts_waitcnt vmcnt(8)\n\ts_branch .LWY%=\n.LWX%=:\n\ts_waitcnt vmcnt(%1)\n.LWY%=:" :: "s"(flag), "i"(8 + Epi::NST) : "memory", "scc"); } \
        else { asm volatile("s_waitcnt vmcnt(8)" ::: "memory"); } } while (0)
#define PG8_WAIT_L(n) asm volatile("s_waitcnt lgkmcnt(" #n ")" ::: "memory")
#define PG8_BAR __builtin_amdgcn_s_barrier()
#define PG8_SCHED __builtin_amdgcn_sched_barrier(0)
    Unit cur, nxt; int ui = 0;
    if (!S.next(0, cur)) return;
    f32x4 acc[2][2][4][2];
#pragma unroll
    for (int a = 0; a < 2; ++a)
#pragma unroll
        for (int b = 0; b < 2; ++b)
#pragma unroll
            for (int m = 0; m < 4; ++m)
#pragma unroll
                for (int n = 0; n < 2; ++n) acc[a][b][m][n] = (f32x4){0.f, 0.f, 0.f, 0.f};
    bf16x8 At[4][2], B0[2][2], B1[2][2]; v8i32 At8[4], B08[2], B18[2];
    const char* cA = GATHER ? (const char*)g.A : (const char*)g.A + (size_t)cur.pm * tstepA; const char* cB = (const char*)g.Bt + (size_t)cur.pn * tstep;
    if constexpr (GATHER != 0) abase = cur.abase;
    if constexpr (GATHER) { PG8_GOFF(tokP, 0); int R0_, C0_, R1_, C1_; stage_rc(tid * 16, R0_, C0_); stage_rc(tid * 16 + 8192, R1_, C1_); cpk = (unsigned)(C0_ * 2) | ((unsigned)(C1_ * 2) << 8); }
    PG8_STAGE(PG8_SB(0, 0), cB, voffB); PG8_STAGE(PG8_SB(0, 1), cB + hstep, voffB); PG8_STAGE_A(0, 0, cA); PG8_STAGE_A(0, 1, cA);
    if (wr == 1) PG8_BAR;
    PG8_WAIT_V(2); PG8_BAR;
    PG8_STAGE(PG8_SB(1, 0), cB + kstep, voffB); PG8_STAGE_A(1, 0, cA + kstep); PG8_STAGE(PG8_SB(1, 1), cB + hstep + kstep, voffB);
    PG8_WAIT_V(6); PG8_BAR;
    for (;;) {
        const bool has_next = S.next(ui + 1, nxt);
        const char* nA = GATHER ? cA : (has_next ? (const char*)g.A + (size_t)nxt.pm * tstepA : cA); const char* nB = has_next ? (const char*)g.Bt + (size_t)nxt.pn * tstep : cB;
        if constexpr (STAMP) st_t = __builtin_amdgcn_s_memrealtime();
#pragma nounroll
        for (int t = 0; t < nt; t += 2) {
            const bool last = (t == nt - 2);
            const int relax_ = __builtin_amdgcn_readfirstlane((t == 0 && ui > 0) ? 1 : 0);
            if constexpr (GATHER != 0) asm volatile("" : "+v"(tokP[0]), "+v"(tokP[1]), "+v"(cpk));
            const char* a1 = cA + (size_t)(t + 1) * kstep;
            const char* a2 = last ? nA : cA + (size_t)(t + 2) * kstep; const char* b2 = last ? nB : cB + (size_t)(t + 2) * kstep;
            const char* a3 = a2 + kstep; const char* b3 = b2 + kstep;
            PG8_LDB(B0, 0, 0); PG8_LDB(B1, 0, 1); PG8_SCHED; PG8_LDA(At, 0, 0); PG8_STAGE_A(1, 1, a1);
            PG8_WAIT_VX(relax_);
            PG8_WAIT_L(0); PG8_BAR; PG8_MMA(0, 0, At, B0); if constexpr (PROBE != 1) PG8_MMA(0, 1, At, B1); PG8_BAR; PG8_SCHED;
            if constexpr (GATHER != 0) { if (last && has_next) abase = nxt.abase; }
            if constexpr (GATHER == 1) { if (last && has_next) { PG8_GOFF(tokP, ui + 1); } }
            PG8_LDA(At, 0, 1); PG8_STAGE(PG8_SB(0, 0), b2, voffB); PG8_STAGE(PG8_SB(0, 1), b2 + hstep, voffB); PG8_STAGE_A(0, 0, a2);
            PG8_WAIT_VX(relax_);
            PG8_WAIT_L(0); PG8_BAR; PG8_MMA(1, 0, At, B0); if constexpr (PROBE != 1) PG8_MMA(1, 1, At, B1); PG8_BAR; PG8_SCHED;
            PG8_LDB(B0, 1, 0); PG8_LDB(B1, 1, 1); PG8_SCHED; PG8_LDA(At, 1, 0); PG8_STAGE_A(0, 1, a2);
            PG8_WAIT_V(8); PG8_WAIT_L(0); PG8_BAR; PG8_MMA(0, 0, At, B0); if constexpr (PROBE != 1) PG8_MMA(0, 1, At, B1); PG8_BAR; PG8_SCHED;
            PG8_LDA(At, 1, 1); PG8_STAGE(PG8_SB(1, 0), b3, voffB); PG8_STAGE(PG8_SB(1, 1), b3 + hstep, voffB); PG8_STAGE_A(1, 0, a3);
            PG8_WAIT_V(8); PG8_WAIT_L(0); PG8_BAR; PG8_MMA(1, 0, At, B0); if constexpr (PROBE != 1) PG8_MMA(1, 1, At, B1); PG8_BAR; PG8_SCHED;
        }
        if constexpr (STAMP) { const unsigned long long n_ = __builtin_amdgcn_s_memrealtime(); st_k += n_ - st_t; st_t = n_; }
        if constexpr (ALIGN_EPI) { if (wr == 0) PG8_BAR; }
        bool keep = false;
        if constexpr (Epi::HAS_MID) { if (cur.nvalid == 1) { E.mid(acc, cur, wr, wc, fr, fq); keep = true; } else { E(acc, cur, wr, wc, fr, fq); } } else { E(acc, cur, wr, wc, fr, fq); }
        if constexpr (STAMP) { const unsigned long long n_ = __builtin_amdgcn_s_memrealtime(); st_e += n_ - st_t; }
        if (!has_next) break;
        if (!keep) {
#pragma unroll
        for (int a = 0; a < 2; ++a)
#pragma unroll
            for (int b = 0; b < 2; ++b)
#pragma unroll
                for (int m = 0; m < 4; ++m)
#pragma unroll
                    for (int n = 0; n < 2; ++n) acc[a][b][m][n] = (f32x4){0.f, 0.f, 0.f, 0.f};
        }
        cur = nxt; cA = nA; cB = nB; ++ui;
        if constexpr (ALIGN_EPI) { if (wr == 1) PG8_BAR; }
    }
    PG8_WAIT_V(0);
    if constexpr (!ALIGN_EPI) { if (wr == 0) PG8_BAR; }
    PG8_BAR;
    if constexpr (STAMP) { if (blockIdx.x == STAMP - 1 && threadIdx.x == 0 && dbg) { dbg[0] = __builtin_amdgcn_s_memrealtime() - st_all; dbg[1] = st_k; dbg[2] = st_e; dbg[3] = (unsigned long long)(ui + 1); } }
#undef PG8_SA
#undef PG8_SB
#undef PG8_STAGE
#undef PG8_STAGE_A
#undef PG8_GOFF
#undef PG8_LDA
#undef PG8_LDB
#undef PG8_MMA
#undef PG8_LD8
#undef PG8_WAIT_V
#undef PG8_WAIT_VX
#undef PG8_WAIT_L
#undef PG8_BAR
#undef PG8_SCHED
}
}

constexpr int NWAVES = 8;
constexpr int LDS_BYTES = 163840;
constexpr int LDSCTL_OFF = 162816;
constexpr int MISC_OFF = LDSCTL_OFF;
constexpr int CW_BAR = 4096;
constexpr int CW_CNT = 64;
constexpr size_t CTL_ZERO_BYTES = 64 * 1024;

#define GAS __attribute__((address_space(1)))
#define LAS __attribute__((address_space(3)))
typedef unsigned v4u __attribute__((ext_vector_type(4)));
typedef float f32x4 __attribute__((ext_vector_type(4)));
typedef short bf16x8 __attribute__((ext_vector_type(8)));
typedef GAS unsigned gu32;
#define RLX_AGENT __ATOMIC_RELAXED, __HIP_MEMORY_SCOPE_AGENT
#define LDS_WAIT() asm volatile("s_waitcnt lgkmcnt(0)" ::: "memory")
#define VM_WAIT() asm volatile("s_waitcnt vmcnt(0)" ::: "memory")
__device__ __forceinline__ unsigned pk2(float lo, float hi) { return cvtpk_s(lo, hi); }
__device__ __forceinline__ float fsigm(float x) { return __builtin_amdgcn_rcpf(1.f + __expf(-x)); }

#define XB_TMO      128
#define XB_XCNT(j)  (256  + 64 * (j))
#define XB_XSUB(j)  (1280 + 64 * (j))
#define XB_XGEN(j)  (2304 + 64 * (j))
#define XB_TOP      3328
#define XB_TOPGEN   3392
#define XCD_BAR_WORDS 3456
#define XB_SPIN_CAP (1u << 18)

__device__ __forceinline__ unsigned xb_ld(unsigned* p)              { return __hip_atomic_load(p, __ATOMIC_RELAXED, __HIP_MEMORY_SCOPE_AGENT); }
__device__ __forceinline__ unsigned xb_add(unsigned* p, unsigned v) { return __hip_atomic_fetch_add(p, v, __ATOMIC_RELAXED, __HIP_MEMORY_SCOPE_AGENT); }
__device__ __forceinline__ unsigned xb_xcc_id() { return (unsigned)__builtin_amdgcn_s_getreg((3 << 11) | 20) & 0xFu; }
#define XB_SPIN(cond, bar) do { unsigned _sp = 0; while (cond) { __builtin_amdgcn_s_sleep(1); \
    if ((++_sp & 255u) == 0u) { if (xb_ld(&(bar)[XB_TMO])) break; if (_sp > XB_SPIN_CAP) { atomicAdd(&(bar)[XB_TMO], 1u); break; } } } } while (0)

struct XcdBarrier {
    unsigned* bar; unsigned x;
    volatile LAS unsigned* st;
};

__device__ __forceinline__ XcdBarrier xcd_barrier_post(unsigned* bar, volatile LAS unsigned* st) {
    XcdBarrier b; b.bar = bar; b.x = xb_xcc_id(); b.st = st;
    if (threadIdx.x == 0) (void)xb_add(&bar[XB_XCNT(b.x)], 1u);
    return b;
}
__device__ __forceinline__ void xcd_barrier_complete(unsigned* bar, unsigned x, unsigned& nloc, unsigned& nx) {
    const unsigned G = gridDim.x * gridDim.y * gridDim.z;
    unsigned sum, cnt, mine, sp = 0u;
    for (;;) {
        sum = 0u; cnt = 0u; mine = 0u;
#pragma unroll
        for (unsigned j = 0; j < 16; ++j) { const unsigned c = xb_ld(&bar[XB_XCNT(j)]); sum += c; cnt += (c > 0u) ? 1u : 0u; mine = (j == x) ? c : mine; }
        if (sum == G) break;
        __builtin_amdgcn_s_sleep(1);
        if ((++sp & 255u) == 0u) { if (xb_ld(&bar[XB_TMO])) break; if (sp > XB_SPIN_CAP) { atomicAdd(&bar[XB_TMO], 1u); break; } }
    }
    nloc = mine > 0u ? mine : 1u; nx = cnt > 0u ? cnt : 1u;
}

__device__ __forceinline__ void xcd_barrier(const XcdBarrier& b) {
    asm volatile("s_waitcnt vmcnt(0)" ::: "memory");
    __syncthreads();
    if (threadIdx.x == 0) {
        unsigned* bar = b.bar;
        __builtin_amdgcn_s_waitcnt(0);
        unsigned nloc = b.st[0], nx = b.st[1];
        if (nloc == 0u) { xcd_barrier_complete(bar, b.x, nloc, nx); b.st[0] = nloc; b.st[1] = nx; }
        const unsigned old = xb_add(&bar[XB_XSUB(b.x)], 1u);
        const unsigned gen = old / nloc;
        if (old + 1u == (gen + 1u) * nloc) {
            __builtin_amdgcn_fence(__ATOMIC_RELEASE, "agent");
            asm volatile("s_waitcnt vmcnt(0)" ::: "memory");
            const unsigned og = xb_add(&bar[XB_TOP], 1u);
            const unsigned tg = og / nx;
            if (og + 1u == (tg + 1u) * nx) xb_add(&bar[XB_TOPGEN], 1u);
            else XB_SPIN(xb_ld(&bar[XB_TOPGEN]) == tg, bar);
            __builtin_amdgcn_fence(__ATOMIC_ACQUIRE, "agent");
            xb_add(&bar[XB_XGEN(b.x)], 1u);
            asm volatile("s_waitcnt vmcnt(0)" ::: "memory");
        } else {
            XB_SPIN(xb_ld(&bar[XB_XGEN(b.x)]) == gen, bar);
            __builtin_amdgcn_fence(__ATOMIC_ACQUIRE, "agent");
            asm volatile("s_waitcnt vmcnt(0)" ::: "memory");
        }
    }
    __syncthreads();
}

__device__ __forceinline__ const void* inptr(int k) { const __attribute__((address_space(4))) char* ka = (const __attribute__((address_space(4))) char*)__builtin_amdgcn_kernarg_segment_ptr(); asm volatile("" : "+s"(ka)); return (const void*)(*(const __attribute__((address_space(4))) unsigned long long*)(ka + 8 * k)); }
struct Frame {
    LAS unsigned char* lds; volatile LAS unsigned* MISC; gu32* ctl; int tid, lane, wave, G;
    float* out; unsigned char* ws;
    __device__ __forceinline__ const float* x() const { return (const float*)inptr(0); }
    __device__ __forceinline__ const float* c() const { return (const float*)inptr(1); }
    __device__ __forceinline__ const int* pos() const { return (const int*)inptr(2); }
    __device__ __forceinline__ const float* w_ada() const { return (const float*)inptr(3); }
    __device__ __forceinline__ const float* b_ada() const { return (const float*)inptr(4); }
    __device__ __forceinline__ const float* n1g() const { return (const float*)inptr(5); }
    __device__ __forceinline__ const float* w_in() const { return (const float*)inptr(6); }
    __device__ __forceinline__ const float* lbl() const { return (const float*)inptr(7); }
    __device__ __forceinline__ const float* hgg() const { return (const float*)inptr(8); }
    __device__ __forceinline__ const float* w_hg() const { return (const float*)inptr(9); }
    __device__ __forceinline__ const float* qg() const { return (const float*)inptr(10); }
    __device__ __forceinline__ const float* kg() const { return (const float*)inptr(11); }
    __device__ __forceinline__ const float* sinks() const { return (const float*)inptr(12); }
    __device__ __forceinline__ const float* w_att() const { return (const float*)inptr(13); }
    __device__ __forceinline__ const float* w_out() const { return (const float*)inptr(14); }
    __device__ __forceinline__ const float* n2g() const { return (const float*)inptr(15); }
    __device__ __forceinline__ const float* w_r() const { return (const float*)inptr(16); }
    __device__ __forceinline__ const float* b_r() const { return (const float*)inptr(17); }
    __device__ __forceinline__ const float* w_up() const { return (const float*)inptr(18); }
    __device__ __forceinline__ const float* b_up() const { return (const float*)inptr(19); }
    __device__ __forceinline__ const float* w_dn() const { return (const float*)inptr(20); }
    __device__ __forceinline__ const float* b_dn() const { return (const float*)inptr(21); }
};
__device__ __forceinline__ int up_vrow(int c) { const int o = c >> 1; return 256 * (o >> 7) + 128 * (c & 1) + (o & 127); }

template <int MAP> __device__ __forceinline__ void p0_item(const float* W, int K, int N, bf16* WT, LAS float* scr, int kb, int nb, int lane) {
    const int k0 = 64 * kb, n0 = 64 * nb;
#pragma unroll 4
    for (int i = 0; i < 16; ++i) { const int kk = 4 * i + (lane >> 4); const f32x4 v = *(const GAS f32x4*)(W + (size_t)(k0 + kk) * N + n0 + 4 * (lane & 15));
        LAS float* d = scr + kk * 65 + 4 * (lane & 15); d[0] = v.x; d[1] = v.y; d[2] = v.z; d[3] = v.w; }
    LDS_WAIT(); asm volatile("" ::: "memory");
    const int c = lane >> 3;
#pragma unroll
    for (int j = 0; j < 8; ++j) { const int n = (lane & 7) + 8 * j; const LAS float* s = scr + (8 * c) * 65 + n;
        v4u o; o.x = pk2(s[0], s[65]); o.y = pk2(s[130], s[195]); o.z = pk2(s[260], s[325]); o.w = pk2(s[390], s[455]);
        const int col = n0 + n, row = MAP ? up_vrow(col) : col;
        *(GAS v4u*)(WT + (size_t)row * K + k0 + 8 * c) = o; }
    LDS_WAIT(); asm volatile("" ::: "memory");
}
__device__ __forceinline__ unsigned pk4_fp8(float a, float b, float c, float d) { int w = 0; w = __builtin_amdgcn_cvt_pk_fp8_f32(a, b, w, false); w = __builtin_amdgcn_cvt_pk_fp8_f32(c, d, w, true); return (unsigned)w; }
constexpr float W8_SCALE = 32.f, W8_INV = 1.f / 32.f;
template <int MAP> __device__ __forceinline__ void p0_item8(const float* W, int K, int N, unsigned char* WT, LAS float* scr, int kb, int nb, int lane) {
    const int k0 = 64 * kb, n0 = 64 * nb;
#pragma unroll 4
    for (int i = 0; i < 16; ++i) { const int kk = 4 * i + (lane >> 4); const f32x4 v = __builtin_nontemporal_load((const GAS f32x4*)(W + (size_t)(k0 + kk) * N + n0 + 4 * (lane & 15)));
        LAS float* d = scr + kk * 65 + 4 * (lane & 15); d[0] = v.x; d[1] = v.y; d[2] = v.z; d[3] = v.w; }
    LDS_WAIT(); asm volatile("" ::: "memory");
    const int c = lane >> 4;
#pragma unroll
    for (int j = 0; j < 4; ++j) { const int n = (lane & 15) + 16 * j; const LAS float* s = scr + (16 * c) * 65 + n;
        v4u o; o.x = pk4_fp8(s[0] * W8_SCALE, s[65] * W8_SCALE, s[130] * W8_SCALE, s[195] * W8_SCALE); o.y = pk4_fp8(s[260] * W8_SCALE, s[325] * W8_SCALE, s[390] * W8_SCALE, s[455] * W8_SCALE);
        o.z = pk4_fp8(s[520] * W8_SCALE, s[585] * W8_SCALE, s[650] * W8_SCALE, s[715] * W8_SCALE); o.w = pk4_fp8(s[780] * W8_SCALE, s[845] * W8_SCALE, s[910] * W8_SCALE, s[975] * W8_SCALE);
        const int col = n0 + n, row = MAP ? up_vrow(col) : col;
        *(GAS v4u*)(WT + (size_t)row * K + k0 + 16 * c) = o; }
    LDS_WAIT(); asm volatile("" ::: "memory");
}
__device__ __forceinline__ void p0_mod(Frame& F) {
    LAS float* cT = (LAS float*)F.lds;
    LAS float* red = (LAS float*)(F.lds + 69632);
    const int wg = blockIdx.x;
    for (int i = F.tid; i < 16 * 1024; i += 512) { const int b = i >> 10, k = i & 1023; cT[k * 16 + (k >> 4) * 4 + b] = silu_f(F.c()[i]); }
    __syncthreads();
    const int ks = F.tid >> 3, c4 = F.tid & 7, col = wg * 32 + 4 * c4;
    float acc[16][4];
#pragma unroll
    for (int b = 0; b < 16; ++b)
#pragma unroll
        for (int j = 0; j < 4; ++j) acc[b][j] = 0.f;
#pragma unroll 4
    for (int r = 0; r < 16; ++r) {
        const int k = ks * 16 + r; const f32x4 w = __builtin_nontemporal_load((const GAS f32x4*)(F.w_ada() + (size_t)k * 6144 + col));
        const LAS f32x4* cp = (const LAS f32x4*)(cT + k * 16 + (k >> 4) * 4);
#pragma unroll
        for (int q = 0; q < 4; ++q) { const f32x4 cv = cp[q];
#pragma unroll
            for (int j = 0; j < 4; ++j) { acc[4 * q + j][0] += cv[j] * w.x; acc[4 * q + j][1] += cv[j] * w.y; acc[4 * q + j][2] += cv[j] * w.z; acc[4 * q + j][3] += cv[j] * w.w; } }
    }
#pragma unroll
    for (int b = 0; b < 16; ++b)
#pragma unroll
        for (int j = 0; j < 4; ++j) { float v = acc[b][j]; v += __shfl_xor(v, 8); v += __shfl_xor(v, 16); v += __shfl_xor(v, 32); acc[b][j] = v; }
    if (F.lane < 8) {
#pragma unroll
        for (int b = 0; b < 16; ++b)
#pragma unroll
            for (int j = 0; j < 4; ++j) red[(F.wave * 16 + b) * 32 + 4 * c4 + j] = acc[b][j];
    }
    __syncthreads();
    { const int b = F.tid >> 5, cc = F.tid & 31; float s = 0.f;
#pragma unroll
      for (int w = 0; w < 8; ++w) s += red[(w * 16 + b) * 32 + cc];
      ((float*)(F.ws + WS_MOD))[b * 6144 + wg * 32 + cc] = s + F.b_ada()[wg * 32 + cc]; }
    __syncthreads();
}
__device__ __forceinline__ void p0_prologue(Frame& F) {
    if (blockIdx.x < 192) p0_mod(F);
    else {
        const int i = ((int)blockIdx.x - 192) * 512 + F.tid;
        float* BUPP = (float*)(F.ws + WS_BUPP);
#pragma unroll
        for (int q = 0; q < 2; ++q) { const int idx = i * 2 + q, e = idx >> 11, c = idx & 2047; BUPP[e * 2048 + up_vrow(c)] = F.b_up()[idx]; }
        if (i < 512) ((float*)(F.ws + WS_LB))[i] = 1.f / (1.f + __expf(F.lbl()[512 + i] - F.lbl()[i]));
        if (i >= 1024 && i < 1280) ((unsigned*)(F.ws + WS_H2))[(size_t)T * 256 + (i - 1024)] = 0u;
        if (i >= 2048 && i < 2304) ((int*)(F.ws + WS_IDT))[i - 2048] = (i - 2048) << 2;
    }
}
__device__ __forceinline__ void dense_weight_copies(Frame& F) {
    LAS float* scr = (LAS float*)(F.lds + F.wave * 16640);
    const int gw = (int)blockIdx.x * NWAVES + F.wave, NGW = F.G * NWAVES;
    constexpr int I_IN = 16 * 76, I_HG = 8 * 16, I_OUT = 16 * 16;
    constexpr int NITEMS = I_IN + 2 * I_HG + I_OUT;
    for (int it = gw; it < NITEMS; it += NGW) {
        int r = it;
        if (r < I_IN) { p0_item8<0>(F.w_in(), 1024, INW, F.ws + WS_WIN, scr, r / 76, r % 76, F.lane); continue; } r -= I_IN;
        if (r < I_HG) { p0_item8<0>(F.w_hg(), 512, 1024, F.ws + WS_WHG, scr, r / 16, r % 16, F.lane); continue; } r -= I_HG;
        if (r < I_HG) { p0_item8<0>(F.w_att(), 512, 1024, F.ws + WS_WATT, scr, r / 16, r % 16, F.lane); continue; } r -= I_HG;
        p0_item8<0>(F.w_out(), 1024, 1024, F.ws + WS_WOUT, scr, r / 16, r % 16, F.lane);
    }
}
__device__ __forceinline__ void moe_weight_copies(Frame& F, int gw, int NGW) {
    LAS float* scr = (LAS float*)(F.lds + F.wave * 16640);
    constexpr int I_UP = 16 * 32, I_DN = 16 * 16;
    for (int it = gw; it < 32 * (I_UP + I_DN); it += NGW) {
        int r = it;
        if (r < 32 * I_UP) { const int e = r / I_UP, q = r % I_UP; p0_item8<1>(F.w_up() + (size_t)e * 1024 * 2048, 1024, 2048, F.ws + WS_WUP + (size_t)e * 2048 * 1024, scr, q / 32, q % 32, F.lane); continue; } r -= 32 * I_UP;
        { const int e = r / I_DN, q = r % I_DN; p0_item8<0>(F.w_dn() + (size_t)e * 1024 * 1024, 1024, 1024, F.ws + WS_WDN + (size_t)e * 1024 * 1024, scr, q / 16, q % 16, F.lane); }
    }
}
__device__ __forceinline__ void normmod_row8(const float* xrow, const float* gain, const float* sh, const float* sc, unsigned char* orow, int lane) {
    const GAS f32x4* xr = (const GAS f32x4*)xrow + lane;
    f32x4 v[4]; float s = 0.f;
#pragma unroll
    for (int j = 0; j < 4; ++j) { v[j] = __builtin_nontemporal_load(xr + 64 * j); s += (v[j].x * v[j].x + v[j].y * v[j].y) + (v[j].z * v[j].z + v[j].w * v[j].w); }
    const float rstd = rsqrtf(wave_sum(s) * (1.f / DM) + EPS);
#pragma unroll
    for (int j = 0; j < 4; ++j) {
        const int c = 4 * lane + 256 * j;
        const f32x4 g = *(const GAS f32x4*)(gain + c), a = *(const GAS f32x4*)(sc + c), b = *(const GAS f32x4*)(sh + c);
        *(GAS unsigned*)(orow + c) = pk4_fp8(v[j].x * rstd * g.x * (1.f + a.x) + b.x, v[j].y * rstd * g.y * (1.f + a.y) + b.y, v[j].z * rstd * g.z * (1.f + a.z) + b.z, v[j].w * rstd * g.w * (1.f + a.w) + b.w);
    }
}
__device__ __forceinline__ void p1_xn(Frame& F) {
    const int gw = (int)blockIdx.x * NWAVES + F.wave, NGW = F.G * NWAVES; const float* MOD = (const float*)(F.ws + WS_MOD); unsigned char* XN = F.ws + WS_XN;
    for (int m = gw; m < T; m += NGW) { const float* mb = MOD + (size_t)(m / SEQ) * 6144; normmod_row8(F.x() + (size_t)m * DM, F.n1g(), mb, mb + 1024, XN + (size_t)m * DM, F.lane); }
}

typedef float f32x2 __attribute__((ext_vector_type(2)));
__device__ __forceinline__ f32x2 ex2_2(f32x2 t) { return (f32x2){__builtin_amdgcn_exp2f(t.x), __builtin_amdgcn_exp2f(t.y)}; }
__device__ __forceinline__ f32x2 rcp_2(f32x2 t) { return (f32x2){__builtin_amdgcn_rcpf(t.x), __builtin_amdgcn_rcpf(t.y)}; }
__device__ __forceinline__ f32x2 sigm_2(f32x2 x) { return rcp_2(ex2_2(x * (-1.4426950408889634f)) + 1.0f); }
__device__ __forceinline__ f32x2 swiglu_2(f32x2 g, f32x2 l) {
    const f32x2 ga = {fminf(g.x, 7.f), fminf(g.y, 7.f)}, la = {__builtin_amdgcn_fmed3f(l.x, -7.f, 7.f), __builtin_amdgcn_fmed3f(l.y, -7.f, 7.f)};
    return (ga * rcp_2(ex2_2(ga * (-1.702f * 1.4426950408889634f)) + 1.0f)) * (la + 1.0f);
}
__device__ __forceinline__ float bflo(unsigned u) { return __uint_as_float(u << 16); }
__device__ __forceinline__ float bfhi(unsigned u) { return __uint_as_float(u & 0xffff0000u); }
struct EpiIn {
    static constexpr bool PERM = true, HAS_MID = false; static constexpr int NST = 0; unsigned char* ws;
    __device__ __forceinline__ void operator()(const f32x4 (&acc)[2][2][4][2], const pg8::Unit& u, int wr, int wc, int fr, int fq) const {
        const int pn = u.pn, row0 = u.pm * 256 + wr * 64 + fr, cl = wc * 32 + 8 * fq;
        if (pn == 2 || pn == 3) {
            bf16* LF = (bf16*)(ws + WS_LF); const float* LB = (const float*)(ws + WS_LB); const int cb = (pn - 2) * 256;
#pragma unroll
            for (int bj = 0; bj < 2; ++bj) { const int col = cb + 128 * bj + cl; const f32x4 l0 = *(const f32x4*)(LB + col), l1 = *(const f32x4*)(LB + col + 4);
#pragma unroll
                for (int ai = 0; ai < 2; ++ai)
#pragma unroll
                    for (int m = 0; m < 4; ++m) { bf16* rp = LF + (size_t)(row0 + 128 * ai + 16 * m) * 512 + col; const f32x4 v0 = acc[ai][bj][m][0] * W8_INV, v1 = acc[ai][bj][m][1] * W8_INV; f32x4 o0, o1;
                        { const f32x2 s0 = sigm_2((f32x2){v0[0], v0[1]}), s1 = sigm_2((f32x2){v0[2], v0[3]}), s2 = sigm_2((f32x2){v1[0], v1[1]}), s3 = sigm_2((f32x2){v1[2], v1[3]});
                          const f32x4 sa = {s0.x, s0.y, s1.x, s1.y}, sb = {s2.x, s2.y, s3.x, s3.y}; const f32x4 fa = l0 + (1.0f - l0) * sa, fb = l1 + (1.0f - l1) * sb;
#pragma unroll
                          for (int j = 0; j < 4; ++j) { o0[j] = __builtin_amdgcn_logf(fa[j]) * 0.6931471805599453f; o1[j] = __builtin_amdgcn_logf(fb[j]) * 0.6931471805599453f; } }
                        v4u w; w.x = pg8::cvt_pk_bf16(o0[0], o0[1]); w.y = pg8::cvt_pk_bf16(o0[2], o0[3]); w.z = pg8::cvt_pk_bf16(o1[0], o1[1]); w.w = pg8::cvt_pk_bf16(o1[2], o1[3]); *(v4u*)rp = w; } }
            return;
        }
        bf16* dst; int ld = 512, cb, act = 0;
        if (pn < 2) { dst = (bf16*)(ws + WS_QH); cb = pn * 256; act = 1; }
        else if (pn < 6) { dst = (bf16*)(ws + WS_VH); cb = (pn - 4) * 256; }
        else if (pn < 8) { dst = (bf16*)(ws + WS_GH); cb = (pn - 6) * 256; act = 1; }
        else if (pn < 10) { dst = (bf16*)(ws + WS_AQ); cb = (pn - 8) * 256; }
        else if (pn == 10) { dst = (bf16*)(ws + WS_AKV); cb = 0; ld = 256; }
        else if (pn < 15) { dst = (bf16*)(ws + WS_SGH); cb = (pn - 11) * 256; ld = 1024; act = 2; }
        else { dst = (bf16*)(ws + WS_SGA); cb = (pn - 15) * 256; ld = 1024; act = 2; }
#pragma unroll
        for (int ai = 0; ai < 2; ++ai)
#pragma unroll
            for (int m = 0; m < 4; ++m) { bf16* rp = dst + (size_t)(row0 + 128 * ai + 16 * m) * ld + cb + cl;
#pragma unroll
                for (int bj = 0; bj < 2; ++bj) { f32x4 v0 = acc[ai][bj][m][0] * W8_INV, v1 = acc[ai][bj][m][1] * W8_INV;
                    if (act != 0) {
                        const f32x2 a0 = {v0[0], v0[1]}, a1 = {v0[2], v0[3]}, a2 = {v1[0], v1[1]}, a3 = {v1[2], v1[3]};
                        f32x2 s0 = sigm_2(a0), s1 = sigm_2(a1), s2 = sigm_2(a2), s3 = sigm_2(a3);
                        if (act == 1) { s0 = s0 * a0; s1 = s1 * a1; s2 = s2 * a2; s3 = s3 * a3; }
                        v0 = (f32x4){s0.x, s0.y, s1.x, s1.y}; v1 = (f32x4){s2.x, s2.y, s3.x, s3.y}; }
                    v4u w; w.x = pg8::cvt_pk_bf16(v0[0], v0[1]); w.y = pg8::cvt_pk_bf16(v0[2], v0[3]); w.z = pg8::cvt_pk_bf16(v1[0], v1[1]); w.w = pg8::cvt_pk_bf16(v1[2], v1[3]);
                    *(v4u*)(rp + 128 * bj) = w; } }
    }
};
struct PairOrder {
    pg8::StaticOrder S;
    __device__ __forceinline__ bool next(int i, pg8::Unit& u) const { if (!S.next(i >> 1, u)) return false; const int hf = i & 1; u.pn += 8 * hf; u.abase += 512u * (unsigned)hf; u.nvalid = hf ? 0 : 1; return true; }
};
struct EpiMrg {
    static constexpr bool PERM = true, HAS_MID = true; static constexpr int NST = 0; unsigned char* MRG; const bf16* SGH; const bf16* SGA;
    __device__ __forceinline__ void mid(f32x4 (&acc)[2][2][4][2], const pg8::Unit& u, int wr, int wc, int fr, int fq) const {
        const int row0 = u.pm * 256 + wr * 64 + fr, col0 = (u.pn & 3) * 256 + wc * 32 + 8 * fq;
#pragma unroll
        for (int ai = 0; ai < 2; ++ai)
#pragma unroll
            for (int m = 0; m < 4; ++m) { const size_t off = (size_t)(row0 + 128 * ai + 16 * m) * 1024 + col0;
#pragma unroll
                for (int bj = 0; bj < 2; ++bj) { const v4u h = *(const v4u*)(SGH + off + 128 * bj), a = *(const v4u*)(SGA + off + 128 * bj);
                    const f32x4 r0 = {bflo(h.x) * __builtin_amdgcn_rcpf(bflo(a.x)), bfhi(h.x) * __builtin_amdgcn_rcpf(bfhi(a.x)), bflo(h.y) * __builtin_amdgcn_rcpf(bflo(a.y)), bfhi(h.y) * __builtin_amdgcn_rcpf(bfhi(a.y))};
                    const f32x4 r1 = {bflo(h.z) * __builtin_amdgcn_rcpf(bflo(a.z)), bfhi(h.z) * __builtin_amdgcn_rcpf(bfhi(a.z)), bflo(h.w) * __builtin_amdgcn_rcpf(bflo(a.w)), bfhi(h.w) * __builtin_amdgcn_rcpf(bfhi(a.w))};
                    acc[ai][bj][m][0] *= r0; acc[ai][bj][m][1] *= r1; }
                asm volatile("" ::: "memory"); }
    }
    __device__ __forceinline__ void operator()(const f32x4 (&acc)[2][2][4][2], const pg8::Unit& u, int wr, int wc, int fr, int fq) const {
        const int row0 = u.pm * 256 + wr * 64 + fr, col0 = (u.pn & 3) * 256 + wc * 32 + 8 * fq;
#pragma unroll
        for (int ai = 0; ai < 2; ++ai)
#pragma unroll
            for (int m = 0; m < 4; ++m) { const size_t off = (size_t)(row0 + 128 * ai + 16 * m) * 1024 + col0;
#pragma unroll
                for (int bj = 0; bj < 2; ++bj) { const v4u s = *(const v4u*)(SGA + off + 128 * bj); const f32x4 v0 = acc[ai][bj][m][0] * W8_INV, v1 = acc[ai][bj][m][1] * W8_INV;
                    *(unsigned long long*)(MRG + off + 128 * bj) = (unsigned long long)pk4_fp8(bflo(s.x) * v0[0], bfhi(s.x) * v0[1], bflo(s.y) * v0[2], bfhi(s.y) * v0[3]) | ((unsigned long long)pk4_fp8(bflo(s.z) * v1[0], bfhi(s.z) * v1[1], bflo(s.w) * v1[2], bfhi(s.w) * v1[3]) << 32); } }
    }
};
struct EpiOut {
    static constexpr bool PERM = true, HAS_MID = false; static constexpr int NST = 0; const float* x; const float* MOD; bf16* X1B; int skip;
    __device__ __forceinline__ void operator()(const f32x4 (&acc)[2][2][4][2], const pg8::Unit& u, int wr, int wc, int fr, int fq) const {
        if (skip) { if (acc[0][0][0][0][0] == 12345.678f) X1B[0] = 1; return; }
        const int row0 = u.pm * 256 + wr * 64 + fr, col0 = u.pn * 256 + wc * 32 + 8 * fq; const float* g1 = MOD + (size_t)(u.pm >> 3) * 6144 + 2048;
        f32x4 gv[2][2];
#pragma unroll
        for (int bj = 0; bj < 2; ++bj)
#pragma unroll
            for (int n = 0; n < 2; ++n) gv[bj][n] = *(const f32x4*)(g1 + col0 + 128 * bj + 4 * n) * W8_INV;
#pragma unroll
        for (int ai = 0; ai < 2; ++ai)
#pragma unroll
            for (int m = 0; m < 4; ++m) { const size_t off = (size_t)(row0 + 128 * ai + 16 * m) * 1024 + col0;
#pragma unroll
                for (int bj = 0; bj < 2; ++bj) { const f32x4 v0 = __builtin_nontemporal_load((const f32x4*)(x + off + 128 * bj)) + gv[bj][0] * acc[ai][bj][m][0], v1 = __builtin_nontemporal_load((const f32x4*)(x + off + 128 * bj + 4)) + gv[bj][1] * acc[ai][bj][m][1];
                    v4u w; w.x = pg8::cvt_pk_bf16(v0[0], v0[1]); w.y = pg8::cvt_pk_bf16(v0[2], v0[3]); w.z = pg8::cvt_pk_bf16(v1[0], v1[1]); w.w = pg8::cvt_pk_bf16(v1[2], v1[3]);
                    *(v4u*)(X1B + off + 128 * bj) = w; } }
    }
};

typedef float f32x16 __attribute__((ext_vector_type(16)));
constexpr int RT_PITCH = 2064;
constexpr int R_TILE = 0, R_PART = 66048, R_LOG = 99840, R_REC = 104064, R_HIST = 112256;
__device__ __forceinline__ void p6_route(Frame& F, int dry) {
    const float* MOD = (const float*)(F.ws + WS_MOD); unsigned* H2 = (unsigned*)(F.ws + WS_H2);
    int* TOKL = (int*)(F.ws + (dry ? WS_TMP : WS_TOKL)); int* SLOT = (int*)(F.ws + (dry ? WS_TMP + 8 * MiB : WS_GATL)); const int cw = dry ? 8192 : CW_CNT; int* TOPI = (int*)(F.ws + WS_TOPI); float* TOPW = (float*)(F.ws + WS_TOPW);
    LAS float* PART = (LAS float*)(F.lds + R_PART); LAS float* LOG = (LAS float*)(F.lds + R_LOG);
    LAS int* REC_E = (LAS int*)(F.lds + R_REC); LAS int* REC_TK = REC_E + 512; LAS float* REC_G = (LAS float*)(REC_E + 1024); LAS int* REC_RK = REC_E + 1536;
    LAS int* HIST = (LAS int*)(F.lds + R_HIST); LAS int* BASE = HIST + 32;
    const int lane = F.lane, wave = F.wave, r32 = lane & 31, hi = lane >> 5;
    bf16x8 wB[8];
#pragma unroll
    for (int s = 0; s < 8; ++s) { const int k0 = 128 * wave + 16 * s + 8 * hi; unsigned p[4];
#pragma unroll
        for (int j = 0; j < 4; ++j) p[j] = pk2(F.w_r()[(size_t)(k0 + 2 * j) * 32 + r32], F.w_r()[(size_t)(k0 + 2 * j + 1) * 32 + r32]);
        v4u q = {p[0], p[1], p[2], p[3]}; wB[s] = __builtin_bit_cast(bf16x8, q); }
    if (F.tid < 32) HIST[F.tid] = 0;
    __syncthreads();
    const bf16* X1B = (const bf16*)(F.ws + WS_X1B);
    for (int tb = (int)blockIdx.x * 4; tb < T / 32; tb += F.G * 4) {
        const int ntile = (T / 32 - tb) < 4 ? (T / 32 - tb) : 4;
        f32x4 cm[4], ca[4];
        { const float* mb = MOD + (size_t)((tb * 32) / SEQ) * 6144;
#pragma unroll
          for (int j = 0; j < 4; ++j) { const int c = 4 * lane + 256 * j; const f32x4 g = *(const GAS f32x4*)(F.n2g() + c), a = *(const GAS f32x4*)(mb + 4096 + c); cm[j] = g * (1.0f + a); ca[j] = *(const GAS f32x4*)(mb + 3072 + c); } }
        unsigned long long xw[4][4];
#define P6_LOAD(tl_) do { _Pragma("unroll") for (int rr = 0; rr < 4; ++rr) { const GAS unsigned long long* xr = (const GAS unsigned long long*)(X1B + (size_t)((tb + (tl_)) * 32 + 4 * wave + rr) * DM) + lane; \
        _Pragma("unroll") for (int j = 0; j < 4; ++j) xw[rr][j] = xr[64 * j]; } } while (0)
        P6_LOAD(0);
        for (int tl = 0; tl < ntile; ++tl) {
            const int t0 = (tb + tl) * 32;
#pragma unroll
            for (int rr = 0; rr < 4; ++rr) {
                const int row = t0 + 4 * wave + rr;
                f32x4 v[4]; float s = 0.f;
#pragma unroll
                for (int j = 0; j < 4; ++j) { const unsigned xl = (unsigned)xw[rr][j], xh = (unsigned)(xw[rr][j] >> 32); v[j] = (f32x4){bflo(xl), bfhi(xl), bflo(xh), bfhi(xh)}; s += (v[j].x * v[j].x + v[j].y * v[j].y) + (v[j].z * v[j].z + v[j].w * v[j].w); }
                const float rstd = rsqrtf(wave_sum(s) * (1.f / DM) + EPS);
#pragma unroll
                for (int j = 0; j < 4; ++j) {
                    const int c = 4 * lane + 256 * j;
                    const f32x4 hv = v[j] * rstd * cm[j] + ca[j];
                    const unsigned lo = pk2(hv.x, hv.y), hh = pk2(hv.z, hv.w);
                    *(GAS unsigned*)(H2 + (size_t)row * 256 + (c >> 2)) = pk4_fp8(hv.x, hv.y, hv.z, hv.w);
                    *(LAS unsigned long long*)(F.lds + R_TILE + (4 * wave + rr) * RT_PITCH + c * 2) = (unsigned long long)lo | ((unsigned long long)hh << 32);
                }
            }
            if (tl + 1 < ntile) P6_LOAD(tl + 1);
            __syncthreads();
            f32x16 acc = {};
#pragma unroll
            for (int s = 0; s < 8; ++s) { const bf16x8 af = *(const LAS bf16x8*)(F.lds + R_TILE + r32 * RT_PITCH + (128 * wave + 16 * s + 8 * hi) * 2);
                acc = __builtin_amdgcn_mfma_f32_32x32x16_bf16(af, wB[s], acc, 0, 0, 0); }
#pragma unroll
            for (int r = 0; r < 16; ++r) { const int tok = (r & 3) + 8 * (r >> 2) + 4 * hi; PART[(wave * 32 + tok) * 33 + r32] = acc[r]; }
            __syncthreads();
#pragma unroll
            for (int q = 0; q < 2; ++q) { const int idx = F.tid + 512 * q, tok = idx >> 5, e = idx & 31; float s = F.b_r()[e];
#pragma unroll
                for (int w = 0; w < 8; ++w) s += PART[(w * 32 + tok) * 33 + e];
                LOG[tok * 33 + e] = s; }
            __syncthreads();
            if (F.tid < 32) {
                float lg[32];
#pragma unroll
                for (int e = 0; e < 32; ++e) lg[e] = LOG[F.tid * 33 + e];
                unsigned used = 0u; float tv[4]; int ti[4];
#pragma unroll
                for (int k = 0; k < 4; ++k) { float best = -INFINITY; int bi = 0;
#pragma unroll
                    for (int e = 0; e < 32; ++e) { const bool ok = !((used >> e) & 1u) && lg[e] > best; best = ok ? lg[e] : best; bi = ok ? e : bi; }
                    used |= 1u << bi; tv[k] = best; ti[k] = bi; }
                const float e1 = __expf(tv[1] - tv[0]), e2 = __expf(tv[2] - tv[0]), e3 = __expf(tv[3] - tv[0]), inv = 1.f / (1.f + e1 + e2 + e3);
                const float gw[4] = {inv, e1 * inv, e2 * inv, e3 * inv};
                const int t = t0 + F.tid;
#pragma unroll
                for (int k = 0; k < 4; ++k) { const int slot = tl * 128 + F.tid * 4 + k; REC_E[slot] = ti[k]; REC_TK[slot] = t * 4 + k; REC_G[slot] = gw[k];
                    REC_RK[slot] = __hip_atomic_fetch_add(&HIST[ti[k]], 1, __ATOMIC_RELAXED, __HIP_MEMORY_SCOPE_WORKGROUP);
                    TOPI[t * 4 + k] = ti[k]; TOPW[t * 4 + k] = gw[k]; }
            }
        }
        __syncthreads();
        if (F.tid < 32) BASE[F.tid] = (int)__hip_atomic_fetch_add(F.ctl + cw + 64 * F.tid, (unsigned)HIST[F.tid], RLX_AGENT);
        __syncthreads();
        for (int slot = F.tid; slot < ntile * 128; slot += 512) { const int e = REC_E[slot], p = BASE[e] + REC_RK[slot]; const int tk = REC_TK[slot]; TOKL[(size_t)e * T + p] = tk; SLOT[tk] = (e << 16) | p; }
        __syncthreads();
        if (F.tid < 32) HIST[F.tid] = 0;
        __syncthreads();
    }
#undef P6_LOAD
}

__device__ __forceinline__ void moe_tables(Frame& F) {
    if (F.tid < 32) F.MISC[64 + F.tid] = __hip_atomic_load(F.ctl + CW_CNT + 64 * F.tid, RLX_AGENT);
    __syncthreads();
    if (F.tid == 0) { unsigned s = 0; for (int e = 0; e < 32; ++e) { F.MISC[16 + e] = s; s += (F.MISC[64 + e] + 255u) >> 8; } F.MISC[48] = s; }
    __syncthreads();
}
template <int NC> struct MoeOrder {
    volatile LAS unsigned* MISC; int G, c;
    __device__ __forceinline__ bool next(int i, pg8::Unit& u) const {
        const int total = (int)MISC[48]; int rt, pl;
        if ((G & 7) == 0 && ((G >> 3) % NC) == 0) { const int rpr = G / NC, perx = rpr >> 3, xcd = c & 7, s = c >> 3; rt = i * rpr + xcd * perx + s / NC; pl = s % NC; }
        else { const int L = i * G + c; rt = L / NC; pl = L % NC; }
        if (rt >= total) return false;
        int e = 0;
        for (int q = 1; q < 32; ++q) e += ((int)MISC[16 + q] <= rt) ? 1 : 0;
        const int j = rt - (int)MISC[16 + e];
        u.pm = rt; u.pn = e * NC + pl;
        if (NC == 8) { u.arow0 = e * T + 256 * j; u.nvalid = (int)MISC[64 + e] - 256 * j; u.abase = 0u; }
        else { u.arow0 = 0; u.nvalid = 256; u.abase = (unsigned)rt * (256u * 1024u); }
        return true;
    }
};
__device__ __forceinline__ void moe_prefill_tokens(Frame& F, const pg8::CachedOrder& CS, const int* rowidx) {
    LAS unsigned short* TK = (LAS unsigned short*)(F.lds + pg8::STAGE_BYTES);
    const int total = CS.n * 256;
    for (int base = 0; base < total; base += 2048) {
        int v[4]; int nv[4];
#pragma unroll
        for (int q = 0; q < 4; ++q) { const int idx = base + q * 512 + F.tid, i = idx >> 8, r = idx & 255; v[q] = 0; nv[q] = 0;
            if (idx < total) { const int arow0 = CS.tab[8 * i + 2]; nv[q] = CS.tab[8 * i + 3]; v[q] = rowidx[arow0 + r]; } }
#pragma unroll
        for (int q = 0; q < 4; ++q) { const int idx = base + q * 512 + F.tid, i = idx >> 8, r = idx & 255; if (idx < total) TK[i * 256 + pg8::tk_pos(r)] = (unsigned short)((r < nv[q]) ? (v[q] >> 2) : T); }
    }
    __syncthreads();
}
struct EpiUp {
    static constexpr bool PERM = true, HAS_MID = false; static constexpr int NST = 8; unsigned char* ACT; const float* BUPP; int skip;
    __device__ __forceinline__ void operator()(const f32x4 (&acc)[2][2][4][2], const pg8::Unit& u, int wr, int wc, int fr, int fq) const {
        if (skip) { if (acc[0][0][0][0][0] == 12345.678f) ACT[0] = 1; return; }
        const int e = u.pn >> 3, pl = u.pn & 7, row0 = u.pm * 256 + wr * 64 + fr, cl = wc * 32 + 8 * fq;
        const float* bp = BUPP + e * 2048 + 256 * pl + cl;
        const f32x4 bg0 = *(const f32x4*)bp, bg1 = *(const f32x4*)(bp + 4), bl0 = *(const f32x4*)(bp + 128), bl1 = *(const f32x4*)(bp + 132);
#pragma unroll
        for (int ai = 0; ai < 2; ++ai)
#pragma unroll
            for (int m = 0; m < 4; ++m) { unsigned char* rp = ACT + (size_t)(row0 + 128 * ai + 16 * m) * 1024 + 128 * pl + cl;
                const f32x4 g0 = acc[ai][0][m][0] * W8_INV + bg0, g1 = acc[ai][0][m][1] * W8_INV + bg1, l0 = acc[ai][1][m][0] * W8_INV + bl0, l1 = acc[ai][1][m][1] * W8_INV + bl1;
                const f32x2 o0 = swiglu_2((f32x2){g0[0], g0[1]}, (f32x2){l0[0], l0[1]}), o1 = swiglu_2((f32x2){g0[2], g0[3]}, (f32x2){l0[2], l0[3]}),
                            o2 = swiglu_2((f32x2){g1[0], g1[1]}, (f32x2){l1[0], l1[1]}), o3 = swiglu_2((f32x2){g1[2], g1[3]}, (f32x2){l1[2], l1[3]});
                *(unsigned long long*)rp = (unsigned long long)pk4_fp8(o0.x, o0.y, o1.x, o1.y) | ((unsigned long long)pk4_fp8(o2.x, o2.y, o3.x, o3.y) << 32); }
    }
};
constexpr float Y8_SCALE = 8.f, Y8_INV = 0.125f;
struct EpiDn {
    static constexpr bool PERM = true, HAS_MID = false; static constexpr int NST = 16; unsigned char* Y; const float* b_dn;
    __device__ __forceinline__ void operator()(const f32x4 (&acc)[2][2][4][2], const pg8::Unit& u, int wr, int wc, int fr, int fq) const {
        const int e = u.pn >> 2, pl = u.pn & 3, row0 = u.pm * 256 + wr * 64 + fr, cl = wc * 32 + 8 * fq; const float* bp = b_dn + e * 1024 + 256 * pl + cl;
        f32x4 bv[2][2];
#pragma unroll
        for (int bj = 0; bj < 2; ++bj) { bv[bj][0] = *(const f32x4*)(bp + 128 * bj) * Y8_SCALE; bv[bj][1] = *(const f32x4*)(bp + 128 * bj + 4) * Y8_SCALE; }
#pragma unroll
        for (int ai = 0; ai < 2; ++ai)
#pragma unroll
            for (int m = 0; m < 4; ++m) { unsigned char* rp = Y + (size_t)(row0 + 128 * ai + 16 * m) * 1024 + 256 * pl + cl;
#pragma unroll
                for (int bj = 0; bj < 2; ++bj) { const f32x4 v0 = acc[ai][bj][m][0] * (W8_INV * Y8_SCALE) + bv[bj][0], v1 = acc[ai][bj][m][1] * (W8_INV * Y8_SCALE) + bv[bj][1];
                    *(unsigned long long*)(rp + 128 * bj) = (unsigned long long)pk4_fp8(v0[0], v0[1], v0[2], v0[3]) | ((unsigned long long)pk4_fp8(v1[0], v1[1], v1[2], v1[3]) << 32); } }
    }
};
__device__ __forceinline__ void p9_final(Frame& F) {
    moe_tables(F);
    const int gw = (int)blockIdx.x * NWAVES + F.wave, NGW = F.G * NWAVES; const float* MOD = (const float*)(F.ws + WS_MOD); const unsigned char* Y = F.ws + WS_Y;
    const int* SLOT = (const int*)(F.ws + WS_GATL); const float* TOPW = (const float*)(F.ws + WS_TOPW); const bf16* X1B = (const bf16*)(F.ws + WS_X1B);
    for (int row = gw; row < T; row += NGW) {
        const float* g2 = MOD + (size_t)(row / SEQ) * 6144 + 5120;
        const v4u sl = *(const GAS v4u*)(SLOT + row * 4); const f32x4 gt = *(const GAS f32x4*)(TOPW + row * 4);
        const unsigned slv[4] = {sl.x, sl.y, sl.z, sl.w}; const float gtv[4] = {gt.x * Y8_INV, gt.y * Y8_INV, gt.z * Y8_INV, gt.w * Y8_INV}; const unsigned char* yr[4];
#pragma unroll
        for (int k = 0; k < 4; ++k) yr[k] = Y + ((size_t)F.MISC[16 + (slv[k] >> 16)] * 256 + (slv[k] & 0xffffu)) * DM;
#pragma unroll
        for (int j = 0; j < 4; ++j) {
            const int c = 4 * F.lane + 256 * j;
            const unsigned long long xw = *(const GAS unsigned long long*)(X1B + (size_t)row * DM + c); const unsigned xl = (unsigned)xw, xh = (unsigned)(xw >> 32);
            const f32x4 g = *(const GAS f32x4*)(g2 + c);
            float s0 = 0.f, s1 = 0.f, s2 = 0.f, s3 = 0.f;
#pragma unroll
            for (int k = 0; k < 4; ++k) { const unsigned y = *(const GAS unsigned*)(yr[k] + c);
                s0 += gtv[k] * __builtin_amdgcn_cvt_f32_fp8(y, 0); s1 += gtv[k] * __builtin_amdgcn_cvt_f32_fp8(y, 1); s2 += gtv[k] * __builtin_amdgcn_cvt_f32_fp8(y, 2); s3 += gtv[k] * __builtin_amdgcn_cvt_f32_fp8(y, 3); }
            f32x4 ov_ = {bflo(xl) + g.x * s0, bfhi(xl) + g.y * s1, bflo(xh) + g.z * s2, bfhi(xh) + g.w * s3};
#ifdef DBG_STAT
            { const unsigned long long* dbg = (const unsigned long long*)(F.ws + WS_TMP); const float us = (DBG_STAT == 4) ? (float)dbg[3] : 8.f * floorf(((float)dbg[DBG_STAT] * 0.01f + DBG_OFS) * 0.125f); ov_ = ov_ + sqrtf(us) * 0.03125f; }
#endif
            *(GAS f32x4*)(F.out + (size_t)row * DM + c) = ov_;
        }
    }
}
typedef short v4i16_t __attribute__((ext_vector_type(4)));
namespace att {
constexpr int L_K = 0, L_V = 32768, L_OST = 65536, L_WSF = 98304;
constexpr float SC2 = 0.125f * 1.4426950408889634f;
__device__ __forceinline__ int crow(int r, int hi) { return (r & 3) + 8 * (r >> 2) + 4 * hi; }
__device__ __forceinline__ bf16x8 vtr2(LAS const unsigned char* p) {
    const v4i16_t lo = __builtin_amdgcn_ds_read_tr16_b64_v4i16((LAS v4i16_t*)p), hi = __builtin_amdgcn_ds_read_tr16_b64_v4i16((LAS v4i16_t*)(p + 512));
    return (bf16x8){lo[0], lo[1], lo[2], lo[3], hi[0], hi[1], hi[2], hi[3]};
}
__device__ __forceinline__ void unit(Frame& F, int b, int kvh, int qb) {
    const bf16* AQ = (const bf16*)(F.ws + WS_AQ); const bf16* AKV = (const bf16*)(F.ws + WS_AKV); unsigned char* HOAO = F.ws + WS_HOAO;
    const int tid = F.tid, lane = F.lane, wave = F.wave, r32 = lane & 31, hi = lane >> 5;
    const int tq0 = b * SEQ + qb * 128, tk0 = tq0 - 128;
    {
        const int key = tid >> 1, half = tid & 1; const bool valid = (qb > 0) || (key >= 128); const int token = valid ? tk0 + key : tq0;
        const bf16* kp = AKV + (size_t)token * 256 + kvh * 64 + half * 32;
        v4u kr[4], vr[4];
#pragma unroll
        for (int q = 0; q < 4; ++q) { kr[q] = *(const GAS v4u*)(kp + 8 * q); vr[q] = *(const GAS v4u*)(kp + 128 + 8 * q); }
        float x[32]; float ss = 0.f;
#pragma unroll
        for (int q = 0; q < 4; ++q) { x[8 * q + 0] = bflo(kr[q].x); x[8 * q + 1] = bfhi(kr[q].x); x[8 * q + 2] = bflo(kr[q].y); x[8 * q + 3] = bfhi(kr[q].y);
            x[8 * q + 4] = bflo(kr[q].z); x[8 * q + 5] = bfhi(kr[q].z); x[8 * q + 6] = bflo(kr[q].w); x[8 * q + 7] = bfhi(kr[q].w); }
#pragma unroll
        for (int d = 0; d < 32; ++d) ss += x[d] * x[d];
        ss += __shfl_xor(ss, 1);
        const float rstd = valid ? rsqrtf(ss * (1.f / 64.f) + EPS) : 0.f;
#pragma unroll
        for (int q = 0; q < 8; ++q) { const f32x4 g = *(const GAS f32x4*)(F.kg() + half * 32 + 4 * q); x[4 * q] *= rstd * g.x; x[4 * q + 1] *= rstd * g.y; x[4 * q + 2] *= rstd * g.z; x[4 * q + 3] *= rstd * g.w; }
        if (half == 0) { const int p = F.pos()[token];
#pragma unroll
            for (int i = 0; i < 8; ++i) { float cs, sn; rope_cs(p, i, cs, sn); const float x1 = x[i], x2 = x[i + 8]; x[i] = x1 * cs - x2 * sn; x[i + 8] = x2 * cs + x1 * sn; } }
#pragma unroll
        for (int q = 0; q < 4; ++q) { v4u w; w.x = pk2(x[8 * q], x[8 * q + 1]); w.y = pk2(x[8 * q + 2], x[8 * q + 3]); w.z = pk2(x[8 * q + 4], x[8 * q + 5]); w.w = pk2(x[8 * q + 6], x[8 * q + 7]);
            *(LAS v4u*)(F.lds + L_K + (half * 4 + q) * 4096 + key * 16) = w; }
        const int kk = key & 63; LAS unsigned char* vd = F.lds + L_V + (key >> 6) * 8192 + half * 4096 + (kk >> 4) * 1024 + (kk & 15) * 64;
#pragma unroll
        for (int q = 0; q < 4; ++q) { v4u w = vr[q]; if (!valid) w = (v4u){0u, 0u, 0u, 0u}; *(LAS v4u*)(vd + 16 * q) = w; }
    }
    __syncthreads();
    LAS float* wsf = (LAS float*)(F.lds + L_WSF) + wave * 64;
    LAS unsigned char* stg = F.lds + L_OST + wave * 4096;
    LAS const unsigned char* vbase = F.lds + L_V + ((lane >> 4) & 1) * 32 + (lane & 3) * 8 + (4 * hi + ((lane & 15) >> 2)) * 64;
#pragma unroll 1
    for (int sbi = 0; sbi < 2; ++sbi) {
        const int sb = wave * 2 + sbi, g = sb >> 2, r0 = (sb & 3) * 32, hq = kvh * 4 + g, tq = tq0 + r0 + r32;
        bf16x8 qr[4];
        {
            const bf16* qp = AQ + (size_t)tq * 512 + hq * 64 + 8 * hi; float x[4][8]; float ss = 0.f;
#pragma unroll
            for (int d0 = 0; d0 < 4; ++d0) { const v4u r = *(const GAS v4u*)(qp + 16 * d0); x[d0][0] = bflo(r.x); x[d0][1] = bfhi(r.x); x[d0][2] = bflo(r.y); x[d0][3] = bfhi(r.y); x[d0][4] = bflo(r.z); x[d0][5] = bfhi(r.z); x[d0][6] = bflo(r.w); x[d0][7] = bfhi(r.w); }
#pragma unroll
            for (int d0 = 0; d0 < 4; ++d0)
#pragma unroll
                for (int j = 0; j < 8; ++j) ss += x[d0][j] * x[d0][j];
            ss += __shfl_xor(ss, 32);
            const float rs = rsqrtf(ss * (1.f / 64.f) + EPS) * SC2;
#pragma unroll
            for (int d0 = 0; d0 < 4; ++d0) { const f32x4 g0 = *(const GAS f32x4*)(F.qg() + 16 * d0 + 8 * hi), g1 = *(const GAS f32x4*)(F.qg() + 16 * d0 + 8 * hi + 4);
                x[d0][0] *= rs * g0.x; x[d0][1] *= rs * g0.y; x[d0][2] *= rs * g0.z; x[d0][3] *= rs * g0.w; x[d0][4] *= rs * g1.x; x[d0][5] *= rs * g1.y; x[d0][6] *= rs * g1.z; x[d0][7] *= rs * g1.w; }
            const int p = F.pos()[tq];
#pragma unroll
            for (int j = 0; j < 8; ++j) { float cs, sn; rope_cs(p, j, cs, sn); const float mine = x[0][j], oth = __shfl_xor(mine, 32); x[0][j] = mine * cs + (hi ? oth : -oth) * sn; }
#pragma unroll
            for (int d0 = 0; d0 < 4; ++d0) { v4u w; w.x = pk2(x[d0][0], x[d0][1]); w.y = pk2(x[d0][2], x[d0][3]); w.z = pk2(x[d0][4], x[d0][5]); w.w = pk2(x[d0][6], x[d0][7]); qr[d0] = __builtin_bit_cast(bf16x8, w); }
        }
        const int kt0 = r0 >> 5, qi = r0 + r32;
        f32x16 p[5];
#pragma unroll
        for (int t = 0; t < 5; ++t) {
            f32x16 a = {};
#pragma unroll
            for (int d0 = 0; d0 < 4; ++d0) { const bf16x8 kf = *(const LAS bf16x8*)(F.lds + L_K + (2 * d0 + hi) * 4096 + (32 * (kt0 + t) + r32) * 16); a = __builtin_amdgcn_mfma_f32_32x32x16_bf16(kf, qr[d0], a, 0, 0, 0); }
            if (t == 0) {
#pragma unroll
                for (int r = 0; r < 16; ++r) a[r] = (crow(r, hi) > r32) ? a[r] : -INFINITY; }
            if (t == 4) {
#pragma unroll
                for (int r = 0; r < 16; ++r) a[r] = (crow(r, hi) <= r32) ? a[r] : -INFINITY; }
            if (qb == 0 && kt0 + t < 4) {
#pragma unroll
                for (int r = 0; r < 16; ++r) a[r] = -INFINITY; }
            p[t] = a;
        }
        const float sink2 = F.sinks()[hq] * 1.4426950408889634f;
        float m = sink2;
#pragma unroll
        for (int t = 0; t < 5; ++t)
#pragma unroll
            for (int r = 0; r < 16; ++r) m = fmaxf(m, p[t][r]);
        m = fmaxf(m, __shfl_xor(m, 32));
        float l = 0.f;
#pragma unroll
        for (int t = 0; t < 5; ++t)
#pragma unroll
            for (int r = 0; r < 16; ++r) { const float e = __builtin_amdgcn_exp2f(p[t][r] - m); p[t][r] = e; l += e; }
        l += __shfl_xor(l, 32);
        l += __builtin_amdgcn_exp2f(sink2 - m);
        f32x16 o[2]; o[0] = (f32x16){}; o[1] = (f32x16){};
#pragma unroll
        for (int t = 0; t < 5; ++t) {
            const int kt = kt0 + t; LAS const unsigned char* vs = vbase + (kt >> 1) * 8192 + (2 * (kt & 1)) * 1024;
#pragma unroll
            for (int s = 0; s < 2; ++s) {
                v4u w; w.x = pk2(p[t][8 * s], p[t][8 * s + 1]); w.y = pk2(p[t][8 * s + 2], p[t][8 * s + 3]); w.z = pk2(p[t][8 * s + 4], p[t][8 * s + 5]); w.w = pk2(p[t][8 * s + 6], p[t][8 * s + 7]);
                const bf16x8 pa = __builtin_bit_cast(bf16x8, w);
#pragma unroll
                for (int d0 = 0; d0 < 2; ++d0) { const bf16x8 vf = vtr2(vs + d0 * 4096 + s * 1024); o[d0] = __builtin_amdgcn_mfma_f32_32x32x16_bf16(pa, vf, o[d0], 0, 0, 0); }
            }
        }
        if (hi == 0) wsf[r32] = l;
        LDS_WAIT(); asm volatile("" ::: "memory");
#pragma unroll
        for (int r = 0; r < 16; ++r) { const int orow = crow(r, hi); const float rl = __builtin_amdgcn_rcpf(wsf[orow]);
#pragma unroll
            for (int d0 = 0; d0 < 2; ++d0) { const float ov = o[d0][r] * rl; stg[orow * 64 + d0 * 32 + r32] = (unsigned char)(__builtin_amdgcn_cvt_pk_fp8_f32(ov, ov, 0, false) & 0xff); } }
        LDS_WAIT(); asm volatile("" ::: "memory");
#pragma unroll
        for (int i = 0; i < 2; ++i) { const int row = i * 16 + (lane >> 2), ch = lane & 3; const v4u v = *(const LAS v4u*)(stg + row * 64 + ch * 16);
            *(GAS v4u*)(HOAO + (size_t)(tq0 + r0 + row) * 1024 + 512 + hq * 64 + ch * 16) = v; }
        LDS_WAIT(); asm volatile("" ::: "memory");
    }
    __syncthreads();
}
}

namespace hg {
typedef float f32x2v __attribute__((ext_vector_type(2)));
constexpr int PK = 272, PJ = 144;
constexpr int L_QE = 0, L_KE = 17408, L_KDT = 34816, L_VT = 53248, L_P = 71680, L_ST = 80896, L_OST = 115712, L_SEGP = 149504, L_DK = 153600;
constexpr int OP = 132;
__device__ __forceinline__ void run(Frame& F, int b, int h) {
    const bf16* QH = (const bf16*)(F.ws + WS_QH); const bf16* LF = (const bf16*)(F.ws + WS_LF); const bf16* VH = (const bf16*)(F.ws + WS_VH); const bf16* GH = (const bf16*)(F.ws + WS_GH);
    unsigned char* HOAO = F.ws + WS_HOAO;
    const int tid = F.tid, lane = F.lane, wave = F.wave, r32 = lane & 31, hi = lane >> 5;
    LAS unsigned char* L = F.lds;
    LAS float* SEGP = (LAS float*)(L + L_SEGP); LAS float* DK = (LAS float*)(L + L_DK); LAS float* OST = (LAS float*)(L + L_OST);
    for (int i = tid; i < (L_OST - L_P) / 16; i += 512) *(LAS v4u*)(L + L_P + i * 16) = (v4u){0u, 0u, 0u, 0u};
    f32x16 st[2]; st[0] = (f32x16){}; st[1] = (f32x16){};
    const int kp2 = 2 * lane;
    const size_t rowb = (size_t)b * SEQ;
    float fv[8][2]; unsigned qv[8], vv[8];
    unsigned lr[8], qr_[8], vr_[8];
    const int oi = tid >> 3, os = tid & 7;
    float gn[16];
#pragma unroll
    for (int q = 0; q < 4; ++q) { const f32x4 g = *(const GAS f32x4*)(F.hgg() + 16 * os + 4 * q); gn[4 * q] = g.x; gn[4 * q + 1] = g.y; gn[4 * q + 2] = g.z; gn[4 * q + 3] = g.w; }
#define HG_LOAD(c) do { _Pragma("unroll") for (int jj = 0; jj < 8; ++jj) { const size_t row = rowb + (size_t)(c) * 64 + 8 * wave + jj; \
        lr[jj] = __builtin_nontemporal_load((const GAS unsigned*)(LF + row * 512 + h * 128 + kp2)); \
        qr_[jj] = __builtin_nontemporal_load((const GAS unsigned*)(QH + row * 512 + h * 128 + kp2)); vr_[jj] = __builtin_nontemporal_load((const GAS unsigned*)(VH + row * 512 + h * 128 + kp2)); } } while (0)
#define HG_A1() do { float p0 = 1.f, p1 = 1.f; _Pragma("unroll") for (int jj = 0; jj < 8; ++jj) { fv[jj][0] = __expf(bflo(lr[jj])); fv[jj][1] = __expf(bfhi(lr[jj])); p0 *= fv[jj][0]; p1 *= fv[jj][1]; qv[jj] = qr_[jj]; vv[jj] = vr_[jj]; } \
        *(LAS f32x2v*)(SEGP + wave * 128 + kp2) = (f32x2v){p0, p1}; } while (0)
    HG_LOAD(0); HG_A1(); HG_LOAD(1);
    __syncthreads();
#ifdef DBG_HG
    unsigned long long hs[4] = {0, 0, 0, 0}, ht = __builtin_amdgcn_s_memrealtime();
#define HG_STAMP(k) do { const unsigned long long n_ = __builtin_amdgcn_s_memrealtime(); hs[k] += n_ - ht; ht = n_; } while (0)
#else
#define HG_STAMP(k) do {} while (0)
#endif
#pragma unroll 1
    for (int c = 0; c < SEQ / 64; ++c) {
        {
            float pre0 = 1.f, pre1 = 1.f, all0 = 1.f, all1 = 1.f;
#pragma unroll
            for (int s = 0; s < 8; ++s) { const f32x2v sp = *(const LAS f32x2v*)(SEGP + s * 128 + kp2); all0 *= sp.x; all1 *= sp.y; if (s < wave) { pre0 *= sp.x; pre1 *= sp.y; } }
            if (wave == 0) *(LAS f32x2v*)(DK + kp2) = (f32x2v){all0, all1};
            f32x2 e2 = {pre0, pre1}; const f32x2 all2 = {all0, all1}; unsigned kd0[4], kd1[4], vt0[4], vt1[4]; f32x2 dprev = {0.f, 0.f};
#pragma unroll
            for (int jj = 0; jj < 8; ++jj) {
                const f32x2 f2 = {fv[jj][0], fv[jj][1]};
                e2 = e2 * f2;
                const f32x2 ke2 = (1.0f - f2) * rcp_2(e2), qe2 = (f32x2){bflo(qv[jj]), bfhi(qv[jj])} * e2, d2 = ke2 * all2;
                const int j = 8 * wave + jj;
                *(LAS unsigned*)(L + L_QE + j * PK + kp2 * 2) = pk2(qe2.x, qe2.y);
                *(LAS unsigned*)(L + L_KE + j * PK + kp2 * 2) = pk2(ke2.x, ke2.y);
                if (jj & 1) { kd0[jj >> 1] = pk2(dprev.x, d2.x); kd1[jj >> 1] = pk2(dprev.y, d2.y); vt0[jj >> 1] = (vv[jj - 1] & 0xffffu) | (vv[jj] << 16); vt1[jj >> 1] = (vv[jj - 1] >> 16) | (vv[jj] & 0xffff0000u); }
                else dprev = d2;
            }
            *(LAS v4u*)(L + L_KDT + kp2 * PJ + 16 * wave) = (v4u){kd0[0], kd0[1], kd0[2], kd0[3]};
            *(LAS v4u*)(L + L_KDT + (kp2 + 1) * PJ + 16 * wave) = (v4u){kd1[0], kd1[1], kd1[2], kd1[3]};
            *(LAS v4u*)(L + L_VT + kp2 * PJ + 16 * wave) = (v4u){vt0[0], vt0[1], vt0[2], vt0[3]};
            *(LAS v4u*)(L + L_VT + (kp2 + 1) * PJ + 16 * wave) = (v4u){vt1[0], vt1[1], vt1[2], vt1[3]};
        }
        const size_t orow = rowb + (size_t)c * 64 + oi;
        const v4u gg0 = *(const GAS v4u*)(GH + orow * 512 + h * 128 + 16 * os), gg1 = *(const GAS v4u*)(GH + orow * 512 + h * 128 + 16 * os + 8);
        __syncthreads();
        HG_STAMP(0);
        for (int tl = wave; tl < 10; tl += 8) {
            const int ib = (tl >= 1) + (tl >= 3) + (tl >= 6), jb = tl - ((ib * (ib + 1)) >> 1);
            typedef float f32x4v __attribute__((ext_vector_type(4)));
            f32x4v a = {0.f, 0.f, 0.f, 0.f}; const int l15 = lane & 15, l4 = lane >> 4;
#pragma unroll
            for (int s = 0; s < 4; ++s) { const bf16x8 af = *(const LAS bf16x8*)(L + L_QE + (16 * ib + l15) * PK + (32 * s + 8 * l4) * 2), bfr = *(const LAS bf16x8*)(L + L_KE + (16 * jb + l15) * PK + (32 * s + 8 * l4) * 2);
                a = __builtin_amdgcn_mfma_f32_16x16x32_bf16(af, bfr, a, 0, 0, 0); }
#pragma unroll
            for (int r = 0; r < 4; ++r) { const int i = 16 * ib + 4 * l4 + r, j = 16 * jb + l15; const float v = (j <= i) ? a[r] : 0.f; *(LAS bf16*)(L + L_P + i * PJ + j * 2) = f2bf(v); }
        }
        const int ib = wave >> 2, vb = wave & 3;
        f32x16 o = {};
#pragma unroll
        for (int s = 0; s < 8; ++s) { const bf16x8 af = *(const LAS bf16x8*)(L + L_QE + (32 * ib + r32) * PK + (16 * s + 8 * hi) * 2), bfr = *(const LAS bf16x8*)(L + L_ST + (32 * vb + r32) * PK + (16 * s + 8 * hi) * 2);
            o = __builtin_amdgcn_mfma_f32_32x32x16_bf16(af, bfr, o, 0, 0, 0); }
#pragma unroll
        for (int q = 0; q < 2; ++q) { const int kb = 2 * (wave >> 2) + q; const float dk = DK[32 * kb + r32];
#pragma unroll
            for (int r = 0; r < 16; ++r) st[q][r] *= dk;
#pragma unroll
            for (int s = 0; s < 4; ++s) { const bf16x8 af = *(const LAS bf16x8*)(L + L_VT + (32 * vb + r32) * PJ + (16 * s + 8 * hi) * 2), bfr = *(const LAS bf16x8*)(L + L_KDT + (32 * kb + r32) * PJ + (16 * s + 8 * hi) * 2);
                st[q] = __builtin_amdgcn_mfma_f32_32x32x16_bf16(af, bfr, st[q], 0, 0, 0); } }
        HG_A1(); { const int cn = (c + 2 < SEQ / 64) ? c + 2 : SEQ / 64 - 1; HG_LOAD(cn); }
        __syncthreads();
        HG_STAMP(1);
#pragma unroll
        for (int s = 0; s < 4; ++s) { const bf16x8 af = *(const LAS bf16x8*)(L + L_P + (32 * ib + r32) * PJ + (16 * s + 8 * hi) * 2), bfr = *(const LAS bf16x8*)(L + L_VT + (32 * vb + r32) * PJ + (16 * s + 8 * hi) * 2);
            o = __builtin_amdgcn_mfma_f32_32x32x16_bf16(af, bfr, o, 0, 0, 0); }
#pragma unroll
        for (int r = 0; r < 16; ++r) OST[(32 * ib + att::crow(r, hi)) * OP + 32 * vb + r32] = o[r];
#pragma unroll
        for (int q = 0; q < 2; ++q) { const int kb = 2 * (wave >> 2) + q;
#pragma unroll
            for (int r = 0; r < 16; ++r) *(LAS bf16*)(L + L_ST + (32 * vb + att::crow(r, hi)) * PK + (32 * kb + r32) * 2) = f2bf(st[q][r]); }
        __syncthreads();
        HG_STAMP(2);
        {
            float ov[16]; float ss = 0.f;
#pragma unroll
            for (int q = 0; q < 4; ++q) { const f32x4 t = *(const LAS f32x4*)(OST + oi * OP + 16 * os + 4 * q); ov[4 * q] = t.x; ov[4 * q + 1] = t.y; ov[4 * q + 2] = t.z; ov[4 * q + 3] = t.w; ss += (t.x * t.x + t.y * t.y) + (t.z * t.z + t.w * t.w); }
            ss += __shfl_xor(ss, 1); ss += __shfl_xor(ss, 2); ss += __shfl_xor(ss, 4);
            const float rstd = rsqrtf(ss * (1.f / 128.f) + EPS);
            const unsigned gw[8] = {gg0.x, gg0.y, gg0.z, gg0.w, gg1.x, gg1.y, gg1.z, gg1.w}; float of[16];
#pragma unroll
            for (int q = 0; q < 8; ++q) { of[2 * q] = ov[2 * q] * rstd * gn[2 * q] * bflo(gw[q]); of[2 * q + 1] = ov[2 * q + 1] * rstd * gn[2 * q + 1] * bfhi(gw[q]); }
            *(GAS v4u*)(HOAO + orow * 1024 + h * 128 + 16 * os) = (v4u){pk4_fp8(of[0], of[1], of[2], of[3]), pk4_fp8(of[4], of[5], of[6], of[7]), pk4_fp8(of[8], of[9], of[10], of[11]), pk4_fp8(of[12], of[13], of[14], of[15])};
        }
        HG_STAMP(3);
    }
#ifdef DBG_HG
    if (blockIdx.x == 0 && tid == 0) { unsigned long long* dbg = (unsigned long long*)(F.ws + WS_TMP); dbg[0] = hs[0]; dbg[1] = hs[1]; dbg[2] = hs[2]; dbg[3] = hs[3]; }
#endif
#undef HG_STAMP
#undef HG_LOAD
#undef HG_A1
    __syncthreads();
}
}
__device__ __forceinline__ void p3_mixers(Frame& F, int sub) {
    constexpr int NHG = 64;
    if ((int)blockIdx.x < NHG) { if (sub & 1) { for (int u = blockIdx.x; u < BATCH * 4; u += NHG) hg::run(F, u >> 2, u & 3); } }
    else { const int na = F.G - NHG; if (sub & 2) { for (int u = (int)blockIdx.x - NHG; u < BATCH * 2 * 16; u += na) att::unit(F, u >> 5, (u >> 4) & 1, u & 15); }
        if (sub & 4) moe_weight_copies(F, ((int)blockIdx.x - NHG) * NWAVES + F.wave, na * NWAVES); }
}

struct Args { const void* in[22]; float* out; unsigned char* ws; int ph_lo, ph_hi, one, sub; };
__global__ void __launch_bounds__(NWAVES * 64, 2) skel_fwd(Args args) {
    extern __shared__ __attribute__((aligned(16))) unsigned char lds[];
    Frame F;
    F.lds = (LAS unsigned char*)lds; F.MISC = (volatile LAS unsigned*)(F.lds + MISC_OFF);
    F.tid = threadIdx.x; F.lane = F.tid & 63; F.wave = __builtin_amdgcn_readfirstlane(F.tid >> 6); F.G = gridDim.x;
    F.out = args.out; F.ws = args.ws; F.ctl = (gu32*)(args.ws + WS_CTL);
    for (int u = F.tid; u < (LDS_BYTES - LDSCTL_OFF) / 4; u += NWAVES * 64) ((LAS unsigned*)(F.lds + LDSCTL_OFF))[u] = 0u;
    __syncthreads();
    XcdBarrier bar; bar.bar = (unsigned*)(F.ctl + CW_BAR); bar.x = 0; bar.st = nullptr;
    if (args.one) bar = xcd_barrier_post((unsigned*)(F.ctl + CW_BAR), F.MISC + 8);
    const int lo = args.ph_lo, hi = args.ph_hi;
#define IN(k) (lo <= (k) && (k) < hi)
#ifndef PROBE_MASK
#define PROBE_MASK 0
#endif
#define REP(k) for (int rep_ = 0; rep_ < (((PROBE_MASK >> (k)) & 1) ? 2 : 1); ++rep_)
#define RSEAM() do { if (rep_ == 0 && ((PROBE_MASK) != 0)) { if (args.one) xcd_barrier(bar); } } while (0)
#define SEAM(k) do { if (IN(k) && IN((k) + 1)) xcd_barrier(bar); } while (0)
    unsigned char* ws = args.ws;
    if (IN(0)) { REP(0) { p0_prologue(F); if ((PROBE_MASK >> 0) & 1) RSEAM(); } SEAM(0); }
    if (IN(1)) { REP(1) { dense_weight_copies(F); p1_xn(F); if ((PROBE_MASK >> 1) & 1) RSEAM(); } SEAM(1); }
    if (IN(2)) REP(2) {
        pg8::Gemm g{(const bf16*)(ws + WS_XN), (const bf16*)(ws + WS_WIN), T, INW, 1024, nullptr, 0, 1024}; pg8::StaticOrder S; S.init(T, INW, F.G, (int)blockIdx.x); S.abase_per_pm = 256u * 1024u;
        { LAS unsigned short* TK = (LAS unsigned short*)(F.lds + pg8::STAGE_BYTES); for (int i = F.tid; i < pg8::MAXU * 256; i += 512) TK[(i & ~255) + pg8::tk_pos(i & 255)] = (unsigned short)(i & 255); __syncthreads(); }
        pg8::CachedOrder CS; CS.build(F.lds, S);
        EpiIn E{ws}; pg8::gemm_phase<EpiIn, pg8::CachedOrder, true, 1, 1>(F.lds, g, CS, E); if ((PROBE_MASK >> 2) & 1) RSEAM();
    }
    SEAM(2);
    if (IN(3)) { REP(3) { p3_mixers(F, args.sub); if ((PROBE_MASK >> 3) & 1) RSEAM(); }
#ifdef DBG_HG
        xcd_barrier(bar); p3_mixers(F, 1);
#endif
        SEAM(3); }
    if (IN(4)) REP(4) {
        PairOrder PS; PS.S.init(T, 1024, F.G, (int)blockIdx.x); PS.S.abase_per_pm = 256u * 1024u; pg8::CachedOrder CS; CS.build(F.lds, PS);
        { LAS unsigned short* TK = (LAS unsigned short*)(F.lds + pg8::STAGE_BYTES); for (int i = F.tid; i < pg8::MAXU * 256; i += 512) TK[(i & ~255) + pg8::tk_pos(i & 255)] = (unsigned short)(i & 255); __syncthreads(); }
        { pg8::Gemm g{(const bf16*)(ws + WS_HOAO), (const bf16*)(ws + WS_WHG), T, 1024, 512, nullptr, 0, 1024}; EpiMrg E{ws + WS_MRG, (const bf16*)(ws + WS_SGH), (const bf16*)(ws + WS_SGA)};
          pg8::gemm_phase<EpiMrg, pg8::CachedOrder, true, 1, 1>(F.lds, g, CS, E); }
        if ((PROBE_MASK >> 4) & 1) RSEAM();
    }
    SEAM(4);
    if (IN(5)) REP(5) {
        pg8::Gemm g{(const bf16*)(ws + WS_MRG), (const bf16*)(ws + WS_WOUT), T, 1024, 1024, nullptr, 0, 1024}; pg8::StaticOrder S; S.init(T, 1024, F.G, (int)blockIdx.x); S.abase_per_pm = 256u * 1024u;
        { LAS unsigned short* TK = (LAS unsigned short*)(F.lds + pg8::STAGE_BYTES); for (int i = F.tid; i < pg8::MAXU * 256; i += 512) TK[(i & ~255) + pg8::tk_pos(i & 255)] = (unsigned short)(i & 255); __syncthreads(); }
        EpiOut E{F.x(), (const float*)(ws + WS_MOD), (bf16*)(ws + WS_X1B), (args.sub >> 3) & 1}; pg8::CachedOrder CS; CS.build(F.lds, S); pg8::gemm_phase<EpiOut, pg8::CachedOrder, true, 1, 1>(F.lds, g, CS, E); if ((PROBE_MASK >> 5) & 1) RSEAM();
    }
    SEAM(5);
    if (IN(6)) { p6_route(F, (args.sub >> 4) & 1); SEAM(6); }
    if (IN(7)) REP(7) {
        moe_tables(F);
        pg8::Gemm g{(const bf16*)(ws + WS_H2), (const bf16*)(ws + WS_WUP), T, NEXP * 2048, 1024, (const int*)(ws + WS_TOKL), T, 1024}; MoeOrder<8> S{F.MISC, F.G, (int)blockIdx.x};
        pg8::CachedOrder CS; CS.build(F.lds, S);
        moe_prefill_tokens(F, CS, (const int*)(ws + WS_TOKL));
        EpiUp E{ws + WS_ACT, (const float*)(ws + WS_BUPP), (args.sub >> 3) & 1};
#if DEV_ORACLE
        if ((args.sub >> 5) & 1) pg8::gemm_phase<EpiUp, pg8::CachedOrder, true, 1, 1, 1>(F.lds, g, CS, E); else if ((args.sub >> 6) & 1) pg8::gemm_phase<EpiUp, pg8::CachedOrder, true, 1, 1, 2>(F.lds, g, CS, E); else
#endif
#if defined(DBG_STAT) && !defined(DBG_HG)
        pg8::gemm_phase<EpiUp, pg8::CachedOrder, true, 1, 1, 0, DBG_BLOCK + 1>(F.lds, g, CS, E, (unsigned long long*)(ws + WS_TMP));
#else
        pg8::gemm_phase<EpiUp, pg8::CachedOrder, true, 1, 1>(F.lds, g, CS, E);
#endif
        if ((PROBE_MASK >> 7) & 1) RSEAM();
    }
    SEAM(7);
    if (IN(8)) REP(8) {
        moe_tables(F);
        pg8::Gemm g{(const bf16*)(ws + WS_ACT), (const bf16*)(ws + WS_WDN), T, NEXP * 1024, 1024, (const int*)(ws + WS_IDT), 0, 1024}; MoeOrder<4> S{F.MISC, F.G, (int)blockIdx.x};
        { LAS unsigned short* TK = (LAS unsigned short*)(F.lds + pg8::STAGE_BYTES); for (int i = F.tid; i < pg8::MAXU * 256; i += 512) TK[(i & ~255) + pg8::tk_pos(i & 255)] = (unsigned short)(i & 255); __syncthreads(); }
        EpiDn E{ws + WS_Y, F.b_dn()}; pg8::CachedOrder CS; CS.build(F.lds, S); pg8::gemm_phase<EpiDn, pg8::CachedOrder, true, 1, 1>(F.lds, g, CS, E); if ((PROBE_MASK >> 8) & 1) RSEAM();
    }
    SEAM(8);
    if (IN(9)) { p9_final(F); }
#undef IN
#undef SEAM
}

#ifndef DEV_MASK
#define DEV_MASK 0x3ff
#ifndef DEV_SUB
#define DEV_SUB 7
#endif
#endif

#if DEV_ORACLE
template <int KIND> __global__ void __launch_bounds__(512, 2) mfma_bench(float* sink, int iters) {
    typedef int v8i __attribute__((ext_vector_type(8))); typedef short s8 __attribute__((ext_vector_type(8))); typedef float f4 __attribute__((ext_vector_type(4))); typedef float f16v __attribute__((ext_vector_type(16)));
    v8i a8, b8; s8 ab, bb;
    for (int i = 0; i < 8; ++i) { a8[i] = threadIdx.x * 2654435761u + i; b8[i] = threadIdx.x * 40503u + 7 * i; ab[i] = (short)(threadIdx.x + i); bb[i] = (short)(3 * threadIdx.x + i); }
    f4 c[8]; f16v d[4];
    for (int i = 0; i < 8; ++i) c[i] = (f4){0.f, 0.f, 0.f, 0.f};
    for (int i = 0; i < 4; ++i) d[i] = (f16v){};
    for (int it = 0; it < iters; ++it) {
        if (KIND == 0) {
#pragma unroll
            for (int i = 0; i < 8; ++i) c[i] = __builtin_amdgcn_mfma_f32_16x16x32_bf16(ab, bb, c[i], 0, 0, 0);
        } else if (KIND == 1) {
#pragma unroll
            for (int i = 0; i < 8; ++i) c[i] = __builtin_amdgcn_mfma_scale_f32_16x16x128_f8f6f4(a8, b8, c[i], 0, 0, 0, 0x7F7F7F7F, 0, 0x7F7F7F7F);
        } else {
#pragma unroll
            for (int i = 0; i < 4; ++i) d[i] = __builtin_amdgcn_mfma_scale_f32_32x32x64_f8f6f4(a8, b8, d[i], 0, 0, 0, 0x7F7F7F7F, 0, 0x7F7F7F7F);
        }
    }
    float s = 0.f;
    for (int i = 0; i < 8; ++i) s += c[i][0] + c[i][1] + c[i][2] + c[i][3];
    for (int i = 0; i < 4; ++i) for (int j = 0; j < 16; ++j) s += d[i][j];
    if (s == 123.456f) sink[threadIdx.x] = s;
}
#endif
extern "C" void kernel_launch(void* const* d_in, const int* in_sizes, int n_in, void* d_out, int out_size, void* d_ws, size_t ws_size, hipStream_t stream) {
    static int grid = 0;
    if (grid == 0) {
        if (n_in != 22 || ws_size < WS_END || out_size != T * DM) { fprintf(stderr, "kernel_launch: unexpected shapes n_in %d ws %zu out %d\n", n_in, ws_size, out_size); grid = -1; return; }
        int dev = 0, cus = 0;
        if (hipGetDevice(&dev) != hipSuccess || hipDeviceGetAttribute(&cus, hipDeviceAttributeMultiprocessorCount, dev) != hipSuccess) { grid = -1; return; }
        if (hipFuncSetAttribute((const void*)skel_fwd, hipFuncAttributeMaxDynamicSharedMemorySize, LDS_BYTES) != hipSuccess) { fprintf(stderr, "kernel_launch: hipFuncSetAttribute failed\n"); grid = -1; return; }
        int per_cu = 0;
        if (hipOccupancyMaxActiveBlocksPerMultiprocessor(&per_cu, (const void*)skel_fwd, NWAVES * 64, LDS_BYTES) != hipSuccess || per_cu < 1) { fprintf(stderr, "kernel_launch: occupancy query says %d workgroups per CU; nothing launched\n", per_cu); grid = -1; return; }
        (void)hipGetLastError();
        grid = cus;
    }
    if (grid < 0) return;
    unsigned char* ws = (unsigned char*)d_ws; float* out = (float*)d_out;
#if DEV_ORACLE
    const float* x = (const float*)d_in[0]; const int* pos = (const int*)d_in[2];
    const float* hgg = (const float*)d_in[8]; const float* qg = (const float*)d_in[10]; const float* kg = (const float*)d_in[11];
    const float* sinks = (const float*)d_in[12]; const float* n2g = (const float*)d_in[15]; const float* w_r = (const float*)d_in[16]; const float* b_r = (const float*)d_in[17];
    const float* w_up = (const float*)d_in[18]; const float* b_up = (const float*)d_in[19]; const float* w_dn = (const float*)d_in[20]; const float* b_dn = (const float*)d_in[21];
    float* MOD = (float*)(ws + WS_MOD); float* LB = (float*)(ws + WS_LB);
    bf16* XN = (bf16*)(ws + WS_XN); bf16* QH = (bf16*)(ws + WS_QH); float* LF = (float*)(ws + WS_LF); bf16* VH = (bf16*)(ws + WS_VH); bf16* GH = (bf16*)(ws + WS_GH);
    bf16* AQ = (bf16*)(ws + WS_AQ); bf16* AKV = (bf16*)(ws + WS_AKV); bf16* SGH = (bf16*)(ws + WS_SGH); bf16* SGA = (bf16*)(ws + WS_SGA);
    bf16* HOAO = (bf16*)(ws + WS_HOAO); bf16* MRG = (bf16*)(ws + WS_MRG); bf16* H2 = (bf16*)(ws + WS_H2); bf16* Y = (bf16*)(ws + WS_Y);
    int* TOPI = (int*)(ws + WS_TOPI); float* TOPW = (float*)(ws + WS_TOPW);
    float* OTMP = (float*)(ws + WS_OTMP); float* QN = (float*)(ws + WS_QN); float* KN = (float*)(ws + WS_KN);
#endif
    (void)hipMemsetAsync(ws + WS_CTL, 0, CTL_ZERO_BYTES, stream);
    Args a{}; for (int i = 0; i < 22; ++i) a.in[i] = d_in[i];
    a.out = out; a.ws = ws; a.one = 0;
#if DEV_ORACLE
#ifndef DEV_REP
#define DEV_REP 0
#endif
#define SK(p) do { a.ph_lo = (p); a.ph_hi = (p) + 1; for (int r_ = 0; r_ < (((DEV_REP >> (p)) & 1) ? 2 : 1); ++r_) hipLaunchKernelGGL(skel_fwd, dim3(grid), dim3(NWAVES * 64), LDS_BYTES, stream, a); } while (0)
#define ON(p) ((DEV_MASK >> (p)) & 1)
    if (ON(0)) SK(0); else { n_mod<<<dim3(24, 16), 256, 0, stream>>>((const float*)d_in[1], (const float*)d_in[3], (const float*)d_in[4], MOD); n_misc<<<4, 256, 0, stream>>>((const float*)d_in[7], LB, H2); }
    if (ON(1)) SK(1); else k_normmod<<<T / 4, 256, 0, stream>>>(x, (const float*)d_in[5], MOD, 0, 1024, XN);
    if (ON(2)) SK(2); else n_gemm<EpiInN><<<dim3(INW / 64, T / 64), 256, 0, stream>>>(XN, 1024, (const float*)d_in[6], INW, 1024, EpiInN{QH, LF, VH, GH, AQ, AKV, SGH, SGA, LB});
    a.sub = ON(3) ? DEV_SUB : 0;
    if (a.sub) { a.ph_lo = 3; a.ph_hi = 4; hipLaunchKernelGGL(skel_fwd, dim3(grid), dim3(NWAVES * 64), LDS_BYTES, stream, a);
#ifdef DEV_SUB2
        a.sub = DEV_SUB2; hipLaunchKernelGGL(skel_fwd, dim3(grid), dim3(NWAVES * 64), LDS_BYTES, stream, a); a.sub = DEV_SUB;
#endif
    }
    if (!(a.sub & 1)) { n_hgrn<<<128, 64, 0, stream>>>(QH, LF, VH, OTMP); n_hgrn_norm<<<T, 256, 0, stream>>>(OTMP, hgg, GH, HOAO); }
    if (!(a.sub & 2)) { n_qkn<<<(T * 10 + 255) / 256, 256, 0, stream>>>(AQ, AKV, pos, qg, kg, QN, KN); n_attn<<<T * 8 / 256, 256, 0, stream>>>(QN, KN, AKV, sinks, HOAO); }
    if (ON(4)) SK(4); else {
        n_gemm<EpiM1N><<<dim3(16, T / 64), 256, 0, stream>>>(HOAO, 1024, (const float*)d_in[9], 1024, 512, EpiM1N{MRG, SGH});
        n_gemm<EpiM2N><<<dim3(16, T / 64), 256, 0, stream>>>(HOAO + 512, 1024, (const float*)d_in[13], 1024, 512, EpiM2N{MRG, SGA});
    }
    if (ON(5)) { SK(5);
#ifdef DEV_SUB5
        a.sub = DEV_SUB5; a.ph_lo = 5; a.ph_hi = 6; hipLaunchKernelGGL(skel_fwd, dim3(grid), dim3(NWAVES * 64), LDS_BYTES, stream, a); a.sub = DEV_SUB;
#endif
    } else n_gemm<EpiOutN><<<dim3(16, T / 64), 256, 0, stream>>>(MRG, 1024, (const float*)d_in[14], 1024, 1024, EpiOutN{x, MOD, out});
    if (ON(6)) { SK(6);
#ifdef DEV_P6_TWICE
        a.sub = DEV_SUB | 16; a.ph_lo = 6; a.ph_hi = 7; hipLaunchKernelGGL(skel_fwd, dim3(grid), dim3(NWAVES * 64), LDS_BYTES, stream, a); a.sub = DEV_SUB;
#endif
    } else n_route<<<T / 4, 256, 0, stream>>>(out, n2g, MOD, w_r, b_r, H2, TOPI, TOPW);
    if (ON(7) && ON(8)) { SK(7);
#ifdef DEV_SUB7
        a.sub = DEV_SUB7; a.ph_lo = 7; a.ph_hi = 8; hipLaunchKernelGGL(skel_fwd, dim3(grid), dim3(NWAVES * 64), LDS_BYTES, stream, a); a.sub = DEV_SUB;
#endif
        SK(8); } else n_moe<<<T * 4, 256, 0, stream>>>(H2, TOPI, TOPW, w_up, b_up, w_dn, b_dn, Y);
#ifdef DEV_BENCH
    mfma_bench<DEV_BENCH><<<256, 512, 0, stream>>>((float*)(ws + WS_TMP), 512);
#endif
    if (ON(9)) SK(9); else k_final<<<T / 4, 256, 0, stream>>>(out, MOD, Y);
#else
    a.one = 1; a.sub = 7; a.ph_lo = 0; a.ph_hi = 10;
    hipLaunchKernelGGL(skel_fwd, dim3(grid), dim3(NWAVES * 64), LDS_BYTES, stream, a);
#endif
}
```

```cpp
#include <hip/hip_runtime.h>
#include <cstdio>
#include <cstdint>
#include <cmath>

typedef unsigned short bf16;
constexpr int BATCH = 16, SEQ = 2048, DM = 1024, T = BATCH * SEQ;
constexpr int INW = 4864, NEXP = 32, TOPK = 4, DEXP = 1024;
constexpr float EPS = 1e-6f;

constexpr size_t MiB = 1u << 20;
constexpr size_t WS_CTL = 0;
constexpr size_t WS_MOD = 1 * MiB;
constexpr size_t WS_LB = 1 * MiB + 512 * 1024;
constexpr size_t WS_IDT = 1 * MiB + 768 * 1024;
constexpr size_t WS_BUPP = 2 * MiB;
constexpr size_t WS_TOKL = 4 * MiB;
constexpr size_t WS_GATL = 8 * MiB;
constexpr size_t WS_TOPI = 12 * MiB;
constexpr size_t WS_TOPW = 13 * MiB;
constexpr size_t WS_WIN = 16 * MiB, WS_WHG = 26 * MiB, WS_WATT = 27 * MiB, WS_WOUT = 28 * MiB, WS_WUP = 32 * MiB, WS_WDN = 160 * MiB;
constexpr size_t WS_H2 = 224 * MiB;
constexpr size_t WS_R = 290 * MiB;
constexpr size_t WS_XN = WS_R, WS_QH = WS_R + 64 * MiB, WS_LF = WS_R + 96 * MiB, WS_VH = WS_R + 160 * MiB, WS_GH = WS_R + 192 * MiB,
                 WS_AQ = WS_R + 224 * MiB, WS_AKV = WS_R + 256 * MiB, WS_SGH = WS_R + 272 * MiB, WS_SGA = WS_R + 336 * MiB,
                 WS_HOAO = WS_R + 400 * MiB, WS_MRG = WS_R + 464 * MiB;
constexpr size_t WS_ACT = WS_R, WS_Y = WS_R + 272 * MiB;
constexpr size_t WS_TMP = 820 * MiB;
constexpr size_t WS_OTMP = WS_TMP, WS_QN = WS_TMP + 64 * MiB, WS_KN = WS_TMP + 128 * MiB;
constexpr size_t WS_M1 = 904 * MiB;
constexpr size_t WS_X1B = 840 * MiB;
constexpr size_t WS_END = 968 * MiB;

__device__ __forceinline__ float bf2f(bf16 v) { return __uint_as_float((unsigned)v << 16); }
typedef float f32x2_t __attribute__((ext_vector_type(2))); typedef __bf16 bf16x2_t __attribute__((ext_vector_type(2)));
__device__ __forceinline__ unsigned cvtpk_s(float lo, float hi) { f32x2_t v = {lo, hi}; bf16x2_t b = __builtin_convertvector(v, bf16x2_t); return __builtin_bit_cast(unsigned, b); }
__device__ __forceinline__ bf16 f2bf(float f) { return (bf16)(cvtpk_s(f, f) & 0xffffu); }
__device__ __forceinline__ float silu_f(float x) { return x / (1.f + __expf(-x)); }
__device__ __forceinline__ float sigm_f(float x) { return 1.f / (1.f + __expf(-x)); }
__device__ __forceinline__ float wave_sum(float v) {
#pragma unroll
    for (int o = 1; o < 64; o <<= 1) v += __shfl_xor(v, o);
    return v;
}

__device__ __forceinline__ void rope_cs(int pos, int i, float& cs, float& sn) {
    const float invf = exp2f(-(float)i * 0.125f * 18.931568569324174f);
    double a = (double)pos * (double)invf * 0.15915494309189535; a -= floor(a);
    sn = __builtin_amdgcn_sinf((float)a); cs = __builtin_amdgcn_cosf((float)a);
}
#ifndef DEV_ORACLE
#define DEV_ORACLE 0
#endif
#if DEV_ORACLE
__global__ void n_mod(const float* c, const float* w_ada, const float* b_ada, float* MOD) {
    const int n = blockIdx.x * 256 + threadIdx.x, b = blockIdx.y;
    __shared__ float cond[1024];
    for (int k = threadIdx.x; k < 1024; k += 256) cond[k] = silu_f(c[b * 1024 + k]);
    __syncthreads();
    float acc = 0.f;
    for (int k = 0; k < 1024; ++k) acc += cond[k] * w_ada[(size_t)k * 6144 + n];
    MOD[b * 6144 + n] = acc + b_ada[n];
}
__global__ void n_misc(const float* lbl, float* LB, bf16* H2) {
    const int i = blockIdx.x * 256 + threadIdx.x;
    if (i < 512) LB[i] = 1.f / (1.f + __expf(lbl[512 + i] - lbl[i]));
    if (i < 1024) H2[(size_t)T * 1024 + i] = 0;
}
__global__ void k_normmod(const float* x, const float* gain, const float* MOD, int sh_off, int sc_off, bf16* out) {
    const int lane = threadIdx.x & 63, row = blockIdx.x * 4 + (threadIdx.x >> 6), b = row / SEQ;
    const float4* xr = (const float4*)(x + (size_t)row * DM) + lane;
    float4 v[4]; float s = 0.f;
#pragma unroll
    for (int j = 0; j < 4; ++j) { v[j] = xr[64 * j]; s += v[j].x * v[j].x + v[j].y * v[j].y + v[j].z * v[j].z + v[j].w * v[j].w; }
    const float rstd = rsqrtf(wave_sum(s) * (1.f / DM) + EPS);
    const float* mb = MOD + (size_t)b * 6144;
#pragma unroll
    for (int j = 0; j < 4; ++j) {
        const int c = 4 * lane + 256 * j;
        const float4 g = *(const float4*)(gain + c), sc = *(const float4*)(mb + sc_off + c), sh = *(const float4*)(mb + sh_off + c);
        ushort4 o;
        o.x = f2bf(v[j].x * rstd * g.x * (1.f + sc.x) + sh.x); o.y = f2bf(v[j].y * rstd * g.y * (1.f + sc.y) + sh.y);
        o.z = f2bf(v[j].z * rstd * g.z * (1.f + sc.z) + sh.z); o.w = f2bf(v[j].w * rstd * g.w * (1.f + sc.w) + sh.w);
        *(ushort4*)(out + (size_t)row * DM + c) = o;
    }
}
template <class Epi> __global__ void n_gemm(const bf16* A, int lda, const float* W, int N, int K, Epi epi) {
    __shared__ float As[16][65], Ws[16][65];
    const int tx = threadIdx.x & 15, ty = threadIdx.x >> 4, m0 = blockIdx.y * 64, n0 = blockIdx.x * 64;
    float acc[4][4];
#pragma unroll
    for (int i = 0; i < 4; ++i)
#pragma unroll
        for (int j = 0; j < 4; ++j) acc[i][j] = 0.f;
    for (int k0 = 0; k0 < K; k0 += 16) {
        for (int i = threadIdx.x; i < 1024; i += 256) { const int r = i >> 4, kk = i & 15; As[kk][r] = bf2f(A[(size_t)(m0 + r) * lda + k0 + kk]); }
        for (int i = threadIdx.x; i < 1024; i += 256) { const int kk = i >> 6, cc = i & 63; Ws[kk][cc] = W[(size_t)(k0 + kk) * N + n0 + cc]; }
        __syncthreads();
#pragma unroll
        for (int kk = 0; kk < 16; ++kk) {
            float a[4], b[4];
#pragma unroll
            for (int i = 0; i < 4; ++i) { a[i] = As[kk][ty * 4 + i]; b[i] = Ws[kk][tx * 4 + i]; }
#pragma unroll
            for (int i = 0; i < 4; ++i)
#pragma unroll
                for (int j = 0; j < 4; ++j) acc[i][j] += a[i] * b[j];
        }
        __syncthreads();
    }
#pragma unroll
    for (int i = 0; i < 4; ++i)
#pragma unroll
        for (int j = 0; j < 4; ++j) epi(m0 + ty * 4 + i, n0 + tx * 4 + j, acc[i][j]);
}
struct EpiInN {
    bf16* QH; float* LF; bf16 *VH, *GH, *AQ, *AKV, *SGH, *SGA; const float* LB;
    __device__ void operator()(int r, int c, float v) const {
        if (c < 512) QH[(size_t)r * 512 + c] = f2bf(silu_f(v));
        else if (c < 1024) { const int cc = c - 512; const float lb = LB[cc]; LF[(size_t)r * 512 + cc] = __logf(lb + (1.f - lb) * sigm_f(v)); }
        else if (c < 1536) VH[(size_t)r * 512 + (c - 1024)] = f2bf(v);
        else if (c < 2048) GH[(size_t)r * 512 + (c - 1536)] = f2bf(silu_f(v));
        else if (c < 2560) AQ[(size_t)r * 512 + (c - 2048)] = f2bf(v);
        else if (c < 2816) AKV[(size_t)r * 256 + (c - 2560)] = f2bf(v);
        else if (c < 3840) SGH[(size_t)r * 1024 + (c - 2816)] = f2bf(sigm_f(v));
        else SGA[(size_t)r * 1024 + (c - 3840)] = f2bf(sigm_f(v));
    }
};
struct EpiM1N { bf16* MRG; const bf16* SG; __device__ void operator()(int r, int c, float v) const { MRG[(size_t)r * 1024 + c] = f2bf(bf2f(SG[(size_t)r * 1024 + c]) * v); } };
struct EpiM2N { bf16* MRG; const bf16* SG; __device__ void operator()(int r, int c, float v) const { MRG[(size_t)r * 1024 + c] = f2bf(bf2f(MRG[(size_t)r * 1024 + c]) + bf2f(SG[(size_t)r * 1024 + c]) * v); } };
struct EpiOutN { const float* x; const float* MOD; float* out; __device__ void operator()(int r, int c, float v) const { out[(size_t)r * 1024 + c] = x[(size_t)r * 1024 + c] + MOD[(size_t)(r / SEQ) * 6144 + 2048 + c] * v; } };

__global__ void n_hgrn(const bf16* QH, const float* LF, const bf16* VH, float* OTMP) {
    const int bh = blockIdx.x >> 1, vh = blockIdx.x & 1, b = bh >> 2, h = bh & 3, v = threadIdx.x;
    __shared__ float S[128 * 64];
    __shared__ float sq[128], sf[128], sk[128];
    for (int i = v; i < 128 * 64; i += 64) S[i] = 0.f;
    for (int t = 0; t < SEQ; ++t) {
        const size_t row = (size_t)b * SEQ + t;
        __syncthreads();
        for (int k = v; k < 128; k += 64) { const float lf = LF[row * 512 + h * 128 + k]; const float f = __expf(lf); sf[k] = f; sk[k] = 1.f - f; sq[k] = bf2f(QH[row * 512 + h * 128 + k]); }
        __syncthreads();
        const float vv = bf2f(VH[row * 512 + h * 128 + vh * 64 + v]);
        float o = 0.f;
        for (int k = 0; k < 128; ++k) { float s = S[k * 64 + v]; s = sf[k] * s + sk[k] * vv; S[k * 64 + v] = s; o += s * sq[k]; }
        OTMP[row * 512 + h * 128 + vh * 64 + v] = o;
    }
}
__global__ void n_hgrn_norm(const float* OTMP, const float* gain, const bf16* GH, bf16* HOAO) {
    const int lane = threadIdx.x & 63, idx = blockIdx.x * 4 + (threadIdx.x >> 6), t = idx >> 2, h = idx & 3;
    const float a = OTMP[(size_t)t * 512 + h * 128 + lane], b = OTMP[(size_t)t * 512 + h * 128 + 64 + lane];
    const float rstd = rsqrtf(wave_sum(a * a + b * b) * (1.f / 128.f) + EPS);
    HOAO[(size_t)t * 1024 + h * 128 + lane] = f2bf(a * rstd * gain[lane] * bf2f(GH[(size_t)t * 512 + h * 128 + lane]));
    HOAO[(size_t)t * 1024 + h * 128 + 64 + lane] = f2bf(b * rstd * gain[64 + lane] * bf2f(GH[(size_t)t * 512 + h * 128 + 64 + lane]));
}
__global__ void n_qkn(const bf16* AQ, const bf16* AKV, const int* pos, const float* qg, const float* kg, float* QN, float* KN) {
    const int idx = blockIdx.x * 256 + threadIdx.x, t = idx / 10, j = idx % 10;
    if (t >= T) return;
    const bf16* src = j < 8 ? AQ + (size_t)t * 512 + j * 64 : AKV + (size_t)t * 256 + (j - 8) * 64;
    const float* g = j < 8 ? qg : kg;
    float* dst = j < 8 ? QN + (size_t)t * 512 + j * 64 : KN + (size_t)t * 128 + (j - 8) * 64;
    float ss = 0.f;
    for (int d = 0; d < 64; ++d) { const float v = bf2f(src[d]); ss += v * v; }
    const float rstd = rsqrtf(ss * (1.f / 64.f) + EPS);
    const int p = pos[t];
    for (int d = 0; d < 64; ++d) {
        float v = bf2f(src[d]) * rstd * g[d];
        if (d < 16) {
            const int i = d & 7; float cs, sn; rope_cs(p, i, cs, sn);
            const float x1 = bf2f(src[i]) * rstd * g[i], x2 = bf2f(src[i + 8]) * rstd * g[i + 8];
            v = d < 8 ? x1 * cs - x2 * sn : x2 * cs + x1 * sn;
        }
        dst[d] = v;
    }
}
__global__ void __launch_bounds__(256) n_attn(const float* QN, const float* KN, const bf16* AKV, const float* sinks, bf16* HOAO) {
    const int idx = blockIdx.x * 256 + threadIdx.x, t = idx >> 3, hq = idx & 7, kvh = hq >> 2, ts = t % SEQ, b0 = t - ts;
    float q[64], acc[64];
#pragma unroll
    for (int d = 0; d < 64; ++d) { q[d] = QN[(size_t)t * 512 + hq * 64 + d] * 0.125f; acc[d] = 0.f; }
    float m = sinks[hq], l = 1.f;
    for (int kt = (ts >= 127 ? ts - 127 : 0); kt <= ts; ++kt) {
        const float* kr = KN + (size_t)(b0 + kt) * 128 + kvh * 64; const bf16* vr = AKV + (size_t)(b0 + kt) * 256 + 128 + kvh * 64;
        float s = 0.f;
#pragma unroll
        for (int d = 0; d < 64; ++d) s += q[d] * kr[d];
        const float mn = fmaxf(m, s), sc = __expf(m - mn), p = __expf(s - mn);
        l = l * sc + p; m = mn;
#pragma unroll
        for (int d = 0; d < 64; ++d) acc[d] = acc[d] * sc + p * bf2f(vr[d]);
    }
    const float il = 1.f / l;
#pragma unroll
    for (int d = 0; d < 64; ++d) HOAO[(size_t)t * 1024 + 512 + hq * 64 + d] = f2bf(acc[d] * il);
}
__global__ void __launch_bounds__(256) n_route(const float* x1, const float* gain, const float* MOD, const float* wr, const float* br, bf16* H2, int* TOPI, float* TOPW) {
    const int lane = threadIdx.x & 63, row = blockIdx.x * 4 + (threadIdx.x >> 6), b = row / SEQ;
    const float4* xr = (const float4*)(x1 + (size_t)row * DM) + lane;
    float4 v[4]; float s = 0.f;
#pragma unroll
    for (int j = 0; j < 4; ++j) { v[j] = xr[64 * j]; s += v[j].x * v[j].x + v[j].y * v[j].y + v[j].z * v[j].z + v[j].w * v[j].w; }
    const float rstd = rsqrtf(wave_sum(s) * (1.f / DM) + EPS);
    const float* mb = MOD + (size_t)b * 6144;
    float hv[16];
#pragma unroll
    for (int j = 0; j < 4; ++j) {
        const int c = 4 * lane + 256 * j;
        const float4 g = *(const float4*)(gain + c), sc = *(const float4*)(mb + 4096 + c), sh = *(const float4*)(mb + 3072 + c);
        hv[4 * j + 0] = v[j].x * rstd * g.x * (1.f + sc.x) + sh.x; hv[4 * j + 1] = v[j].y * rstd * g.y * (1.f + sc.y) + sh.y;
        hv[4 * j + 2] = v[j].z * rstd * g.z * (1.f + sc.z) + sh.z; hv[4 * j + 3] = v[j].w * rstd * g.w * (1.f + sc.w) + sh.w;
        ushort4 o; o.x = f2bf(hv[4 * j]); o.y = f2bf(hv[4 * j + 1]); o.z = f2bf(hv[4 * j + 2]); o.w = f2bf(hv[4 * j + 3]);
        *(ushort4*)(H2 + (size_t)row * DM + c) = o;
    }
    float lg[32];
#pragma unroll
    for (int e = 0; e < 32; ++e) {
        float p = 0.f;
#pragma unroll
        for (int j = 0; j < 4; ++j)
#pragma unroll
            for (int i = 0; i < 4; ++i) p += hv[4 * j + i] * wr[(size_t)(4 * lane + 256 * j + i) * 32 + e];
        lg[e] = wave_sum(p) + br[e];
    }
    unsigned used = 0u; float tv[4]; int ti[4];
#pragma unroll
    for (int k = 0; k < 4; ++k) {
        float best = -INFINITY; int bi = 0;
#pragma unroll
        for (int e = 0; e < 32; ++e) { const bool ok = !((used >> e) & 1u) && lg[e] > best; best = ok ? lg[e] : best; bi = ok ? e : bi; }
        used |= 1u << bi; tv[k] = best; ti[k] = bi;
    }
    const float e1 = __expf(tv[1] - tv[0]), e2 = __expf(tv[2] - tv[0]), e3 = __expf(tv[3] - tv[0]), inv = 1.f / (1.f + e1 + e2 + e3);
    if (lane == 0) {
        TOPI[row * 4 + 0] = ti[0]; TOPI[row * 4 + 1] = ti[1]; TOPI[row * 4 + 2] = ti[2]; TOPI[row * 4 + 3] = ti[3];
        TOPW[row * 4 + 0] = inv; TOPW[row * 4 + 1] = e1 * inv; TOPW[row * 4 + 2] = e2 * inv; TOPW[row * 4 + 3] = e3 * inv;
    }
}
__global__ void n_moe(const bf16* H2, const int* TOPI, const float* TOPW, const float* w_up, const float* b_up, const float* w_dn, const float* b_dn, bf16* Y) {
    const int a = blockIdx.x, t = a >> 2, tid = threadIdx.x, e = TOPI[a];
    const float gate = TOPW[a];
    __shared__ float hr[1024], av[1024];
    for (int k = tid; k < 1024; k += 256) hr[k] = bf2f(H2[(size_t)t * 1024 + k]);
    __syncthreads();
    const float* wu = w_up + (size_t)e * 1024 * 2048; const float* bu = b_up + (size_t)e * 2048;
    float ag[4], al[4];
#pragma unroll
    for (int j = 0; j < 4; ++j) { ag[j] = 0.f; al[j] = 0.f; }
    for (int k = 0; k < 1024; ++k) {
        const float h = hr[k];
#pragma unroll
        for (int j = 0; j < 4; ++j) { const float2 w = *(const float2*)(wu + (size_t)k * 2048 + 2 * (tid + 256 * j)); ag[j] += h * w.x; al[j] += h * w.y; }
    }
#pragma unroll
    for (int j = 0; j < 4; ++j) {
        const int o = tid + 256 * j;
        const float g = fminf(ag[j] + bu[2 * o], 7.f), li = fminf(fmaxf(al[j] + bu[2 * o + 1], -7.f), 7.f);
        av[o] = g * sigm_f(1.702f * g) * (li + 1.f);
    }
    __syncthreads();
    const float* wd = w_dn + (size_t)e * 1024 * 1024; const float* bd = b_dn + (size_t)e * 1024;
    float y[4];
#pragma unroll
    for (int j = 0; j < 4; ++j) y[j] = 0.f;
    for (int k = 0; k < 1024; ++k) {
        const float h = av[k];
#pragma unroll
        for (int j = 0; j < 4; ++j) y[j] += h * wd[(size_t)k * 1024 + tid + 256 * j];
    }
#pragma unroll
    for (int j = 0; j < 4; ++j) Y[(size_t)a * 1024 + tid + 256 * j] = f2bf(gate * (y[j] + bd[tid + 256 * j]));
}
__global__ void k_final(float* out, const float* MOD, const bf16* Y) {
    const int lane = threadIdx.x & 63, row = blockIdx.x * 4 + (threadIdx.x >> 6), b = row / SEQ;
    const float* g2 = MOD + (size_t)b * 6144 + 5120;
#pragma unroll
    for (int j = 0; j < 4; ++j) {
        const int c = 4 * lane + 256 * j;
        float4 x = *(float4*)(out + (size_t)row * DM + c); const float4 g = *(const float4*)(g2 + c);
        float s0 = 0.f, s1 = 0.f, s2 = 0.f, s3 = 0.f;
#pragma unroll
        for (int k = 0; k < 4; ++k) { const ushort4 y = *(const ushort4*)(Y + ((size_t)row * 4 + k) * DM + c); s0 += bf2f(y.x); s1 += bf2f(y.y); s2 += bf2f(y.z); s3 += bf2f(y.w); }
        x.x += g.x * s0; x.y += g.y * s1; x.z += g.z * s2; x.w += g.w * s3;
        *(float4*)(out + (size_t)row * DM + c) = x;
    }
}

#endif

namespace pg8 {
#define PG8_LAS __attribute__((address_space(3)))
typedef unsigned short bf16_t;
typedef short bf16x8 __attribute__((ext_vector_type(8)));
typedef float f32x4 __attribute__((ext_vector_type(4)));
typedef unsigned u32x4 __attribute__((ext_vector_type(4))); typedef int v4i32_t __attribute__((ext_vector_type(4)));
constexpr int BM = 256, BK = 64, HALF = 128, HTB = HALF * BK * 2  , STAGE_BYTES = 8 * HTB, NXCD = 8, WGM = 8, MAXU = 24  ;

__host__ __device__ __forceinline__ int lds_byte(int r, int c) { const int st = (r >> 4) * 2 + (c >> 5), rr = r & 15, cc = c & 31, ob = rr * 64 + cc * 2; return st * 1024 + (ob ^ (((ob >> 9) & 1) << 5)); }
__host__ __device__ __forceinline__ void stage_rc(int b, int& R, int& C) { const int st = b / 1024, sb = b % 1024, swz = sb ^ (((sb >> 9) & 1) << 5); R = (st >> 1) * 16 + swz / 64; C = (st & 1) * 32 + (swz % 64) / 2; }
__host__ __device__ __forceinline__ int perm32(int rho) { const int n = rho >> 4, i = rho & 15; return 8 * (i >> 2) + 4 * n + (i & 3); }

struct Unit { int pm, pn, arow0, nvalid; unsigned abase; };
struct Gemm { const bf16_t* A; const bf16_t* Bt; int M, N, K; const int* rowidx; int zero_row; int lda; };

struct StaticOrder {
    int nM, nN, nwg, G, c; unsigned abase_per_pm;
    __host__ __device__ void init(int M, int N, int G_, int c_) { nM = M / BM; nN = N / BM; nwg = nM * nN; G = G_; c = c_; abase_per_pm = 0u; }
    __host__ __device__ bool next(int i, Unit& u) const {
        const long L = (long)i * G + c; if (L >= nwg) return false;
        int wgid = (int)L; { const int q = nwg / NXCD, r = nwg % NXCD, xcd = wgid % NXCD, off = wgid / NXCD; wgid = (xcd < r ? xcd * (q + 1) : r * (q + 1) + (xcd - r) * q) + off; }
        const int nig = WGM * nN, gid = wgid / nig, fm = gid * WGM, gsz = (nM - fm) < WGM ? (nM - fm) : WGM;
        u.pm = fm + ((wgid % nig) % gsz); u.pn = (wgid % nig) / gsz; u.arow0 = 0; u.nvalid = 0; u.abase = (unsigned)u.pm * abase_per_pm; return true;
    }
};
constexpr int UT_OFF = STAGE_BYTES + MAXU * 512;
struct CachedOrder {
    const PG8_LAS int* tab; int n;
    template <class Sched> __device__ __forceinline__ void build(PG8_LAS unsigned char* lds, const Sched& S) {
        PG8_LAS int* t = (PG8_LAS int*)(lds + UT_OFF);
        if (threadIdx.x < 64) { Unit u; u.pm = 0; u.pn = 0; u.arow0 = 0; u.nvalid = 0; u.abase = 0u; const int i = threadIdx.x; const bool ok = (i < MAXU) && S.next(i, u);
            if (ok) { t[8 * i] = u.pm; t[8 * i + 1] = u.pn; t[8 * i + 2] = u.arow0; t[8 * i + 3] = u.nvalid; t[8 * i + 4] = (int)u.abase; }
            const unsigned long long m = __ballot(ok); if (i == 0) t[8 * MAXU] = __popcll(m); }
        __syncthreads();
        tab = t; n = __builtin_amdgcn_readfirstlane(t[8 * MAXU]);
    }
    __device__ __forceinline__ bool next(int i, Unit& u) const {
        if (i >= n) return false;
        const v4i32_t a = *(const PG8_LAS v4i32_t*)(tab + 8 * i); u.pm = __builtin_amdgcn_readfirstlane(a.x); u.pn = __builtin_amdgcn_readfirstlane(a.y); u.arow0 = __builtin_amdgcn_readfirstlane(a.z); u.nvalid = __builtin_amdgcn_readfirstlane(a.w);
        u.abase = (unsigned)__builtin_amdgcn_readfirstlane(tab[8 * i + 4]); return true;
    }
};
__device__ __forceinline__ unsigned cvt_pk_bf16(float lo, float hi) { unsigned r; asm volatile("v_cvt_pk_bf16_f32 %0, %1, %2" : "=v"(r) : "v"(lo), "v"(hi)); return r; }

__host__ __device__ __forceinline__ int tk_pos(int r) { return (r & 63) * 4 + ((r >> 7) & 1) + 2 * ((r >> 6) & 1); }
typedef int v8i32 __attribute__((ext_vector_type(8))); typedef int v4i32 __attribute__((ext_vector_type(4)));
template <class Epi, class Sched, bool ALIGN_EPI, int GATHER, int EB = 2, int PROBE = 0, int STAMP = 0>
__device__ __forceinline__ void gemm_phase(PG8_LAS unsigned char* lds, const Gemm g, const Sched& S, const Epi& E, unsigned long long* dbg = nullptr) {
    unsigned long long st_all = 0, st_k = 0, st_e = 0, st_t = 0; if constexpr (STAMP) st_all = __builtin_amdgcn_s_memrealtime();
    const int tid = threadIdx.x, wid = __builtin_amdgcn_readfirstlane(tid >> 6), lane = tid & 63, wr = wid >> 2, wc = wid & 3, fr = lane & 15, fq = lane >> 4;
    const int K = g.K, nt = K * EB / (BK * 2), lda = g.lda;
    unsigned voffA[2], voffB[2];
#pragma unroll
    for (int i = 0; i < 2; ++i) { int R, C; stage_rc(tid * 16 + i * 8192, R, C); const int Rb = Epi::PERM ? ((R & ~31) + perm32(R & 31)) : R;
        voffA[i] = (unsigned)(R * lda * EB + C * 2); voffB[i] = (unsigned)(Rb * K * EB + C * 2); }
    unsigned tokP[2], cpk = 0, abase = 0;
    const size_t kstep = (size_t)(BK * 2);
    const size_t hstep = (size_t)HALF * K * EB;
    const size_t hstepA = GATHER ? 0 : (size_t)HALF * lda * EB; const size_t tstepA = (size_t)BM * lda * EB;
    const size_t tstep = 2 * hstep;
    const unsigned ldsw = (unsigned)wid * 1024u;
    const int aoff = lds_byte(wr * 64 + fr, fq * 8), boff = lds_byte(wc * 32 + fr, fq * 8);
#define PG8_SA(b, h) (((b) * 2 + (h)) * HTB)
#define PG8_SB(b, h) ((4 + (b) * 2 + (h)) * HTB)
#define PG8_STAGE(bufoff, gbase, voff) do { _Pragma("unroll") for (int _i = 0; _i < 2; ++_i) \
        __builtin_amdgcn_global_load_lds((const unsigned*)((const char*)(gbase) + (voff)[_i]), (PG8_LAS unsigned*)(lds + (bufoff) + ldsw + _i * 8192), 16, 0, 0); } while (0)
#define PG8_STAGE_A(b, h, gbase) do { if constexpr (PROBE == 2) { PG8_STAGE(PG8_SA(b, h), cB, voffB); } else if constexpr (GATHER) { _Pragma("unroll") for (int _i = 0; _i < 2; ++_i) { const unsigned off_ = ((tokP[_i] >> (16 * (h))) & 0xffffu) * (unsigned)(lda * EB) + ((cpk >> (8 * _i)) & 0xffu) + abase; \
        __builtin_amdgcn_global_load_lds((const unsigned*)((const char*)(gbase) + off_), (PG8_LAS unsigned*)(lds + PG8_SA(b, h) + ldsw + _i * 8192), 16, 0, 0); } } else { PG8_STAGE(PG8_SA(b, h), (gbase) + (h) * hstepA, voffA); } } while (0)
#define PG8_GOFF(dst, uo) do { if constexpr (GATHER == 1) { int R_, C_; stage_rc(tid * 16, R_, C_); const unsigned long long tn_ = *(const PG8_LAS unsigned long long*)(lds + STAGE_BYTES + (uo) * 512 + R_ * 8); dst[0] = (unsigned)tn_; dst[1] = (unsigned)(tn_ >> 32); } \
        else { int R_, C_; stage_rc(tid * 16, R_, C_); dst[0] = (unsigned)R_ | ((unsigned)(HALF + R_) << 16); dst[1] = (unsigned)(R_ + 64) | ((unsigned)(HALF + 64 + R_) << 16); } } while (0)
#define PG8_LD8(addr) __builtin_shufflevector(*(const PG8_LAS v4i32*)(addr), *(const PG8_LAS v4i32*)((addr) + 1024), 0, 1, 2, 3, 4, 5, 6, 7)
#define PG8_LDA(dst, b, h) do { if constexpr (EB == 2) { _Pragma("unroll") for (int m = 0; m < 4; ++m) _Pragma("unroll") for (int k = 0; k < 2; ++k) dst[m][k] = *(const PG8_LAS bf16x8*)(lds + PG8_SA(b, h) + aoff + m * 2048 + k * 1024); } \
        else { _Pragma("unroll") for (int m = 0; m < 4; ++m) dst##8[m] = PG8_LD8(lds + PG8_SA(b, h) + aoff + m * 2048); } } while (0)
#define PG8_LDB(dst, b, h) do { if constexpr (EB == 2) { _Pragma("unroll") for (int n = 0; n < 2; ++n) _Pragma("unroll") for (int k = 0; k < 2; ++k) dst[n][k] = *(const PG8_LAS bf16x8*)(lds + PG8_SB(b, h) + boff + n * 2048 + k * 1024); } \
        else { _Pragma("unroll") for (int n = 0; n < 2; ++n) dst##8[n] = PG8_LD8(lds + PG8_SB(b, h) + boff + n * 2048); } } while (0)
#define PG8_MMA(ai, bj, At, Bt) do { __builtin_amdgcn_s_setprio(1); if constexpr (EB == 2) { _Pragma("unroll") for (int m = 0; m < 4; ++m) _Pragma("unroll") for (int n = 0; n < 2; ++n) _Pragma("unroll") for (int k = 0; k < 2; ++k) \
        acc[ai][bj][m][n] = __builtin_amdgcn_mfma_f32_16x16x32_bf16(Bt[n][k], At[m][k], acc[ai][bj][m][n], 0, 0, 0); } else { _Pragma("unroll") for (int m = 0; m < 4; ++m) _Pragma("unroll") for (int n = 0; n < 2; ++n) \
        acc[ai][bj][m][n] = __builtin_amdgcn_mfma_scale_f32_16x16x128_f8f6f4(Bt##8[n], At##8[m], acc[ai][bj][m][n], 0, 0, 0, 0x7F7F7F7F, 0, 0x7F7F7F7F); } __builtin_amdgcn_s_setprio(0); } while (0)
#define PG8_WAIT_V(n) asm volatile("s_waitcnt vmcnt(" #n ")" ::: "memory")
#define PG8_WAIT_VX(flag) do { if constexpr (Epi::NST > 0) { asm volatile("s_cmp_lg_u32 %0, 0\n\ts_cbranch_scc1 .LWX%=\n\ts_waitcnt vmcnt(8)\n\ts_branch .LWY%=\n.LWX%=:\n\ts_waitcnt vmcnt(%1)\n.LWY%=:" :: "s"(flag), "i"(8 + Epi::NST) : "memory", "scc"); } \
        else { asm volatile("s_waitcnt vmcnt(8)" ::: "memory"); } } while (0)
#define PG8_WAIT_L(n) asm volatile("s_waitcnt lgkmcnt(" #n ")" ::: "memory")
#define PG8_BAR __builtin_amdgcn_s_barrier()
#define PG8_SCHED __builtin_amdgcn_sched_barrier(0)
    Unit cur, nxt; int ui = 0;
    if (!S.next(0, cur)) return;
    f32x4 acc[2][2][4][2];
#pragma unroll
    for (int a = 0; a < 2; ++a)
#pragma unroll
        for (int b = 0; b < 2; ++b)
#pragma unroll
            for (int m = 0; m < 4; ++m)
#pragma unroll
                for (int n = 0; n < 2; ++n) acc[a][b][m][n] = (f32x4){0.f, 0.f, 0.f, 0.f};
    bf16x8 At[4][2], B0[2][2], B1[2][2]; v8i32 At8[4], B08[2], B18[2];
    const char* cA = GATHER ? (const char*)g.A : (const char*)g.A + (size_t)cur.pm * tstepA; const char* cB = (const char*)g.Bt + (size_t)cur.pn * tstep;
    if constexpr (GATHER != 0) abase = cur.abase;
    if constexpr (GATHER) { PG8_GOFF(tokP, 0); int R0_, C0_, R1_, C1_; stage_rc(tid * 16, R0_, C0_); stage_rc(tid * 16 + 8192, R1_, C1_); cpk = (unsigned)(C0_ * 2) | ((unsigned)(C1_ * 2) << 8); }
    PG8_STAGE(PG8_SB(0, 0), cB, voffB); PG8_STAGE(PG8_SB(0, 1), cB + hstep, voffB); PG8_STAGE_A(0, 0, cA); PG8_STAGE_A(0, 1, cA);
    if (wr == 1) PG8_BAR;
    PG8_WAIT_V(2); PG8_BAR;
    PG8_STAGE(PG8_SB(1, 0), cB + kstep, voffB); PG8_STAGE_A(1, 0, cA + kstep); PG8_STAGE(PG8_SB(1, 1), cB + hstep + kstep, voffB);
    PG8_WAIT_V(6); PG8_BAR;
    for (;;) {
        const bool has_next = S.next(ui + 1, nxt);
        const char* nA = GATHER ? cA : (has_next ? (const char*)g.A + (size_t)nxt.pm * tstepA : cA); const char* nB = has_next ? (const char*)g.Bt + (size_t)nxt.pn * tstep : cB;
        if constexpr (STAMP) st_t = __builtin_amdgcn_s_memrealtime();
#pragma nounroll
        for (int t = 0; t < nt; t += 2) {
            const bool last = (t == nt - 2);
            const int relax_ = __builtin_amdgcn_readfirstlane((t == 0 && ui > 0) ? 1 : 0);
            if constexpr (GATHER != 0) asm volatile("" : "+v"(tokP[0]), "+v"(tokP[1]), "+v"(cpk));
            const char* a1 = cA + (size_t)(t + 1) * kstep;
            const char* a2 = last ? nA : cA + (size_t)(t + 2) * kstep; const char* b2 = last ? nB : cB + (size_t)(t + 2) * kstep;
            const char* a3 = a2 + kstep; const char* b3 = b2 + kstep;
            PG8_LDB(B0, 0, 0); PG8_LDB(B1, 0, 1); PG8_SCHED; PG8_LDA(At, 0, 0); PG8_STAGE_A(1, 1, a1);
            PG8_WAIT_VX(relax_);
            PG8_WAIT_L(0); PG8_BAR; PG8_MMA(0, 0, At, B0); if constexpr (PROBE != 1) PG8_MMA(0, 1, At, B1); PG8_BAR; PG8_SCHED;
            if constexpr (GATHER != 0) { if (last && has_next) abase = nxt.abase; }
            if constexpr (GATHER == 1) { if (last && has_next) { PG8_GOFF(tokP, ui + 1); } }
            PG8_LDA(At, 0, 1); PG8_STAGE(PG8_SB(0, 0), b2, voffB); PG8_STAGE(PG8_SB(0, 1), b2 + hstep, voffB); PG8_STAGE_A(0, 0, a2);
            PG8_WAIT_VX(relax_);
            PG8_WAIT_L(0); PG8_BAR; PG8_MMA(1, 0, At, B0); if constexpr (PROBE != 1) PG8_MMA(1, 1, At, B1); PG8_BAR; PG8_SCHED;
            PG8_LDB(B0, 1, 0); PG8_LDB(B1, 1, 1); PG8_SCHED; PG8_LDA(At, 1, 0); PG8_STAGE_A(0, 1, a2);
            PG8_WAIT_V(8); PG8_WAIT_L(0); PG8_BAR; PG8_MMA(0, 0, At, B0); if constexpr (PROBE != 1) PG8_MMA(0, 1, At, B1); PG8_BAR; PG8_SCHED;
            PG8_LDA(At, 1, 1); PG8_STAGE(PG8_SB(1, 0), b3, voffB); PG8_STAGE(PG8_SB(1, 1), b3 + hstep, voffB); PG8_STAGE_A(1, 0, a3);
            PG8_WAIT_V(8); PG8_WAIT_L(0); PG8_BAR; PG8_MMA(1, 0, At, B0); if constexpr (PROBE != 1) PG8_MMA(1, 1, At, B1); PG8_BAR; PG8_SCHED;
        }
        if constexpr (STAMP) { const unsigned long long n_ = __builtin_amdgcn_s_memrealtime(); st_k += n_ - st_t; st_t = n_; }
        if constexpr (ALIGN_EPI) { if (wr == 0) PG8_BAR; }
        bool keep = false;
        if constexpr (Epi::HAS_MID) { if (cur.nvalid == 1) { E.mid(acc, cur, wr, wc, fr, fq); keep = true; } else { E(acc, cur, wr, wc, fr, fq); } } else { E(acc, cur, wr, wc, fr, fq); }
        if constexpr (STAMP) { const unsigned long long n_ = __builtin_amdgcn_s_memrealtime(); st_e += n_ - st_t; }
        if (!has_next) break;
        if (!keep) {
#pragma unroll
        for (int a = 0; a < 2; ++a)
#pragma unroll
            for (int b = 0; b < 2; ++b)
#pragma unroll
                for (int m = 0; m < 4; ++m)
#pragma unroll
                    for (int n = 0; n < 2; ++n) acc[a][b][m][n] = (f32x4){0.f, 0.f, 0.f, 0.f};
        }
        cur = nxt; cA = nA; cB = nB; ++ui;
        if constexpr (ALIGN_EPI) { if (wr == 1) PG8_BAR; }
    }
    PG8_WAIT_V(0);
    if constexpr (!ALIGN_EPI) { if (wr == 0) PG8_BAR; }
    PG8_BAR;
    if constexpr (STAMP) { if (blockIdx.x == STAMP - 1 && threadIdx.x == 0 && dbg) { dbg[0] = __builtin_amdgcn_s_memrealtime() - st_all; dbg[1] = st_k; dbg[2] = st_e; dbg[3] = (unsigned long long)(ui + 1); } }
#undef PG8_SA
#undef PG8_SB
#undef PG8_STAGE
#undef PG8_STAGE_A
#undef PG8_GOFF
#undef PG8_LDA
#undef PG8_LDB
#undef PG8_MMA
#undef PG8_LD8
#undef PG8_WAIT_V
#undef PG8_WAIT_VX
#undef PG8_WAIT_L
#undef PG8_BAR
#undef PG8_SCHED
}
}

constexpr int NWAVES = 8;
constexpr int LDS_BYTES = 163840;
constexpr int LDSCTL_OFF = 162816;
constexpr int MISC_OFF = LDSCTL_OFF;
constexpr int CW_BAR = 4096;
constexpr int CW_CNT = 64;
constexpr size_t CTL_ZERO_BYTES = 64 * 1024;

#define GAS __attribute__((address_space(1)))
#define LAS __attribute__((address_space(3)))
typedef unsigned v4u __attribute__((ext_vector_type(4)));
typedef float f32x4 __attribute__((ext_vector_type(4)));
typedef short bf16x8 __attribute__((ext_vector_type(8)));
typedef GAS unsigned gu32;
#define RLX_AGENT __ATOMIC_RELAXED, __HIP_MEMORY_SCOPE_AGENT
#define LDS_WAIT() asm volatile("s_waitcnt lgkmcnt(0)" ::: "memory")
#define VM_WAIT() asm volatile("s_waitcnt vmcnt(0)" ::: "memory")
__device__ __forceinline__ unsigned pk2(float lo, float hi) { return cvtpk_s(lo, hi); }
__device__ __forceinline__ float fsigm(float x) { return __builtin_amdgcn_rcpf(1.f + __expf(-x)); }

#define XB_TMO      128
#define XB_XCNT(j)  (256  + 64 * (j))
#define XB_XSUB(j)  (1280 + 64 * (j))
#define XB_XGEN(j)  (2304 + 64 * (j))
#define XB_TOP      3328
#define XB_TOPGEN   3392
#define XCD_BAR_WORDS 3456
#define XB_SPIN_CAP (1u << 18)

__device__ __forceinline__ unsigned xb_ld(unsigned* p)              { return __hip_atomic_load(p, __ATOMIC_RELAXED, __HIP_MEMORY_SCOPE_AGENT); }
__device__ __forceinline__ unsigned xb_add(unsigned* p, unsigned v) { return __hip_atomic_fetch_add(p, v, __ATOMIC_RELAXED, __HIP_MEMORY_SCOPE_AGENT); }
__device__ __forceinline__ unsigned xb_xcc_id() { return (unsigned)__builtin_amdgcn_s_getreg((3 << 11) | 20) & 0xFu; }
#define XB_SPIN(cond, bar) do { unsigned _sp = 0; while (cond) { __builtin_amdgcn_s_sleep(1); \
    if ((++_sp & 255u) == 0u) { if (xb_ld(&(bar)[XB_TMO])) break; if (_sp > XB_SPIN_CAP) { atomicAdd(&(bar)[XB_TMO], 1u); break; } } } } while (0)

struct XcdBarrier {
    unsigned* bar; unsigned x;
    volatile LAS unsigned* st;
};

__device__ __forceinline__ XcdBarrier xcd_barrier_post(unsigned* bar, volatile LAS unsigned* st) {
    XcdBarrier b; b.bar = bar; b.x = xb_xcc_id(); b.st = st;
    if (threadIdx.x == 0) (void)xb_add(&bar[XB_XCNT(b.x)], 1u);
    return b;
}
__device__ __forceinline__ void xcd_barrier_complete(unsigned* bar, unsigned x, unsigned& nloc, unsigned& nx) {
    const unsigned G = gridDim.x * gridDim.y * gridDim.z;
    unsigned sum, cnt, mine, sp = 0u;
    for (;;) {
        sum = 0u; cnt = 0u; mine = 0u;
#pragma unroll
        for (unsigned j = 0; j < 16; ++j) { const unsigned c = xb_ld(&bar[XB_XCNT(j)]); sum += c; cnt += (c > 0u) ? 1u : 0u; mine = (j == x) ? c : mine; }
        if (sum == G) break;
        __builtin_amdgcn_s_sleep(1);
        if ((++sp & 255u) == 0u) { if (xb_ld(&bar[XB_TMO])) break; if (sp > XB_SPIN_CAP) { atomicAdd(&bar[XB_TMO], 1u); break; } }
    }
    nloc = mine > 0u ? mine : 1u; nx = cnt > 0u ? cnt : 1u;
}

__device__ __forceinline__ void xcd_barrier(const XcdBarrier& b) {
    asm volatile("s_waitcnt vmcnt(0)" ::: "memory");
    __syncthreads();
    if (threadIdx.x == 0) {
        unsigned* bar = b.bar;
        __builtin_amdgcn_s_waitcnt(0);
        unsigned nloc = b.st[0], nx = b.st[1];
        if (nloc == 0u) { xcd_barrier_complete(bar, b.x, nloc, nx); b.st[0] = nloc; b.st[1] = nx; }
        const unsigned old = xb_add(&bar[XB_XSUB(b.x)], 1u);
        const unsigned gen = old / nloc;
        if (old + 1u == (gen + 1u) * nloc) {
            __builtin_amdgcn_fence(__ATOMIC_RELEASE, "agent");
            asm volatile("s_waitcnt vmcnt(0)" ::: "memory");
            const unsigned og = xb_add(&bar[XB_TOP], 1u);
            const unsigned tg = og / nx;
            if (og + 1u == (tg + 1u) * nx) xb_add(&bar[XB_TOPGEN], 1u);
            else XB_SPIN(xb_ld(&bar[XB_TOPGEN]) == tg, bar);
            __builtin_amdgcn_fence(__ATOMIC_ACQUIRE, "agent");
            xb_add(&bar[XB_XGEN(b.x)], 1u);
            asm volatile("s_waitcnt vmcnt(0)" ::: "memory");
        } else {
            XB_SPIN(xb_ld(&bar[XB_XGEN(b.x)]) == gen, bar);
            __builtin_amdgcn_fence(__ATOMIC_ACQUIRE, "agent");
            asm volatile("s_waitcnt vmcnt(0)" ::: "memory");
        }
    }
    __syncthreads();
}

__device__ __forceinline__ const void* inptr(int k) { const __attribute__((address_space(4))) char* ka = (const __attribute__((address_space(4))) char*)__builtin_amdgcn_kernarg_segment_ptr(); asm volatile("" : "+s"(ka)); return (const void*)(*(const __attribute__((address_space(4))) unsigned long long*)(ka + 8 * k)); }
struct Frame {
    LAS unsigned char* lds; volatile LAS unsigned* MISC; gu32* ctl; int tid, lane, wave, G;
    float* out; unsigned char* ws;
    __device__ __forceinline__ const float* x() const { return (const float*)inptr(0); }
    __device__ __forceinline__ const float* c() const { return (const float*)inptr(1); }
    __device__ __forceinline__ const int* pos() const { return (const int*)inptr(2); }
    __device__ __forceinline__ const float* w_ada() const { return (const float*)inptr(3); }
    __device__ __forceinline__ const float* b_ada() const { return (const float*)inptr(4); }
    __device__ __forceinline__ const float* n1g() const { return (const float*)inptr(5); }
    __device__ __forceinline__ const float* w_in() const { return (const float*)inptr(6); }
    __device__ __forceinline__ const float* lbl() const { return (const float*)inptr(7); }
    __device__ __forceinline__ const float* hgg() const { return (const float*)inptr(8); }
    __device__ __forceinline__ const float* w_hg() const { return (const float*)inptr(9); }
    __device__ __forceinline__ const float* qg() const { return (const float*)inptr(10); }
    __device__ __forceinline__ const float* kg() const { return (const float*)inptr(11); }
    __device__ __forceinline__ const float* sinks() const { return (const float*)inptr(12); }
    __device__ __forceinline__ const float* w_att() const { return (const float*)inptr(13); }
    __device__ __forceinline__ const float* w_out() const { return (const float*)inptr(14); }
    __device__ __forceinline__ const float* n2g() const { return (const float*)inptr(15); }
    __device__ __forceinline__ const float* w_r() const { return (const float*)inptr(16); }
    __device__ __forceinline__ const float* b_r() const { return (const float*)inptr(17); }
    __device__ __forceinline__ const float* w_up() const { return (const float*)inptr(18); }
    __device__ __forceinline__ const float* b_up() const { return (const float*)inptr(19); }
    __device__ __forceinline__ const float* w_dn() const { return (const float*)inptr(20); }
    __device__ __forceinline__ const float* b_dn() const { return (const float*)inptr(21); }
};
__device__ __forceinline__ int up_vrow(int c) { const int o = c >> 1; return 256 * (o >> 7) + 128 * (c & 1) + (o & 127); }

template <int MAP> __device__ __forceinline__ void p0_item(const float* W, int K, int N, bf16* WT, LAS float* scr, int kb, int nb, int lane) {
    const int k0 = 64 * kb, n0 = 64 * nb;
#pragma unroll 4
    for (int i = 0; i < 16; ++i) { const int kk = 4 * i + (lane >> 4); const f32x4 v = *(const GAS f32x4*)(W + (size_t)(k0 + kk) * N + n0 + 4 * (lane & 15));
        LAS float* d = scr + kk * 65 + 4 * (lane & 15); d[0] = v.x; d[1] = v.y; d[2] = v.z; d[3] = v.w; }
    LDS_WAIT(); asm volatile("" ::: "memory");
    const int c = lane >> 3;
#pragma unroll
    for (int j = 0; j < 8; ++j) { const int n = (lane & 7) + 8 * j; const LAS float* s = scr + (8 * c) * 65 + n;
        v4u o; o.x = pk2(s[0], s[65]); o.y = pk2(s[130], s[195]); o.z = pk2(s[260], s[325]); o.w = pk2(s[390], s[455]);
        const int col = n0 + n, row = MAP ? up_vrow(col) : col;
        *(GAS v4u*)(WT + (size_t)row * K + k0 + 8 * c) = o; }
    LDS_WAIT(); asm volatile("" ::: "memory");
}
__device__ __forceinline__ unsigned pk4_fp8(float a, float b, float c, float d) { int w = 0; w = __builtin_amdgcn_cvt_pk_fp8_f32(a, b, w, false); w = __builtin_amdgcn_cvt_pk_fp8_f32(c, d, w, true); return (unsigned)w; }
constexpr float W8_SCALE = 32.f, W8_INV = 1.f / 32.f;
template <int MAP> __device__ __forceinline__ void p0_item8(const float* W, int K, int N, unsigned char* WT, LAS float* scr, int kb, int nb, int lane) {
    const int k0 = 64 * kb, n0 = 64 * nb;
#pragma unroll 4
    for (int i = 0; i < 16; ++i) { const int kk = 4 * i + (lane >> 4); const f32x4 v = __builtin_nontemporal_load((const GAS f32x4*)(W + (size_t)(k0 + kk) * N + n0 + 4 * (lane & 15)));
        LAS float* d = scr + kk * 65 + 4 * (lane & 15); d[0] = v.x; d[1] = v.y; d[2] = v.z; d[3] = v.w; }
    LDS_WAIT(); asm volatile("" ::: "memory");
    const int c = lane >> 4;
#pragma unroll
    for (int j = 0; j < 4; ++j) { const int n = (lane & 15) + 16 * j; const LAS float* s = scr + (16 * c) * 65 + n;
        v4u o; o.x = pk4_fp8(s[0] * W8_SCALE, s[65] * W8_SCALE, s[130] * W8_SCALE, s[195] * W8_SCALE); o.y = pk4_fp8(s[260] * W8_SCALE, s[325] * W8_SCALE, s[390] * W8_SCALE, s[455] * W8_SCALE);
        o.z = pk4_fp8(s[520] * W8_SCALE, s[585] * W8_SCALE, s[650] * W8_SCALE, s[715] * W8_SCALE); o.w = pk4_fp8(s[780] * W8_SCALE, s[845] * W8_SCALE, s[910] * W8_SCALE, s[975] * W8_SCALE);
        const int col = n0 + n, row = MAP ? up_vrow(col) : col;
        *(GAS v4u*)(WT + (size_t)row * K + k0 + 16 * c) = o; }
    LDS_WAIT(); asm volatile("" ::: "memory");
}
__device__ __forceinline__ void p0_mod(Frame& F) {
    LAS float* cT = (LAS float*)F.lds;
    LAS float* red = (LAS float*)(F.lds + 69632);
    const int wg = blockIdx.x;
    for (int i = F.tid; i < 16 * 1024; i += 512) { const int b = i >> 10, k = i & 1023; cT[k * 16 + (k >> 4) * 4 + b] = silu_f(F.c()[i]); }
    __syncthreads();
    const int ks = F.tid >> 3, c4 = F.tid & 7, col = wg * 32 + 4 * c4;
    float acc[16][4];
#pragma unroll
    for (int b = 0; b < 16; ++b)
#pragma unroll
        for (int j = 0; j < 4; ++j) acc[b][j] = 0.f;
#pragma unroll 4
    for (int r = 0; r < 16; ++r) {
        const int k = ks * 16 + r; const f32x4 w = __builtin_nontemporal_load((const GAS f32x4*)(F.w_ada() + (size_t)k * 6144 + col));
        const LAS f32x4* cp = (const LAS f32x4*)(cT + k * 16 + (k >> 4) * 4);
#pragma unroll
        for (int q = 0; q < 4; ++q) { const f32x4 cv = cp[q];
#pragma unroll
            for (int j = 0; j < 4; ++j) { acc[4 * q + j][0] += cv[j] * w.x; acc[4 * q + j][1] += cv[j] * w.y; acc[4 * q + j][2] += cv[j] * w.z; acc[4 * q + j][3] += cv[j] * w.w; } }
    }
#pragma unroll
    for (int b = 0; b < 16; ++b)
#pragma unroll
        for (int j = 0; j < 4; ++j) { float v = acc[b][j]; v += __shfl_xor(v, 8); v += __shfl_xor(v, 16); v += __shfl_xor(v, 32); acc[b][j] = v; }
    if (F.lane < 8) {
#pragma unroll
        for (int b = 0; b < 16; ++b)
#pragma unroll
            for (int j = 0; j < 4; ++j) red[(F.wave * 16 + b) * 32 + 4 * c4 + j] = acc[b][j];
    }
    __syncthreads();
    { const int b = F.tid >> 5, cc = F.tid & 31; float s = 0.f;
#pragma unroll
      for (int w = 0; w < 8; ++w) s += red[(w * 16 + b) * 32 + cc];
      ((float*)(F.ws + WS_MOD))[b * 6144 + wg * 32 + cc] = s + F.b_ada()[wg * 32 + cc]; }
    __syncthreads();
}
__device__ __forceinline__ void p0_prologue(Frame& F) {
    if (blockIdx.x < 192) p0_mod(F);
    else {
        const int i = ((int)blockIdx.x - 192) * 512 + F.tid;
        float* BUPP = (float*)(F.ws + WS_BUPP);
#pragma unroll
        for (int q = 0; q < 2; ++q) { const int idx = i * 2 + q, e = idx >> 11, c = idx & 2047; BUPP[e * 2048 + up_vrow(c)] = F.b_up()[idx]; }
        if (i < 512) ((float*)(F.ws + WS_LB))[i] = 1.f / (1.f + __expf(F.lbl()[512 + i] - F.lbl()[i]));
        if (i >= 1024 && i < 1280) ((unsigned*)(F.ws + WS_H2))[(size_t)T * 256 + (i - 1024)] = 0u;
        if (i >= 2048 && i < 2304) ((int*)(F.ws + WS_IDT))[i - 2048] = (i - 2048) << 2;
    }
}
__device__ __forceinline__ void dense_weight_copies(Frame& F) {
    LAS float* scr = (LAS float*)(F.lds + F.wave * 16640);
    const int gw = (int)blockIdx.x * NWAVES + F.wave, NGW = F.G * NWAVES;
    constexpr int I_IN = 16 * 76, I_HG = 8 * 16, I_OUT = 16 * 16;
    constexpr int NITEMS = I_IN + 2 * I_HG + I_OUT;
    for (int it = gw; it < NITEMS; it += NGW) {
        int r = it;
        if (r < I_IN) { p0_item8<0>(F.w_in(), 1024, INW, F.ws + WS_WIN, scr, r / 76, r % 76, F.lane); continue; } r -= I_IN;
        if (r < I_HG) { p0_item8<0>(F.w_hg(), 512, 1024, F.ws + WS_WHG, scr, r / 16, r % 16, F.lane); continue; } r -= I_HG;
        if (r < I_HG) { p0_item8<0>(F.w_att(), 512, 1024, F.ws + WS_WATT, scr, r / 16, r % 16, F.lane); continue; } r -= I_HG;
        p0_item8<0>(F.w_out(), 1024, 1024, F.ws + WS_WOUT, scr, r / 16, r % 16, F.lane);
    }
}
__device__ __forceinline__ void moe_weight_copies(Frame& F, int gw, int NGW) {
    LAS float* scr = (LAS float*)(F.lds + F.wave * 16640);
    constexpr int I_UP = 16 * 32, I_DN = 16 * 16;
    for (int it = gw; it < 32 * (I_UP + I_DN); it += NGW) {
        int r = it;
        if (r < 32 * I_UP) { const int e = r / I_UP, q = r % I_UP; p0_item8<1>(F.w_up() + (size_t)e * 1024 * 2048, 1024, 2048, F.ws + WS_WUP + (size_t)e * 2048 * 1024, scr, q / 32, q % 32, F.lane); continue; } r -= 32 * I_UP;
        { const int e = r / I_DN, q = r % I_DN; p0_item8<0>(F.w_dn() + (size_t)e * 1024 * 1024, 1024, 1024, F.ws + WS_WDN + (size_t)e * 1024 * 1024, scr, q / 16, q % 16, F.lane); }
    }
}
__device__ __forceinline__ void normmod_row8(const float* xrow, const float* gain, const float* sh, const float* sc, unsigned char* orow, int lane) {
    const GAS f32x4* xr = (const GAS f32x4*)xrow + lane;
    f32x4 v[4]; float s = 0.f;
#pragma unroll
    for (int j = 0; j < 4; ++j) { v[j] = __builtin_nontemporal_load(xr + 64 * j); s += (v[j].x * v[j].x + v[j].y * v[j].y) + (v[j].z * v[j].z + v[j].w * v[j].w); }
    const float rstd = rsqrtf(wave_sum(s) * (1.f / DM) + EPS);
#pragma unroll
    for (int j = 0; j < 4; ++j) {
        const int c = 4 * lane + 256 * j;
        const f32x4 g = *(const GAS f32x4*)(gain + c), a = *(const GAS f32x4*)(sc + c), b = *(const GAS f32x4*)(sh + c);
        *(GAS unsigned*)(orow + c) = pk4_fp8(v[j].x * rstd * g.x * (1.f + a.x) + b.x, v[j].y * rstd * g.y * (1.f + a.y) + b.y, v[j].z * rstd * g.z * (1.f + a.z) + b.z, v[j].w * rstd * g.w * (1.f + a.w) + b.w);
    }
}
__device__ __forceinline__ void p1_xn(Frame& F) {
    const int gw = (int)blockIdx.x * NWAVES + F.wave, NGW = F.G * NWAVES; const float* MOD = (const float*)(F.ws + WS_MOD); unsigned char* XN = F.ws + WS_XN;
    for (int m = gw; m < T; m += NGW) { const float* mb = MOD + (size_t)(m / SEQ) * 6144; normmod_row8(F.x() + (size_t)m * DM, F.n1g(), mb, mb + 1024, XN + (size_t)m * DM, F.lane); }
}

typedef float f32x2 __attribute__((ext_vector_type(2)));
__device__ __forceinline__ f32x2 ex2_2(f32x2 t) { return (f32x2){__builtin_amdgcn_exp2f(t.x), __builtin_amdgcn_exp2f(t.y)}; }
__device__ __forceinline__ f32x2 rcp_2(f32x2 t) { return (f32x2){__builtin_amdgcn_rcpf(t.x), __builtin_amdgcn_rcpf(t.y)}; }
__device__ __forceinline__ f32x2 sigm_2(f32x2 x) { return rcp_2(ex2_2(x * (-1.4426950408889634f)) + 1.0f); }
__device__ __forceinline__ f32x2 swiglu_2(f32x2 g, f32x2 l) {
    const f32x2 ga = {fminf(g.x, 7.f), fminf(g.y, 7.f)}, la = {__builtin_amdgcn_fmed3f(l.x, -7.f, 7.f), __builtin_amdgcn_fmed3f(l.y, -7.f, 7.f)};
    return (ga * rcp_2(ex2_2(ga * (-1.702f * 1.4426950408889634f)) + 1.0f)) * (la + 1.0f);
}
__device__ __forceinline__ float bflo(unsigned u) { return __uint_as_float(u << 16); }
__device__ __forceinline__ float bfhi(unsigned u) { return __uint_as_float(u & 0xffff0000u); }
struct EpiIn {
    static constexpr bool PERM = true, HAS_MID = false; static constexpr int NST = 0; unsigned char* ws;
    __device__ __forceinline__ void operator()(const f32x4 (&acc)[2][2][4][2], const pg8::Unit& u, int wr, int wc, int fr, int fq) const {
        const int pn = u.pn, row0 = u.pm * 256 + wr * 64 + fr, cl = wc * 32 + 8 * fq;
        if (pn == 2 || pn == 3) {
            bf16* LF = (bf16*)(ws + WS_LF); const float* LB = (const float*)(ws + WS_LB); const int cb = (pn - 2) * 256;
#pragma unroll
            for (int bj = 0; bj < 2; ++bj) { const int col = cb + 128 * bj + cl; const f32x4 l0 = *(const f32x4*)(LB + col), l1 = *(const f32x4*)(LB + col + 4);
#pragma unroll
                for (int ai = 0; ai < 2; ++ai)
#pragma unroll
                    for (int m = 0; m < 4; ++m) { bf16* rp = LF + (size_t)(row0 + 128 * ai + 16 * m) * 512 + col; const f32x4 v0 = acc[ai][bj][m][0] * W8_INV, v1 = acc[ai][bj][m][1] * W8_INV; f32x4 o0, o1;
                        { const f32x2 s0 = sigm_2((f32x2){v0[0], v0[1]}), s1 = sigm_2((f32x2){v0[2], v0[3]}), s2 = sigm_2((f32x2){v1[0], v1[1]}), s3 = sigm_2((f32x2){v1[2], v1[3]});
                          const f32x4 sa = {s0.x, s0.y, s1.x, s1.y}, sb = {s2.x, s2.y, s3.x, s3.y}; const f32x4 fa = l0 + (1.0f - l0) * sa, fb = l1 + (1.0f - l1) * sb;
#pragma unroll
                          for (int j = 0; j < 4; ++j) { o0[j] = __builtin_amdgcn_logf(fa[j]) * 0.6931471805599453f; o1[j] = __builtin_amdgcn_logf(fb[j]) * 0.6931471805599453f; } }
                        v4u w; w.x = pg8::cvt_pk_bf16(o0[0], o0[1]); w.y = pg8::cvt_pk_bf16(o0[2], o0[3]); w.z = pg8::cvt_pk_bf16(o1[0], o1[1]); w.w = pg8::cvt_pk_bf16(o1[2], o1[3]); *(v4u*)rp = w; } }
            return;
        }
        bf16* dst; int ld = 512, cb, act = 0;
        if (pn < 2) { dst = (bf16*)(ws + WS_QH); cb = pn * 256; act = 1; }
        else if (pn < 6) { dst = (bf16*)(ws + WS_VH); cb = (pn - 4) * 256; }
        else if (pn < 8) { dst = (bf16*)(ws + WS_GH); cb = (pn - 6) * 256; act = 1; }
        else if (pn < 10) { dst = (bf16*)(ws + WS_AQ); cb = (pn - 8) * 256; }
        else if (pn == 10) { dst = (bf16*)(ws + WS_AKV); cb = 0; ld = 256; }
        else if (pn < 15) { dst = (bf16*)(ws + WS_SGH); cb = (pn - 11) * 256; ld = 1024; act = 2; }
        else { dst = (bf16*)(ws + WS_SGA); cb = (pn - 15) * 256; ld = 1024; act = 2; }
#pragma unroll
        for (int ai = 0; ai < 2; ++ai)
#pragma unroll
            for (int m = 0; m < 4; ++m) { bf16* rp = dst + (size_t)(row0 + 128 * ai + 16 * m) * ld + cb + cl;
#pragma unroll
                for (int bj = 0; bj < 2; ++bj) { f32x4 v0 = acc[ai][bj][m][0] * W8_INV, v1 = acc[ai][bj][m][1] * W8_INV;
                    if (act != 0) {
                        const f32x2 a0 = {v0[0], v0[1]}, a1 = {v0[2], v0[3]}, a2 = {v1[0], v1[1]}, a3 = {v1[2], v1[3]};
                        f32x2 s0 = sigm_2(a0), s1 = sigm_2(a1), s2 = sigm_2(a2), s3 = sigm_2(a3);
                        if (act == 1) { s0 = s0 * a0; s1 = s1 * a1; s2 = s2 * a2; s3 = s3 * a3; }
                        v0 = (f32x4){s0.x, s0.y, s1.x, s1.y}; v1 = (f32x4){s2.x, s2.y, s3.x, s3.y}; }
                    v4u w; w.x = pg8::cvt_pk_bf16(v0[0], v0[1]); w.y = pg8::cvt_pk_bf16(v0[2], v0[3]); w.z = pg8::cvt_pk_bf16(v1[0], v1[1]); w.w = pg8::cvt_pk_bf16(v1[2], v1[3]);
                    *(v4u*)(rp + 128 * bj) = w; } }
    }
};
struct PairOrder {
    pg8::StaticOrder S;
    __device__ __forceinline__ bool next(int i, pg8::Unit& u) const { if (!S.next(i >> 1, u)) return false; const int hf = i & 1; u.pn += 8 * hf; u.abase += 512u * (unsigned)hf; u.nvalid = hf ? 0 : 1; return true; }
};
struct EpiMrg {
    static constexpr bool PERM = true, HAS_MID = true; static constexpr int NST = 0; unsigned char* MRG; const bf16* SGH; const bf16* SGA;
    __device__ __forceinline__ void mid(f32x4 (&acc)[2][2][4][2], const pg8::Unit& u, int wr, int wc, int fr, int fq) const {
        const int row0 = u.pm * 256 + wr * 64 + fr, col0 = (u.pn & 3) * 256 + wc * 32 + 8 * fq;
#pragma unroll
        for (int ai = 0; ai < 2; ++ai)
#pragma unroll
            for (int m = 0; m < 4; ++m) { const size_t off = (size_t)(row0 + 128 * ai + 16 * m) * 1024 + col0;
#pragma unroll
                for (int bj = 0; bj < 2; ++bj) { const v4u h = *(const v4u*)(SGH + off + 128 * bj), a = *(const v4u*)(SGA + off + 128 * bj);
                    const f32x4 r0 = {bflo(h.x) * __builtin_amdgcn_rcpf(bflo(a.x)), bfhi(h.x) * __builtin_amdgcn_rcpf(bfhi(a.x)), bflo(h.y) * __builtin_amdgcn_rcpf(bflo(a.y)), bfhi(h.y) * __builtin_amdgcn_rcpf(bfhi(a.y))};
                    const f32x4 r1 = {bflo(h.z) * __builtin_amdgcn_rcpf(bflo(a.z)), bfhi(h.z) * __builtin_amdgcn_rcpf(bfhi(a.z)), bflo(h.w) * __builtin_amdgcn_rcpf(bflo(a.w)), bfhi(h.w) * __builtin_amdgcn_rcpf(bfhi(a.w))};
                    acc[ai][bj][m][0] *= r0; acc[ai][bj][m][1] *= r1; }
                asm volatile("" ::: "memory"); }
    }
    __device__ __forceinline__ void operator()(const f32x4 (&acc)[2][2][4][2], const pg8::Unit& u, int wr, int wc, int fr, int fq) const {
        const int row0 = u.pm * 256 + wr * 64 + fr, col0 = (u.pn & 3) * 256 + wc * 32 + 8 * fq;
#pragma unroll
        for (int ai = 0; ai < 2; ++ai)
#pragma unroll
            for (int m = 0; m < 4; ++m) { const size_t off = (size_t)(row0 + 128 * ai + 16 * m) * 1024 + col0;
#pragma unroll
                for (int bj = 0; bj < 2; ++bj) { const v4u s = *(const v4u*)(SGA + off + 128 * bj); const f32x4 v0 = acc[ai][bj][m][0] * W8_INV, v1 = acc[ai][bj][m][1] * W8_INV;
                    *(unsigned long long*)(MRG + off + 128 * bj) = (unsigned long long)pk4_fp8(bflo(s.x) * v0[0], bfhi(s.x) * v0[1], bflo(s.y) * v0[2], bfhi(s.y) * v0[3]) | ((unsigned long long)pk4_fp8(bflo(s.z) * v1[0], bfhi(s.z) * v1[1], bflo(s.w) * v1[2], bfhi(s.w) * v1[3]) << 32); } }
    }
};
struct EpiOut {
    static constexpr bool PERM = true, HAS_MID = false; static constexpr int NST = 0; const float* x; const float* MOD; bf16* X1B; int skip;
    __device__ __forceinline__ void operator()(const f32x4 (&acc)[2][2][4][2], const pg8::Unit& u, int wr, int wc, int fr, int fq) const {
        if (skip) { if (acc[0][0][0][0][0] == 12345.678f) X1B[0] = 1; return; }
        const int row0 = u.pm * 256 + wr * 64 + fr, col0 = u.pn * 256 + wc * 32 + 8 * fq; const float* g1 = MOD + (size_t)(u.pm >> 3) * 6144 + 2048;
        f32x4 gv[2][2];
#pragma unroll
        for (int bj = 0; bj < 2; ++bj)
#pragma unroll
            for (int n = 0; n < 2; ++n) gv[bj][n] = *(const f32x4*)(g1 + col0 + 128 * bj + 4 * n) * W8_INV;
#pragma unroll
        for (int ai = 0; ai < 2; ++ai)
#pragma unroll
            for (int m = 0; m < 4; ++m) { const size_t off = (size_t)(row0 + 128 * ai + 16 * m) * 1024 + col0;
#pragma unroll
                for (int bj = 0; bj < 2; ++bj) { const f32x4 v0 = __builtin_nontemporal_load((const f32x4*)(x + off + 128 * bj)) + gv[bj][0] * acc[ai][bj][m][0], v1 = __builtin_nontemporal_load((const f32x4*)(x + off + 128 * bj + 4)) + gv[bj][1] * acc[ai][bj][m][1];
                    v4u w; w.x = pg8::cvt_pk_bf16(v0[0], v0[1]); w.y = pg8::cvt_pk_bf16(v0[2], v0[3]); w.z = pg8::cvt_pk_bf16(v1[0], v1[1]); w.w = pg8::cvt_pk_bf16(v1[2], v1[3]);
                    *(v4u*)(X1B + off + 128 * bj) = w; } }
    }
};

typedef float f32x16 __attribute__((ext_vector_type(16)));
constexpr int RT_PITCH = 2064;
constexpr int R_TILE = 0, R_PART = 66048, R_LOG = 99840, R_REC = 104064, R_HIST = 112256;
__device__ __forceinline__ void p6_route(Frame& F, int dry) {
    const float* MOD = (const float*)(F.ws + WS_MOD); unsigned* H2 = (unsigned*)(F.ws + WS_H2);
    int* TOKL = (int*)(F.ws + (dry ? WS_TMP : WS_TOKL)); int* SLOT = (int*)(F.ws + (dry ? WS_TMP + 8 * MiB : WS_GATL)); const int cw = dry ? 8192 : CW_CNT; int* TOPI = (int*)(F.ws + WS_TOPI); float* TOPW = (float*)(F.ws + WS_TOPW);
    LAS float* PART = (LAS float*)(F.lds + R_PART); LAS float* LOG = (LAS float*)(F.lds + R_LOG);
    LAS int* REC_E = (LAS int*)(F.lds + R_REC); LAS int* REC_TK = REC_E + 512; LAS float* REC_G = (LAS float*)(REC_E + 1024); LAS int* REC_RK = REC_E + 1536;
    LAS int* HIST = (LAS int*)(F.lds + R_HIST); LAS int* BASE = HIST + 32;
    const int lane = F.lane, wave = F.wave, r32 = lane & 31, hi = lane >> 5;
    bf16x8 wB[8];
#pragma unroll
    for (int s = 0; s < 8; ++s) { const int k0 = 128 * wave + 16 * s + 8 * hi; unsigned p[4];
#pragma unroll
        for (int j = 0; j < 4; ++j) p[j] = pk2(F.w_r()[(size_t)(k0 + 2 * j) * 32 + r32], F.w_r()[(size_t)(k0 + 2 * j + 1) * 32 + r32]);
        v4u q = {p[0], p[1], p[2], p[3]}; wB[s] = __builtin_bit_cast(bf16x8, q); }
    if (F.tid < 32) HIST[F.tid] = 0;
    __syncthreads();
    const bf16* X1B = (const bf16*)(F.ws + WS_X1B);
    for (int tb = (int)blockIdx.x * 4; tb < T / 32; tb += F.G * 4) {
        const int ntile = (T / 32 - tb) < 4 ? (T / 32 - tb) : 4;
        f32x4 cm[4], ca[4];
        { const float* mb = MOD + (size_t)((tb * 32) / SEQ) * 6144;
#pragma unroll
          for (int j = 0; j < 4; ++j) { const int c = 4 * lane + 256 * j; const f32x4 g = *(const GAS f32x4*)(F.n2g() + c), a = *(const GAS f32x4*)(mb + 4096 + c); cm[j] = g * (1.0f + a); ca[j] = *(const GAS f32x4*)(mb + 3072 + c); } }
        unsigned long long xw[4][4];
#define P6_LOAD(tl_) do { _Pragma("unroll") for (int rr = 0; rr < 4; ++rr) { const GAS unsigned long long* xr = (const GAS unsigned long long*)(X1B + (size_t)((tb + (tl_)) * 32 + 4 * wave + rr) * DM) + lane; \
        _Pragma("unroll") for (int j = 0; j < 4; ++j) xw[rr][j] = xr[64 * j]; } } while (0)
        P6_LOAD(0);
        for (int tl = 0; tl < ntile; ++tl) {
            const int t0 = (tb + tl) * 32;
#pragma unroll
            for (int rr = 0; rr < 4; ++rr) {
                const int row = t0 + 4 * wave + rr;
                f32x4 v[4]; float s = 0.f;
#pragma unroll
                for (int j = 0; j < 4; ++j) { const unsigned xl = (unsigned)xw[rr][j], xh = (unsigned)(xw[rr][j] >> 32); v[j] = (f32x4){bflo(xl), bfhi(xl), bflo(xh), bfhi(xh)}; s += (v[j].x * v[j].x + v[j].y * v[j].y) + (v[j].z * v[j].z + v[j].w * v[j].w); }
                const float rstd = rsqrtf(wave_sum(s) * (1.f / DM) + EPS);
#pragma unroll
                for (int j = 0; j < 4; ++j) {
                    const int c = 4 * lane + 256 * j;
                    const f32x4 hv = v[j] * rstd * cm[j] + ca[j];
                    const unsigned lo = pk2(hv.x, hv.y), hh = pk2(hv.z, hv.w);
                    *(GAS unsigned*)(H2 + (size_t)row * 256 + (c >> 2)) = pk4_fp8(hv.x, hv.y, hv.z, hv.w);
                    *(LAS unsigned long long*)(F.lds + R_TILE + (4 * wave + rr) * RT_PITCH + c * 2) = (unsigned long long)lo | ((unsigned long long)hh << 32);
                }
            }
            if (tl + 1 < ntile) P6_LOAD(tl + 1);
            __syncthreads();
            f32x16 acc = {};
#pragma unroll
            for (int s = 0; s < 8; ++s) { const bf16x8 af = *(const LAS bf16x8*)(F.lds + R_TILE + r32 * RT_PITCH + (128 * wave + 16 * s + 8 * hi) * 2);
                acc = __builtin_amdgcn_mfma_f32_32x32x16_bf16(af, wB[s], acc, 0, 0, 0); }
#pragma unroll
            for (int r = 0; r < 16; ++r) { const int tok = (r & 3) + 8 * (r >> 2) + 4 * hi; PART[(wave * 32 + tok) * 33 + r32] = acc[r]; }
            __syncthreads();
#pragma unroll
            for (int q = 0; q < 2; ++q) { const int idx = F.tid + 512 * q, tok = idx >> 5, e = idx & 31; float s = F.b_r()[e];
#pragma unroll
                for (int w = 0; w < 8; ++w) s += PART[(w * 32 + tok) * 33 + e];
                LOG[tok * 33 + e] = s; }
            __syncthreads();
            if (F.tid < 32) {
                float lg[32];
#pragma unroll
                for (int e = 0; e < 32; ++e) lg[e] = LOG[F.tid * 33 + e];
                unsigned used = 0u; float tv[4]; int ti[4];
#pragma unroll
                for (int k = 0; k < 4; ++k) { float best = -INFINITY; int bi = 0;
#pragma unroll
                    for (int e = 0; e < 32; ++e) { const bool ok = !((used >> e) & 1u) && lg[e] > best; best = ok ? lg[e] : best; bi = ok ? e : bi; }
                    used |= 1u << bi; tv[k] = best; ti[k] = bi; }
                const float e1 = __expf(tv[1] - tv[0]), e2 = __expf(tv[2] - tv[0]), e3 = __expf(tv[3] - tv[0]), inv = 1.f / (1.f + e1 + e2 + e3);
                const float gw[4] = {inv, e1 * inv, e2 * inv, e3 * inv};
                const int t = t0 + F.tid;
#pragma unroll
                for (int k = 0; k < 4; ++k) { const int slot = tl * 128 + F.tid * 4 + k; REC_E[slot] = ti[k]; REC_TK[slot] = t * 4 + k; REC_G[slot] = gw[k];
                    REC_RK[slot] = __hip_atomic_fetch_add(&HIST[ti[k]], 1, __ATOMIC_RELAXED, __HIP_MEMORY_SCOPE_WORKGROUP);
                    TOPI[t * 4 + k] = ti[k]; TOPW[t * 4 + k] = gw[k]; }
            }
        }
        __syncthreads();
        if (F.tid < 32) BASE[F.tid] = (int)__hip_atomic_fetch_add(F.ctl + cw + 64 * F.tid, (unsigned)HIST[F.tid], RLX_AGENT);
        __syncthreads();
        for (int slot = F.tid; slot < ntile * 128; slot += 512) { const int e = REC_E[slot], p = BASE[e] + REC_RK[slot]; const int tk = REC_TK[slot]; TOKL[(size_t)e * T + p] = tk; SLOT[tk] = (e << 16) | p; }
        __syncthreads();
        if (F.tid < 32) HIST[F.tid] = 0;
        __syncthreads();
    }
#undef P6_LOAD
}

__device__ __forceinline__ void moe_tables(Frame& F) {
    if (F.tid < 32) F.MISC[64 + F.tid] = __hip_atomic_load(F.ctl + CW_CNT + 64 * F.tid, RLX_AGENT);
    __syncthreads();
    if (F.tid == 0) { unsigned s = 0; for (int e = 0; e < 32; ++e) { F.MISC[16 + e] = s; s += (F.MISC[64 + e] + 255u) >> 8; } F.MISC[48] = s; }
    __syncthreads();
}
template <int NC> struct MoeOrder {
    volatile LAS unsigned* MISC; int G, c;
    __device__ __forceinline__ bool next(int i, pg8::Unit& u) const {
        const int total = (int)MISC[48]; int rt, pl;
        if ((G & 7) == 0 && ((G >> 3) % NC) == 0) { const int rpr = G / NC, perx = rpr >> 3, xcd = c & 7, s = c >> 3; rt = i * rpr + xcd * perx + s / NC; pl = s % NC; }
        else { const int L = i * G + c; rt = L / NC; pl = L % NC; }
        if (rt >= total) return false;
        int e = 0;
        for (int q = 1; q < 32; ++q) e += ((int)MISC[16 + q] <= rt) ? 1 : 0;
        const int j = rt - (int)MISC[16 + e];
        u.pm = rt; u.pn = e * NC + pl;
        if (NC == 8) { u.arow0 = e * T + 256 * j; u.nvalid = (int)MISC[64 + e] - 256 * j; u.abase = 0u; }
        else { u.arow0 = 0; u.nvalid = 256; u.abase = (unsigned)rt * (256u * 1024u); }
        return true;
    }
};
__device__ __forceinline__ void moe_prefill_tokens(Frame& F, const pg8::CachedOrder& CS, const int* rowidx) {
    LAS unsigned short* TK = (LAS unsigned short*)(F.lds + pg8::STAGE_BYTES);
    const int total = CS.n * 256;
    for (int base = 0; base < total; base += 2048) {
        int v[4]; int nv[4];
#pragma unroll
        for (int q = 0; q < 4; ++q) { const int idx = base + q * 512 + F.tid, i = idx >> 8, r = idx & 255; v[q] = 0; nv[q] = 0;
            if (idx < total) { const int arow0 = CS.tab[8 * i + 2]; nv[q] = CS.tab[8 * i + 3]; v[q] = rowidx[arow0 + r]; } }
#pragma unroll
        for (int q = 0; q < 4; ++q) { const int idx = base + q * 512 + F.tid, i = idx >> 8, r = idx & 255; if (idx < total) TK[i * 256 + pg8::tk_pos(r)] = (unsigned short)((r < nv[q]) ? (v[q] >> 2) : T); }
    }
    __syncthreads();
}
struct EpiUp {
    static constexpr bool PERM = true, HAS_MID = false; static constexpr int NST = 8; unsigned char* ACT; const float* BUPP; int skip;
    __device__ __forceinline__ void operator()(const f32x4 (&acc)[2][2][4][2], const pg8::Unit& u, int wr, int wc, int fr, int fq) const {
        if (skip) { if (acc[0][0][0][0][0] == 12345.678f) ACT[0] = 1; return; }
        const int e = u.pn >> 3, pl = u.pn & 7, row0 = u.pm * 256 + wr * 64 + fr, cl = wc * 32 + 8 * fq;
        const float* bp = BUPP + e * 2048 + 256 * pl + cl;
        const f32x4 bg0 = *(const f32x4*)bp, bg1 = *(const f32x4*)(bp + 4), bl0 = *(const f32x4*)(bp + 128), bl1 = *(const f32x4*)(bp + 132);
#pragma unroll
        for (int ai = 0; ai < 2; ++ai)
#pragma unroll
            for (int m = 0; m < 4; ++m) { unsigned char* rp = ACT + (size_t)(row0 + 128 * ai + 16 * m) * 1024 + 128 * pl + cl;
                const f32x4 g0 = acc[ai][0][m][0] * W8_INV + bg0, g1 = acc[ai][0][m][1] * W8_INV + bg1, l0 = acc[ai][1][m][0] * W8_INV + bl0, l1 = acc[ai][1][m][1] * W8_INV + bl1;
                const f32x2 o0 = swiglu_2((f32x2){g0[0], g0[1]}, (f32x2){l0[0], l0[1]}), o1 = swiglu_2((f32x2){g0[2], g0[3]}, (f32x2){l0[2], l0[3]}),
                            o2 = swiglu_2((f32x2){g1[0], g1[1]}, (f32x2){l1[0], l1[1]}), o3 = swiglu_2((f32x2){g1[2], g1[3]}, (f32x2){l1[2], l1[3]});
                *(unsigned long long*)rp = (unsigned long long)pk4_fp8(o0.x, o0.y, o1.x, o1.y) | ((unsigned long long)pk4_fp8(o2.x, o2.y, o3.x, o3.y) << 32); }
    }
};
constexpr float Y8_SCALE = 8.f, Y8_INV = 0.125f;
struct EpiDn {
    static constexpr bool PERM = true, HAS_MID = false; static constexpr int NST = 16; unsigned char* Y; const float* b_dn;
    __device__ __forceinline__ void operator()(const f32x4 (&acc)[2][2][4][2], const pg8::Unit& u, int wr, int wc, int fr, int fq) const {
        const int e = u.pn >> 2, pl = u.pn & 3, row0 = u.pm * 256 + wr * 64 + fr, cl = wc * 32 + 8 * fq; const float* bp = b_dn + e * 1024 + 256 * pl + cl;
        f32x4 bv[2][2];
#pragma unroll
        for (int bj = 0; bj < 2; ++bj) { bv[bj][0] = *(const f32x4*)(bp + 128 * bj) * Y8_SCALE; bv[bj][1] = *(const f32x4*)(bp + 128 * bj + 4) * Y8_SCALE; }
#pragma unroll
        for (int ai = 0; ai < 2; ++ai)
#pragma unroll
            for (int m = 0; m < 4; ++m) { unsigned char* rp = Y + (size_t)(row0 + 128 * ai + 16 * m) * 1024 + 256 * pl + cl;
#pragma unroll
                for (int bj = 0; bj < 2; ++bj) { const f32x4 v0 = acc[ai][bj][m][0] * (W8_INV * Y8_SCALE) + bv[bj][0], v1 = acc[ai][bj][m][1] * (W8_INV * Y8_SCALE) + bv[bj][1];
                    *(unsigned long long*)(rp + 128 * bj) = (unsigned long long)pk4_fp8(v0[0], v0[1], v0[2], v0[3]) | ((unsigned long long)pk4_fp8(v1[0], v1[1], v1[2], v1[3]) << 32); } }
    }
};
__device__ __forceinline__ void p9_final(Frame& F) {
    moe_tables(F);
    const int gw = (int)blockIdx.x * NWAVES + F.wave, NGW = F.G * NWAVES; const float* MOD = (const float*)(F.ws + WS_MOD); const unsigned char* Y = F.ws + WS_Y;
    const int* SLOT = (const int*)(F.ws + WS_GATL); const float* TOPW = (const float*)(F.ws + WS_TOPW); const bf16* X1B = (const bf16*)(F.ws + WS_X1B);
    for (int row = gw; row < T; row += NGW) {
        const float* g2 = MOD + (size_t)(row / SEQ) * 6144 + 5120;
        const v4u sl = *(const GAS v4u*)(SLOT + row * 4); const f32x4 gt = *(const GAS f32x4*)(TOPW + row * 4);
        const unsigned slv[4] = {sl.x, sl.y, sl.z, sl.w}; const float gtv[4] = {gt.x * Y8_INV, gt.y * Y8_INV, gt.z * Y8_INV, gt.w * Y8_INV}; const unsigned char* yr[4];
#pragma unroll
        for (int k = 0; k < 4; ++k) yr[k] = Y + ((size_t)F.MISC[16 + (slv[k] >> 16)] * 256 + (slv[k] & 0xffffu)) * DM;
#pragma unroll
        for (int j = 0; j < 4; ++j) {
            const int c = 4 * F.lane + 256 * j;
            const unsigned long long xw = *(const GAS unsigned long long*)(X1B + (size_t)row * DM + c); const unsigned xl = (unsigned)xw, xh = (unsigned)(xw >> 32);
            const f32x4 g = *(const GAS f32x4*)(g2 + c);
            float s0 = 0.f, s1 = 0.f, s2 = 0.f, s3 = 0.f;
#pragma unroll
            for (int k = 0; k < 4; ++k) { const unsigned y = *(const GAS unsigned*)(yr[k] + c);
                s0 += gtv[k] * __builtin_amdgcn_cvt_f32_fp8(y, 0); s1 += gtv[k] * __builtin_amdgcn_cvt_f32_fp8(y, 1); s2 += gtv[k] * __builtin_amdgcn_cvt_f32_fp8(y, 2); s3 += gtv[k] * __builtin_amdgcn_cvt_f32_fp8(y, 3); }
            f32x4 ov_ = {bflo(xl) + g.x * s0, bfhi(xl) + g.y * s1, bflo(xh) + g.z * s2, bfhi(xh) + g.w * s3};
#ifdef DBG_STAT
            { const unsigned long long* dbg = (const unsigned long long*)(F.ws + WS_TMP); const float us = (DBG_STAT == 4) ? (float)dbg[3] : 8.f * floorf(((float)dbg[DBG_STAT] * 0.01f + DBG_OFS) * 0.125f); ov_ = ov_ + sqrtf(us) * 0.03125f; }
#endif
            *(GAS f32x4*)(F.out + (size_t)row * DM + c) = ov_;
        }
    }
}
typedef short v4i16_t __attribute__((ext_vector_type(4)));
namespace att {
constexpr int L_K = 0, L_V = 32768, L_OST = 65536, L_WSF = 98304;
constexpr float SC2 = 0.125f * 1.4426950408889634f;
__device__ __forceinline__ int crow(int r, int hi) { return (r & 3) + 8 * (r >> 2) + 4 * hi; }
__device__ __forceinline__ bf16x8 vtr2(LAS const unsigned char* p) {
    const v4i16_t lo = __builtin_amdgcn_ds_read_tr16_b64_v4i16((LAS v4i16_t*)p), hi = __builtin_amdgcn_ds_read_tr16_b64_v4i16((LAS v4i16_t*)(p + 512));
    return (bf16x8){lo[0], lo[1], lo[2], lo[3], hi[0], hi[1], hi[2], hi[3]};
}
__device__ __forceinline__ void unit(Frame& F, int b, int kvh, int qb) {
    const bf16* AQ = (const bf16*)(F.ws + WS_AQ); const bf16* AKV = (const bf16*)(F.ws + WS_AKV); unsigned char* HOAO = F.ws + WS_HOAO;
    const int tid = F.tid, lane = F.lane, wave = F.wave, r32 = lane & 31, hi = lane >> 5;
    const int tq0 = b * SEQ + qb * 128, tk0 = tq0 - 128;
    {
        const int key = tid >> 1, half = tid & 1; const bool valid = (qb > 0) || (key >= 128); const int token = valid ? tk0 + key : tq0;
        const bf16* kp = AKV + (size_t)token * 256 + kvh * 64 + half * 32;
        v4u kr[4], vr[4];
#pragma unroll
        for (int q = 0; q < 4; ++q) { kr[q] = *(const GAS v4u*)(kp + 8 * q); vr[q] = *(const GAS v4u*)(kp + 128 + 8 * q); }
        float x[32]; float ss = 0.f;
#pragma unroll
        for (int q = 0; q < 4; ++q) { x[8 * q + 0] = bflo(kr[q].x); x[8 * q + 1] = bfhi(kr[q].x); x[8 * q + 2] = bflo(kr[q].y); x[8 * q + 3] = bfhi(kr[q].y);
            x[8 * q + 4] = bflo(kr[q].z); x[8 * q + 5] = bfhi(kr[q].z); x[8 * q + 6] = bflo(kr[q].w); x[8 * q + 7] = bfhi(kr[q].w); }
#pragma unroll
        for (int d = 0; d < 32; ++d) ss += x[d] * x[d];
        ss += __shfl_xor(ss, 1);
        const float rstd = valid ? rsqrtf(ss * (1.f / 64.f) + EPS) : 0.f;
#pragma unroll
        for (int q = 0; q < 8; ++q) { const f32x4 g = *(const GAS f32x4*)(F.kg() + half * 32 + 4 * q); x[4 * q] *= rstd * g.x; x[4 * q + 1] *= rstd * g.y; x[4 * q + 2] *= rstd * g.z; x[4 * q + 3] *= rstd * g.w; }
        if (half == 0) { const int p = F.pos()[token];
#pragma unroll
            for (int i = 0; i < 8; ++i) { float cs, sn; rope_cs(p, i, cs, sn); const float x1 = x[i], x2 = x[i + 8]; x[i] = x1 * cs - x2 * sn; x[i + 8] = x2 * cs + x1 * sn; } }
#pragma unroll
        for (int q = 0; q < 4; ++q) { v4u w; w.x = pk2(x[8 * q], x[8 * q + 1]); w.y = pk2(x[8 * q + 2], x[8 * q + 3]); w.z = pk2(x[8 * q + 4], x[8 * q + 5]); w.w = pk2(x[8 * q + 6], x[8 * q + 7]);
            *(LAS v4u*)(F.lds + L_K + (half * 4 + q) * 4096 + key * 16) = w; }
        const int kk = key & 63; LAS unsigned char* vd = F.lds + L_V + (key >> 6) * 8192 + half * 4096 + (kk >> 4) * 1024 + (kk & 15) * 64;
#pragma unroll
        for (int q = 0; q < 4; ++q) { v4u w = vr[q]; if (!valid) w = (v4u){0u, 0u, 0u, 0u}; *(LAS v4u*)(vd + 16 * q) = w; }
    }
    __syncthreads();
    LAS float* wsf = (LAS float*)(F.lds + L_WSF) + wave * 64;
    LAS unsigned char* stg = F.lds + L_OST + wave * 4096;
    LAS const unsigned char* vbase = F.lds + L_V + ((lane >> 4) & 1) * 32 + (lane & 3) * 8 + (4 * hi + ((lane & 15) >> 2)) * 64;
#pragma unroll 1
    for (int sbi = 0; sbi < 2; ++sbi) {
        const int sb = wave * 2 + sbi, g = sb >> 2, r0 = (sb & 3) * 32, hq = kvh * 4 + g, tq = tq0 + r0 + r32;
        bf16x8 qr[4];
        {
            const bf16* qp = AQ + (size_t)tq * 512 + hq * 64 + 8 * hi; float x[4][8]; float ss = 0.f;
#pragma unroll
            for (int d0 = 0; d0 < 4; ++d0) { const v4u r = *(const GAS v4u*)(qp + 16 * d0); x[d0][0] = bflo(r.x); x[d0][1] = bfhi(r.x); x[d0][2] = bflo(r.y); x[d0][3] = bfhi(r.y); x[d0][4] = bflo(r.z); x[d0][5] = bfhi(r.z); x[d0][6] = bflo(r.w); x[d0][7] = bfhi(r.w); }
#pragma unroll
            for (int d0 = 0; d0 < 4; ++d0)
#pragma unroll
                for (int j = 0; j < 8; ++j) ss += x[d0][j] * x[d0][j];
            ss += __shfl_xor(ss, 32);
            const float rs = rsqrtf(ss * (1.f / 64.f) + EPS) * SC2;
#pragma unroll
            for (int d0 = 0; d0 < 4; ++d0) { const f32x4 g0 = *(const GAS f32x4*)(F.qg() + 16 * d0 + 8 * hi), g1 = *(const GAS f32x4*)(F.qg() + 16 * d0 + 8 * hi + 4);
                x[d0][0] *= rs * g0.x; x[d0][1] *= rs * g0.y; x[d0][2] *= rs * g0.z; x[d0][3] *= rs * g0.w; x[d0][4] *= rs * g1.x; x[d0][5] *= rs * g1.y; x[d0][6] *= rs * g1.z; x[d0][7] *= rs * g1.w; }
            const int p = F.pos()[tq];
#pragma unroll
            for (int j = 0; j < 8; ++j) { float cs, sn; rope_cs(p, j, cs, sn); const float mine = x[0][j], oth = __shfl_xor(mine, 32); x[0][j] = mine * cs + (hi ? oth : -oth) * sn; }
#pragma unroll
            for (int d0 = 0; d0 < 4; ++d0) { v4u w; w.x = pk2(x[d0][0], x[d0][1]); w.y = pk2(x[d0][2], x[d0][3]); w.z = pk2(x[d0][4], x[d0][5]); w.w = pk2(x[d0][6], x[d0][7]); qr[d0] = __builtin_bit_cast(bf16x8, w); }
        }
        const int kt0 = r0 >> 5, qi = r0 + r32;
        f32x16 p[5];
#pragma unroll
        for (int t = 0; t < 5; ++t) {
            f32x16 a = {};
#pragma unroll
            for (int d0 = 0; d0 < 4; ++d0) { const bf16x8 kf = *(const LAS bf16x8*)(F.lds + L_K + (2 * d0 + hi) * 4096 + (32 * (kt0 + t) + r32) * 16); a = __builtin_amdgcn_mfma_f32_32x32x16_bf16(kf, qr[d0], a, 0, 0, 0); }
            if (t == 0) {
#pragma unroll
                for (int r = 0; r < 16; ++r) a[r] = (crow(r, hi) > r32) ? a[r] : -INFINITY; }
            if (t == 4) {
#pragma unroll
                for (int r = 0; r < 16; ++r) a[r] = (crow(r, hi) <= r32) ? a[r] : -INFINITY; }
            if (qb == 0 && kt0 + t < 4) {
#pragma unroll
                for (int r = 0; r < 16; ++r) a[r] = -INFINITY; }
            p[t] = a;
        }
        const float sink2 = F.sinks()[hq] * 1.4426950408889634f;
        float m = sink2;
#pragma unroll
        for (int t = 0; t < 5; ++t)
#pragma unroll
            for (int r = 0; r < 16; ++r) m = fmaxf(m, p[t][r]);
        m = fmaxf(m, __shfl_xor(m, 32));
        float l = 0.f;
#pragma unroll
        for (int t = 0; t < 5; ++t)
#pragma unroll
            for (int r = 0; r < 16; ++r) { const float e = __builtin_amdgcn_exp2f(p[t][r] - m); p[t][r] = e; l += e; }
        l += __shfl_xor(l, 32);
        l += __builtin_amdgcn_exp2f(sink2 - m);
        f32x16 o[2]; o[0] = (f32x16){}; o[1] = (f32x16){};
#pragma unroll
        for (int t = 0; t < 5; ++t) {
            const int kt = kt0 + t; LAS const unsigned char* vs = vbase + (kt >> 1) * 8192 + (2 * (kt & 1)) * 1024;
#pragma unroll
            for (int s = 0; s < 2; ++s) {
                v4u w; w.x = pk2(p[t][8 * s], p[t][8 * s + 1]); w.y = pk2(p[t][8 * s + 2], p[t][8 * s + 3]); w.z = pk2(p[t][8 * s + 4], p[t][8 * s + 5]); w.w = pk2(p[t][8 * s + 6], p[t][8 * s + 7]);
                const bf16x8 pa = __builtin_bit_cast(bf16x8, w);
#pragma unroll
                for (int d0 = 0; d0 < 2; ++d0) { const bf16x8 vf = vtr2(vs + d0 * 4096 + s * 1024); o[d0] = __builtin_amdgcn_mfma_f32_32x32x16_bf16(pa, vf, o[d0], 0, 0, 0); }
            }
        }
        if (hi == 0) wsf[r32] = l;
        LDS_WAIT(); asm volatile("" ::: "memory");
#pragma unroll
        for (int r = 0; r < 16; ++r) { const int orow = crow(r, hi); const float rl = __builtin_amdgcn_rcpf(wsf[orow]);
#pragma unroll
            for (int d0 = 0; d0 < 2; ++d0) { const float ov = o[d0][r] * rl; stg[orow * 64 + d0 * 32 + r32] = (unsigned char)(__builtin_amdgcn_cvt_pk_fp8_f32(ov, ov, 0, false) & 0xff); } }
        LDS_WAIT(); asm volatile("" ::: "memory");
#pragma unroll
        for (int i = 0; i < 2; ++i) { const int row = i * 16 + (lane >> 2), ch = lane & 3; const v4u v = *(const LAS v4u*)(stg + row * 64 + ch * 16);
            *(GAS v4u*)(HOAO + (size_t)(tq0 + r0 + row) * 1024 + 512 + hq * 64 + ch * 16) = v; }
        LDS_WAIT(); asm volatile("" ::: "memory");
    }
    __syncthreads();
}
}

namespace hg {
typedef float f32x2v __attribute__((ext_vector_type(2)));
constexpr int PK = 272, PJ = 144;
constexpr int L_QE = 0, L_KE = 17408, L_KDT = 34816, L_VT = 53248, L_P = 71680, L_ST = 80896, L_OST = 115712, L_SEGP = 149504, L_DK = 153600;
constexpr int OP = 132;
__device__ __forceinline__ void run(Frame& F, int b, int h) {
    const bf16* QH = (const bf16*)(F.ws + WS_QH); const bf16* LF = (const bf16*)(F.ws + WS_LF); const bf16* VH = (const bf16*)(F.ws + WS_VH); const bf16* GH = (const bf16*)(F.ws + WS_GH);
    unsigned char* HOAO = F.ws + WS_HOAO;
    const int tid = F.tid, lane = F.lane, wave = F.wave, r32 = lane & 31, hi = lane >> 5;
    LAS unsigned char* L = F.lds;
    LAS float* SEGP = (LAS float*)(L + L_SEGP); LAS float* DK = (LAS float*)(L + L_DK); LAS float* OST = (LAS float*)(L + L_OST);
    for (int i = tid; i < (L_OST - L_P) / 16; i += 512) *(LAS v4u*)(L + L_P + i * 16) = (v4u){0u, 0u, 0u, 0u};
    f32x16 st[2]; st[0] = (f32x16){}; st[1] = (f32x16){};
    const int kp2 = 2 * lane;
    const size_t rowb = (size_t)b * SEQ;
    float fv[8][2]; unsigned qv[8], vv[8];
    unsigned lr[8], qr_[8], vr_[8];
    const int oi = tid >> 3, os = tid & 7;
    float gn[16];
#pragma unroll
    for (int q = 0; q < 4; ++q) { const f32x4 g = *(const GAS f32x4*)(F.hgg() + 16 * os + 4 * q); gn[4 * q] = g.x; gn[4 * q + 1] = g.y; gn[4 * q + 2] = g.z; gn[4 * q + 3] = g.w; }
#define HG_LOAD(c) do { _Pragma("unroll") for (int jj = 0; jj < 8; ++jj) { const size_t row = rowb + (size_t)(c) * 64 + 8 * wave + jj; \
        lr[jj] = *(const GAS unsigned*)(LF + row * 512 + h * 128 + kp2); \
        qr_[jj] = *(const GAS unsigned*)(QH + row * 512 + h * 128 + kp2); vr_[jj] = *(const GAS unsigned*)(VH + row * 512 + h * 128 + kp2); } } while (0)
#define HG_A1() do { float p0 = 1.f, p1 = 1.f; _Pragma("unroll") for (int jj = 0; jj < 8; ++jj) { fv[jj][0] = __expf(bflo(lr[jj])); fv[jj][1] = __expf(bfhi(lr[jj])); p0 *= fv[jj][0]; p1 *= fv[jj][1]; qv[jj] = qr_[jj]; vv[jj] = vr_[jj]; } \
        *(LAS f32x2v*)(SEGP + wave * 128 + kp2) = (f32x2v){p0, p1}; } while (0)
    HG_LOAD(0); HG_A1(); HG_LOAD(1);
    __syncthreads();
#ifdef DBG_HG
    unsigned long long hs[4] = {0, 0, 0, 0}, ht = __builtin_amdgcn_s_memrealtime();
#define HG_STAMP(k) do { const unsigned long long n_ = __builtin_amdgcn_s_memrealtime(); hs[k] += n_ - ht; ht = n_; } while (0)
#else
#define HG_STAMP(k) do {} while (0)
#endif
#pragma unroll 1
    for (int c = 0; c < SEQ / 64; ++c) {
        {
            float pre0 = 1.f, pre1 = 1.f, all0 = 1.f, all1 = 1.f;
#pragma unroll
            for (int s = 0; s < 8; ++s) { const f32x2v sp = *(const LAS f32x2v*)(SEGP + s * 128 + kp2); all0 *= sp.x; all1 *= sp.y; if (s < wave) { pre0 *= sp.x; pre1 *= sp.y; } }
            if (wave == 0) *(LAS f32x2v*)(DK + kp2) = (f32x2v){all0, all1};
            f32x2 e2 = {pre0, pre1}; const f32x2 all2 = {all0, all1}; unsigned kd0[4], kd1[4], vt0[4], vt1[4]; f32x2 dprev = {0.f, 0.f};
#pragma unroll
            for (int jj = 0; jj < 8; ++jj) {
                const f32x2 f2 = {fv[jj][0], fv[jj][1]};
                e2 = e2 * f2;
                const f32x2 ke2 = (1.0f - f2) * rcp_2(e2), qe2 = (f32x2){bflo(qv[jj]), bfhi(qv[jj])} * e2, d2 = ke2 * all2;
                const int j = 8 * wave + jj;
                *(LAS unsigned*)(L + L_QE + j * PK + kp2 * 2) = pk2(qe2.x, qe2.y);
                *(LAS unsigned*)(L + L_KE + j * PK + kp2 * 2) = pk2(ke2.x, ke2.y);
                if (jj & 1) { kd0[jj >> 1] = pk2(dprev.x, d2.x); kd1[jj >> 1] = pk2(dprev.y, d2.y); vt0[jj >> 1] = (vv[jj - 1] & 0xffffu) | (vv[jj] << 16); vt1[jj >> 1] = (vv[jj - 1] >> 16) | (vv[jj] & 0xffff0000u); }
                else dprev = d2;
            }
            *(LAS v4u*)(L + L_KDT + kp2 * PJ + 16 * wave) = (v4u){kd0[0], kd0[1], kd0[2], kd0[3]};
            *(LAS v4u*)(L + L_KDT + (kp2 + 1) * PJ + 16 * wave) = (v4u){kd1[0], kd1[1], kd1[2], kd1[3]};
            *(LAS v4u*)(L + L_VT + kp2 * PJ + 16 * wave) = (v4u){vt0[0], vt0[1], vt0[2], vt0[3]};
            *(LAS v4u*)(L + L_VT + (kp2 + 1) * PJ + 16 * wave) = (v4u){vt1[0], vt1[1], vt1[2], vt1[3]};
        }
        const size_t orow = rowb + (size_t)c * 64 + oi;
        const v4u gg0 = *(const GAS v4u*)(GH + orow * 512 + h * 128 + 16 * os), gg1 = *(const GAS v4u*)(GH + orow * 512 + h * 128 + 16 * os + 8);
        __syncthreads();
        HG_STAMP(0);
        for (int tl = wave; tl < 10; tl += 8) {
            const int ib = (tl >= 1) + (tl >= 3) + (tl >= 6), jb = tl - ((ib * (ib + 1)) >> 1);
            typedef float f32x4v __attribute__((ext_vector_type(4)));
            f32x4v a = {0.f, 0.f, 0.f, 0.f}; const int l15 = lane & 15, l4 = lane >> 4;
#pragma unroll
            for (int s = 0; s < 4; ++s) { const bf16x8 af = *(const LAS bf16x8*)(L + L_QE + (16 * ib + l15) * PK + (32 * s + 8 * l4) * 2), bfr = *(const LAS bf16x8*)(L + L_KE + (16 * jb + l15) * PK + (32 * s + 8 * l4) * 2);
                a = __builtin_amdgcn_mfma_f32_16x16x32_bf16(af, bfr, a, 0, 0, 0); }
#pragma unroll
            for (int r = 0; r < 4; ++r) { const int i = 16 * ib + 4 * l4 + r, j = 16 * jb + l15; const float v = (j <= i) ? a[r] : 0.f; *(LAS bf16*)(L + L_P + i * PJ + j * 2) = f2bf(v); }
        }
        const int ib = wave >> 2, vb = wave & 3;
        f32x16 o = {};
#pragma unroll
        for (int s = 0; s < 8; ++s) { const bf16x8 af = *(const LAS bf16x8*)(L + L_QE + (32 * ib + r32) * PK + (16 * s + 8 * hi) * 2), bfr = *(const LAS bf16x8*)(L + L_ST + (32 * vb + r32) * PK + (16 * s + 8 * hi) * 2);
            o = __builtin_amdgcn_mfma_f32_32x32x16_bf16(af, bfr, o, 0, 0, 0); }
#pragma unroll
        for (int q = 0; q < 2; ++q) { const int kb = 2 * (wave >> 2) + q; const float dk = DK[32 * kb + r32];
#pragma unroll
            for (int r = 0; r < 16; ++r) st[q][r] *= dk;
#pragma unroll
            for (int s = 0; s < 4; ++s) { const bf16x8 af = *(const LAS bf16x8*)(L + L_VT + (32 * vb + r32) * PJ + (16 * s + 8 * hi) * 2), bfr = *(const LAS bf16x8*)(L + L_KDT + (32 * kb + r32) * PJ + (16 * s + 8 * hi) * 2);
                st[q] = __builtin_amdgcn_mfma_f32_32x32x16_bf16(af, bfr, st[q], 0, 0, 0); } }
        HG_A1(); { const int cn = (c + 2 < SEQ / 64) ? c + 2 : SEQ / 64 - 1; HG_LOAD(cn); }
        __syncthreads();
        HG_STAMP(1);
#pragma unroll
        for (int s = 0; s < 4; ++s) { const bf16x8 af = *(const LAS bf16x8*)(L + L_P + (32 * ib + r32) * PJ + (16 * s + 8 * hi) * 2), bfr = *(const LAS bf16x8*)(L + L_VT + (32 * vb + r32) * PJ + (16 * s + 8 * hi) * 2);
            o = __builtin_amdgcn_mfma_f32_32x32x16_bf16(af, bfr, o, 0, 0, 0); }
#pragma unroll
        for (int r = 0; r < 16; ++r) OST[(32 * ib + att::crow(r, hi)) * OP + 32 * vb + r32] = o[r];
#pragma unroll
        for (int q = 0; q < 2; ++q) { const int kb = 2 * (wave >> 2) + q;
#pragma unroll
            for (int r = 0; r < 16; ++r) *(LAS bf16*)(L + L_ST + (32 * vb + att::crow(r, hi)) * PK + (32 * kb + r32) * 2) = f2bf(st[q][r]); }
        __syncthreads();
        HG_STAMP(2);
        {
            float ov[16]; float ss = 0.f;
#pragma unroll
            for (int q = 0; q < 4; ++q) { const f32x4 t = *(const LAS f32x4*)(OST + oi * OP + 16 * os + 4 * q); ov[4 * q] = t.x; ov[4 * q + 1] = t.y; ov[4 * q + 2] = t.z; ov[4 * q + 3] = t.w; ss += (t.x * t.x + t.y * t.y) + (t.z * t.z + t.w * t.w); }
            ss += __shfl_xor(ss, 1); ss += __shfl_xor(ss, 2); ss += __shfl_xor(ss, 4);
            const float rstd = rsqrtf(ss * (1.f / 128.f) + EPS);
            const unsigned gw[8] = {gg0.x, gg0.y, gg0.z, gg0.w, gg1.x, gg1.y, gg1.z, gg1.w}; float of[16];
#pragma unroll
            for (int q = 0; q < 8; ++q) { of[2 * q] = ov[2 * q] * rstd * gn[2 * q] * bflo(gw[q]); of[2 * q + 1] = ov[2 * q + 1] * rstd * gn[2 * q + 1] * bfhi(gw[q]); }
            *(GAS v4u*)(HOAO + orow * 1024 + h * 128 + 16 * os) = (v4u){pk4_fp8(of[0], of[1], of[2], of[3]), pk4_fp8(of[4], of[5], of[6], of[7]), pk4_fp8(of[8], of[9], of[10], of[11]), pk4_fp8(of[12], of[13], of[14], of[15])};
        }
        HG_STAMP(3);
    }
#ifdef DBG_HG
    if (blockIdx.x == 0 && tid == 0) { unsigned long long* dbg = (unsigned long long*)(F.ws + WS_TMP); dbg[0] = hs[0]; dbg[1] = hs[1]; dbg[2] = hs[2]; dbg[3] = hs[3]; }
#endif
#undef HG_STAMP
#undef HG_LOAD
#undef HG_A1
    __syncthreads();
}
}
__device__ __forceinline__ void p3_mixers(Frame& F, int sub) {
    constexpr int NHG = 64;
    if ((int)blockIdx.x < NHG) { if (sub & 1) { for (int u = blockIdx.x; u < BATCH * 4; u += NHG) hg::run(F, u >> 2, u & 3); } }
    else { const int na = F.G - NHG; if (sub & 2) { for (int u = (int)blockIdx.x - NHG; u < BATCH * 2 * 16; u += na) att::unit(F, u >> 5, (u >> 4) & 1, u & 15); }
        if (sub & 4) moe_weight_copies(F, ((int)blockIdx.x - NHG) * NWAVES + F.wave, na * NWAVES); }
}

struct Args { const void* in[22]; float* out; unsigned char* ws; int ph_lo, ph_hi, one, sub; };
__global__ void __launch_bounds__(NWAVES * 64, 2) skel_fwd(Args args) {
    extern __shared__ __attribute__((aligned(16))) unsigned char lds[];
    Frame F;
    F.lds = (LAS unsigned char*)lds; F.MISC = (volatile LAS unsigned*)(F.lds + MISC_OFF);
    F.tid = threadIdx.x; F.lane = F.tid & 63; F.wave = __builtin_amdgcn_readfirstlane(F.tid >> 6); F.G = gridDim.x;
    F.out = args.out; F.ws = args.ws; F.ctl = (gu32*)(args.ws + WS_CTL);
    for (int u = F.tid; u < (LDS_BYTES - LDSCTL_OFF) / 4; u += NWAVES * 64) ((LAS unsigned*)(F.lds + LDSCTL_OFF))[u] = 0u;
    __syncthreads();
    XcdBarrier bar; bar.bar = (unsigned*)(F.ctl + CW_BAR); bar.x = 0; bar.st = nullptr;
    if (args.one) bar = xcd_barrier_post((unsigned*)(F.ctl + CW_BAR), F.MISC + 8);
    const int lo = args.ph_lo, hi = args.ph_hi;
#define IN(k) (lo <= (k) && (k) < hi)
#ifndef PROBE_MASK
#define PROBE_MASK 0
#endif
#define REP(k) for (int rep_ = 0; rep_ < (((PROBE_MASK >> (k)) & 1) ? 2 : 1); ++rep_)
#define RSEAM() do { if (rep_ == 0 && ((PROBE_MASK) != 0)) { if (args.one) xcd_barrier(bar); } } while (0)
#define SEAM(k) do { if (IN(k) && IN((k) + 1)) xcd_barrier(bar); } while (0)
    unsigned char* ws = args.ws;
    if (IN(0)) { REP(0) { p0_prologue(F); if ((PROBE_MASK >> 0) & 1) RSEAM(); } SEAM(0); }
    if (IN(1)) { REP(1) { dense_weight_copies(F); p1_xn(F); if ((PROBE_MASK >> 1) & 1) RSEAM(); } SEAM(1); }
    if (IN(2)) REP(2) {
        pg8::Gemm g{(const bf16*)(ws + WS_XN), (const bf16*)(ws + WS_WIN), T, INW, 1024, nullptr, 0, 1024}; pg8::StaticOrder S; S.init(T, INW, F.G, (int)blockIdx.x); S.abase_per_pm = 256u * 1024u;
        { LAS unsigned short* TK = (LAS unsigned short*)(F.lds + pg8::STAGE_BYTES); for (int i = F.tid; i < pg8::MAXU * 256; i += 512) TK[(i & ~255) + pg8::tk_pos(i & 255)] = (unsigned short)(i & 255); __syncthreads(); }
        pg8::CachedOrder CS; CS.build(F.lds, S);
        EpiIn E{ws}; pg8::gemm_phase<EpiIn, pg8::CachedOrder, true, 1, 1>(F.lds, g, CS, E); if ((PROBE_MASK >> 2) & 1) RSEAM();
    }
    SEAM(2);
    if (IN(3)) { REP(3) { p3_mixers(F, args.sub); if ((PROBE_MASK >> 3) & 1) RSEAM(); }
#ifdef DBG_HG
        xcd_barrier(bar); p3_mixers(F, 1);
#endif
        SEAM(3); }
    if (IN(4)) REP(4) {
        PairOrder PS; PS.S.init(T, 1024, F.G, (int)blockIdx.x); PS.S.abase_per_pm = 256u * 1024u; pg8::CachedOrder CS; CS.build(F.lds, PS);
        { LAS unsigned short* TK = (LAS unsigned short*)(F.lds + pg8::STAGE_BYTES); for (int i = F.tid; i < pg8::MAXU * 256; i += 512) TK[(i & ~255) + pg8::tk_pos(i & 255)] = (unsigned short)(i & 255); __syncthreads(); }
        { pg8::Gemm g{(const bf16*)(ws + WS_HOAO), (const bf16*)(ws + WS_WHG), T, 1024, 512, nullptr, 0, 1024}; EpiMrg E{ws + WS_MRG, (const bf16*)(ws + WS_SGH), (const bf16*)(ws + WS_SGA)};
          pg8::gemm_phase<EpiMrg, pg8::CachedOrder, true, 1, 1>(F.lds, g, CS, E); }
        if ((PROBE_MASK >> 4) & 1) RSEAM();
    }
    SEAM(4);
    if (IN(5)) REP(5) {
        pg8::Gemm g{(const bf16*)(ws + WS_MRG), (const bf16*)(ws + WS_WOUT), T, 1024, 1024, nullptr, 0, 1024}; pg8::StaticOrder S; S.init(T, 1024, F.G, (int)blockIdx.x); S.abase_per_pm = 256u * 1024u;
        { LAS unsigned short* TK = (LAS unsigned short*)(F.lds + pg8::STAGE_BYTES); for (int i = F.tid; i < pg8::MAXU * 256; i += 512) TK[(i & ~255) + pg8::tk_pos(i & 255)] = (unsigned short)(i & 255); __syncthreads(); }
        EpiOut E{F.x(), (const float*)(ws + WS_MOD), (bf16*)(ws + WS_X1B), (args.sub >> 3) & 1}; pg8::CachedOrder CS; CS.build(F.lds, S); pg8::gemm_phase<EpiOut, pg8::CachedOrder, true, 1, 1>(F.lds, g, CS, E); if ((PROBE_MASK >> 5) & 1) RSEAM();
    }
    SEAM(5);
    if (IN(6)) { p6_route(F, (args.sub >> 4) & 1); SEAM(6); }
    if (IN(7)) REP(7) {
        moe_tables(F);
        pg8::Gemm g{(const bf16*)(ws + WS_H2), (const bf16*)(ws + WS_WUP), T, NEXP * 2048, 1024, (const int*)(ws + WS_TOKL), T, 1024}; MoeOrder<8> S{F.MISC, F.G, (int)blockIdx.x};
        pg8::CachedOrder CS; CS.build(F.lds, S);
        moe_prefill_tokens(F, CS, (const int*)(ws + WS_TOKL));
        EpiUp E{ws + WS_ACT, (const float*)(ws + WS_BUPP), (args.sub >> 3) & 1};
#if DEV_ORACLE
        if ((args.sub >> 5) & 1) pg8::gemm_phase<EpiUp, pg8::CachedOrder, true, 1, 1, 1>(F.lds, g, CS, E); else if ((args.sub >> 6) & 1) pg8::gemm_phase<EpiUp, pg8::CachedOrder, true, 1, 1, 2>(F.lds, g, CS, E); else
#endif
#if defined(DBG_STAT) && !defined(DBG_HG)
        pg8::gemm_phase<EpiUp, pg8::CachedOrder, true, 1, 1, 0, DBG_BLOCK + 1>(F.lds, g, CS, E, (unsigned long long*)(ws + WS_TMP));
#else
        pg8::gemm_phase<EpiUp, pg8::CachedOrder, true, 1, 1>(F.lds, g, CS, E);
#endif
        if ((PROBE_MASK >> 7) & 1) RSEAM();
    }
    SEAM(7);
    if (IN(8)) REP(8) {
        moe_tables(F);
        pg8::Gemm g{(const bf16*)(ws + WS_ACT), (const bf16*)(ws + WS_WDN), T, NEXP * 1024, 1024, (const int*)(ws + WS_IDT), 0, 1024}; MoeOrder<4> S{F.MISC, F.G, (int)blockIdx.x};
        { LAS unsigned short* TK = (LAS unsigned short*)(F.lds + pg8::STAGE_BYTES); for (int i = F.tid; i < pg8::MAXU * 256; i += 512) TK[(i & ~255) + pg8::tk_pos(i & 255)] = (unsigned short)(i & 255); __syncthreads(); }
        EpiDn E{ws + WS_Y, F.b_dn()}; pg8::CachedOrder CS; CS.build(F.lds, S); pg8::gemm_phase<EpiDn, pg8::CachedOrder, true, 1, 1>(F.lds, g, CS, E); if ((PROBE_MASK >> 8) & 1) RSEAM();
    }
    SEAM(8);
    if (IN(9)) { p9_final(F); }
#undef IN
#undef SEAM
}

#ifndef DEV_MASK
#define DEV_MASK 0x3ff
#ifndef DEV_SUB
#define DEV_SUB 7
#endif
#endif

#if DEV_ORACLE
template <int KIND> __global__ void __launch_bounds__(512, 2) mfma_bench(float* sink, int iters) {
    typedef int v8i __attribute__((ext_vector_type(8))); typedef short s8 __attribute__((ext_vector_type(8))); typedef float f4 __attribute__((ext_vector_type(4))); typedef float f16v __attribute__((ext_vector_type(16)));
    v8i a8, b8; s8 ab, bb;
    for (int i = 0; i < 8; ++i) { a8[i] = threadIdx.x * 2654435761u + i; b8[i] = threadIdx.x * 40503u + 7 * i; ab[i] = (short)(threadIdx.x + i); bb[i] = (short)(3 * threadIdx.x + i); }
    f4 c[8]; f16v d[4];
    for (int i = 0; i < 8; ++i) c[i] = (f4){0.f, 0.f, 0.f, 0.f};
    for (int i = 0; i < 4; ++i) d[i] = (f16v){};
    for (int it = 0; it < iters; ++it) {
        if (KIND == 0) {
#pragma unroll
            for (int i = 0; i < 8; ++i) c[i] = __builtin_amdgcn_mfma_f32_16x16x32_bf16(ab, bb, c[i], 0, 0, 0);
        } else if (KIND == 1) {
#pragma unroll
            for (int i = 0; i < 8; ++i) c[i] = __builtin_amdgcn_mfma_scale_f32_16x16x128_f8f6f4(a8, b8, c[i], 0, 0, 0, 0x7F7F7F7F, 0, 0x7F7F7F7F);
        } else {
#pragma unroll
            for (int i = 0; i < 4; ++i) d[i] = __builtin_amdgcn_mfma_scale_f32_32x32x64_f8f6f4(a8, b8, d[i], 0, 0, 0, 0x7F7F7F7F, 0, 0x7F7F7F7F);
        }
    }
    float s = 0.f;
    for (int i = 0; i < 8; ++i) s += c[i][0] + c[i][1] + c[i][2] + c[i][3];
    for (int i = 0; i < 4; ++i) for (int j = 0; j < 16; ++j) s += d[i][j];
    if (s == 123.456f) sink[threadIdx.x] = s;
}
#endif
extern "C" void kernel_launch(void* const* d_in, const int* in_sizes, int n_in, void* d_out, int out_size, void* d_ws, size_t ws_size, hipStream_t stream) {
    static int grid = 0;
    if (grid == 0) {
        if (n_in != 22 || ws_size < WS_END || out_size != T * DM) { fprintf(stderr, "kernel_launch: unexpected shapes n_in %d ws %zu out %d\n", n_in, ws_size, out_size); grid = -1; return; }
        int dev = 0, cus = 0;
        if (hipGetDevice(&dev) != hipSuccess || hipDeviceGetAttribute(&cus, hipDeviceAttributeMultiprocessorCount, dev) != hipSuccess) { grid = -1; return; }
        if (hipFuncSetAttribute((const void*)skel_fwd, hipFuncAttributeMaxDynamicSharedMemorySize, LDS_BYTES) != hipSuccess) { fprintf(stderr, "kernel_launch: hipFuncSetAttribute failed\n"); grid = -1; return; }
        int per_cu = 0;
        if (hipOccupancyMaxActiveBlocksPerMultiprocessor(&per_cu, (const void*)skel_fwd, NWAVES * 64, LDS_BYTES) != hipSuccess || per_cu < 1) { fprintf(stderr, "kernel_launch: occupancy query says %d workgroups per CU; nothing launched\n", per_cu); grid = -1; return; }
        (void)hipGetLastError();
        grid = cus;
    }
    if (grid < 0) return;
    unsigned char* ws = (unsigned char*)d_ws; float* out = (float*)d_out;
#if DEV_ORACLE
    const float* x = (const float*)d_in[0]; const int* pos = (const int*)d_in[2];
    const float* hgg = (const float*)d_in[8]; const float* qg = (const float*)d_in[10]; const float* kg = (const float*)d_in[11];
    const float* sinks = (const float*)d_in[12]; const float* n2g = (const float*)d_in[15]; const float* w_r = (const float*)d_in[16]; const float* b_r = (const float*)d_in[17];
    const float* w_up = (const float*)d_in[18]; const float* b_up = (const float*)d_in[19]; const float* w_dn = (const float*)d_in[20]; const float* b_dn = (const float*)d_in[21];
    float* MOD = (float*)(ws + WS_MOD); float* LB = (float*)(ws + WS_LB);
    bf16* XN = (bf16*)(ws + WS_XN); bf16* QH = (bf16*)(ws + WS_QH); float* LF = (float*)(ws + WS_LF); bf16* VH = (bf16*)(ws + WS_VH); bf16* GH = (bf16*)(ws + WS_GH);
    bf16* AQ = (bf16*)(ws + WS_AQ); bf16* AKV = (bf16*)(ws + WS_AKV); bf16* SGH = (bf16*)(ws + WS_SGH); bf16* SGA = (bf16*)(ws + WS_SGA);
    bf16* HOAO = (bf16*)(ws + WS_HOAO); bf16* MRG = (bf16*)(ws + WS_MRG); bf16* H2 = (bf16*)(ws + WS_H2); bf16* Y = (bf16*)(ws + WS_Y);
    int* TOPI = (int*)(ws + WS_TOPI); float* TOPW = (float*)(ws + WS_TOPW);
    float* OTMP = (float*)(ws + WS_OTMP); float* QN = (float*)(ws + WS_QN); float* KN = (float*)(ws + WS_KN);
#endif
    (void)hipMemsetAsync(ws + WS_CTL, 0, CTL_ZERO_BYTES, stream);
    Args a{}; for (int i = 0; i < 22; ++i) a.in[i] = d_in[i];
    a.out = out; a.ws = ws; a.one = 0;
#if DEV_ORACLE
#ifndef DEV_REP
#define DEV_REP 0
#endif
#define SK(p) do { a.ph_lo = (p); a.ph_hi = (p) + 1; for (int r_ = 0; r_ < (((DEV_REP >> (p)) & 1) ? 2 : 1); ++r_) hipLaunchKernelGGL(skel_fwd, dim3(grid), dim3(NWAVES * 64), LDS_BYTES, stream, a); } while (0)
#define ON(p) ((DEV_MASK >> (p)) & 1)
    if (ON(0)) SK(0); else { n_mod<<<dim3(24, 16), 256, 0, stream>>>((const float*)d_in[1], (const float*)d_in[3], (const float*)d_in[4], MOD); n_misc<<<4, 256, 0, stream>>>((const float*)d_in[7], LB, H2); }
    if (ON(1)) SK(1); else k_normmod<<<T / 4, 256, 0, stream>>>(x, (const float*)d_in[5], MOD, 0, 1024, XN);
    if (ON(2)) SK(2); else n_gemm<EpiInN><<<dim3(INW / 64, T / 64), 256, 0, stream>>>(XN, 1024, (const float*)d_in[6], INW, 1024, EpiInN{QH, LF, VH, GH, AQ, AKV, SGH, SGA, LB});
    a.sub = ON(3) ? DEV_SUB : 0;
    if (a.sub) { a.ph_lo = 3; a.ph_hi = 4; hipLaunchKernelGGL(skel_fwd, dim3(grid), dim3(NWAVES * 64), LDS_BYTES, stream, a);
#ifdef DEV_SUB2
        a.sub = DEV_SUB2; hipLaunchKernelGGL(skel_fwd, dim3(grid), dim3(NWAVES * 64), LDS_BYTES, stream, a); a.sub = DEV_SUB;
#endif
    }
    if (!(a.sub & 1)) { n_hgrn<<<128, 64, 0, stream>>>(QH, LF, VH, OTMP); n_hgrn_norm<<<T, 256, 0, stream>>>(OTMP, hgg, GH, HOAO); }
    if (!(a.sub & 2)) { n_qkn<<<(T * 10 + 255) / 256, 256, 0, stream>>>(AQ, AKV, pos, qg, kg, QN, KN); n_attn<<<T * 8 / 256, 256, 0, stream>>>(QN, KN, AKV, sinks, HOAO); }
    if (ON(4)) SK(4); else {
        n_gemm<EpiM1N><<<dim3(16, T / 64), 256, 0, stream>>>(HOAO, 1024, (const float*)d_in[9], 1024, 512, EpiM1N{MRG, SGH});
        n_gemm<EpiM2N><<<dim3(16, T / 64), 256, 0, stream>>>(HOAO + 512, 1024, (const float*)d_in[13], 1024, 512, EpiM2N{MRG, SGA});
    }
    if (ON(5)) { SK(5);
#ifdef DEV_SUB5
        a.sub = DEV_SUB5; a.ph_lo = 5; a.ph_hi = 6; hipLaunchKernelGGL(skel_fwd, dim3(grid), dim3(NWAVES * 64), LDS_BYTES, stream, a); a.sub = DEV_SUB;
#endif
    } else n_gemm<EpiOutN><<<dim3(16, T / 64), 256, 0, stream>>>(MRG, 1024, (const float*)d_in[14], 1024, 1024, EpiOutN{x, MOD, out});
    if (ON(6)) { SK(6);
#ifdef DEV_P6_TWICE
        a.sub = DEV_SUB | 16; a.ph_lo = 6; a.ph_hi = 7; hipLaunchKernelGGL(skel_fwd, dim3(grid), dim3(NWAVES * 64), LDS_BYTES, stream, a); a.sub = DEV_SUB;
#endif
    } else n_route<<<T / 4, 256, 0, stream>>>(out, n2g, MOD, w_r, b_r, H2, TOPI, TOPW);
    if (ON(7) && ON(8)) { SK(7);
#ifdef DEV_SUB7
        a.sub = DEV_SUB7; a.ph_lo = 7; a.ph_hi = 8; hipLaunchKernelGGL(skel_fwd, dim3(grid), dim3(NWAVES * 64), LDS_BYTES, stream, a); a.sub = DEV_SUB;
#endif
        SK(8); } else n_moe<<<T * 4, 256, 0, stream>>>(H2, TOPI, TOPW, w_up, b_up, w_dn, b_dn, Y);
#ifdef DEV_BENCH
    mfma_bench<DEV_BENCH><<<256, 512, 0, stream>>>((float*)(ws + WS_TMP), 512);
#endif
    if (ON(9)) SK(9); else k_final<<<T / 4, 256, 0, stream>>>(out, MOD, Y);
#else
    a.one = 1; a.sub = 7; a.ph_lo = 0; a.ph_hi = 10;
    hipLaunchKernelGGL(skel_fwd, dim3(grid), dim3(NWAVES * 64), LDS_BYTES, stream, a);
#endif
}
```

```cpp
#include <hip/hip_runtime.h>
#include <cstdio>
#include <cstdint>
#include <cmath>

typedef unsigned short bf16;
constexpr int BATCH = 16, SEQ = 2048, DM = 1024, T = BATCH * SEQ;
constexpr int INW = 4864, NEXP = 32, TOPK = 4, DEXP = 1024;
constexpr float EPS = 1e-6f;

constexpr size_t MiB = 1u << 20;
constexpr size_t WS_CTL = 0;
constexpr size_t WS_MOD = 1 * MiB;
constexpr size_t WS_LB = 1 * MiB + 512 * 1024;
constexpr size_t WS_IDT = 1 * MiB + 768 * 1024;
constexpr size_t WS_BUPP = 2 * MiB;
constexpr size_t WS_TOKL = 4 * MiB;
constexpr size_t WS_GATL = 8 * MiB;
constexpr size_t WS_TOPI = 12 * MiB;
constexpr size_t WS_TOPW = 13 * MiB;
constexpr size_t WS_WIN = 16 * MiB, WS_WHG = 26 * MiB, WS_WATT = 27 * MiB, WS_WOUT = 28 * MiB, WS_WUP = 32 * MiB, WS_WDN = 160 * MiB;
constexpr size_t WS_H2 = 224 * MiB;
constexpr size_t WS_R = 290 * MiB;
constexpr size_t WS_XN = WS_R, WS_QH = WS_R + 64 * MiB, WS_LF = WS_R + 96 * MiB, WS_VH = WS_R + 160 * MiB, WS_GH = WS_R + 192 * MiB,
                 WS_AQ = WS_R + 224 * MiB, WS_AKV = WS_R + 256 * MiB, WS_SGH = WS_R + 272 * MiB, WS_SGA = WS_R + 336 * MiB,
                 WS_HOAO = WS_R + 400 * MiB, WS_MRG = WS_R + 464 * MiB;
constexpr size_t WS_ACT = WS_R, WS_Y = WS_R + 272 * MiB;
constexpr size_t WS_TMP = 820 * MiB;
constexpr size_t WS_OTMP = WS_TMP, WS_QN = WS_TMP + 64 * MiB, WS_KN = WS_TMP + 128 * MiB;
constexpr size_t WS_M1 = 904 * MiB;
constexpr size_t WS_X1B = 840 * MiB;
constexpr size_t WS_END = 968 * MiB;

__device__ __forceinline__ float bf2f(bf16 v) { return __uint_as_float((unsigned)v << 16); }
typedef float f32x2_t __attribute__((ext_vector_type(2))); typedef __bf16 bf16x2_t __attribute__((ext_vector_type(2)));
__device__ __forceinline__ unsigned cvtpk_s(float lo, float hi) { f32x2_t v = {lo, hi}; bf16x2_t b = __builtin_convertvector(v, bf16x2_t); return __builtin_bit_cast(unsigned, b); }
__device__ __forceinline__ bf16 f2bf(float f) { return (bf16)(cvtpk_s(f, f) & 0xffffu); }
__device__ __forceinline__ float silu_f(float x) { return x / (1.f + __expf(-x)); }
__device__ __forceinline__ float sigm_f(float x) { return 1.f / (1.f + __expf(-x)); }
__device__ __forceinline__ float wave_sum(float v) {
#pragma unroll
    for (int o = 1; o < 64; o <<= 1) v += __shfl_xor(v, o);
    return v;
}

__device__ __forceinline__ void rope_cs(int pos, int i, float& cs, float& sn) {
    const float invf = exp2f(-(float)i * 0.125f * 18.931568569324174f);
    double a = (double)pos * (double)invf * 0.15915494309189535; a -= floor(a);
    sn = __builtin_amdgcn_sinf((float)a); cs = __builtin_amdgcn_cosf((float)a);
}
#ifndef DEV_ORACLE
#define DEV_ORACLE 0
#endif
#if DEV_ORACLE
__global__ void n_mod(const float* c, const float* w_ada, const float* b_ada, float* MOD) {
    const int n = blockIdx.x * 256 + threadIdx.x, b = blockIdx.y;
    __shared__ float cond[1024];
    for (int k = threadIdx.x; k < 1024; k += 256) cond[k] = silu_f(c[b * 1024 + k]);
    __syncthreads();
    float acc = 0.f;
    for (int k = 0; k < 1024; ++k) acc += cond[k] * w_ada[(size_t)k * 6144 + n];
    MOD[b * 6144 + n] = acc + b_ada[n];
}
__global__ void n_misc(const float* lbl, float* LB, bf16* H2) {
    const int i = blockIdx.x * 256 + threadIdx.x;
    if (i < 512) LB[i] = 1.f / (1.f + __expf(lbl[512 + i] - lbl[i]));
    if (i < 1024) H2[(size_t)T * 1024 + i] = 0;
}
__global__ void k_normmod(const float* x, const float* gain, const float* MOD, int sh_off, int sc_off, bf16* out) {
    const int lane = threadIdx.x & 63, row = blockIdx.x * 4 + (threadIdx.x >> 6), b = row / SEQ;
    const float4* xr = (const float4*)(x + (size_t)row * DM) + lane;
    float4 v[4]; float s = 0.f;
#pragma unroll
    for (int j = 0; j < 4; ++j) { v[j] = xr[64 * j]; s += v[j].x * v[j].x + v[j].y * v[j].y + v[j].z * v[j].z + v[j].w * v[j].w; }
    const float rstd = rsqrtf(wave_sum(s) * (1.f / DM) + EPS);
    const float* mb = MOD + (size_t)b * 6144;
#pragma unroll
    for (int j = 0; j < 4; ++j) {
        const int c = 4 * lane + 256 * j;
        const float4 g = *(const float4*)(gain + c), sc = *(const float4*)(mb + sc_off + c), sh = *(const float4*)(mb + sh_off + c);
        ushort4 o;
        o.x = f2bf(v[j].x * rstd * g.x * (1.f + sc.x) + sh.x); o.y = f2bf(v[j].y * rstd * g.y * (1.f + sc.y) + sh.y);
        o.z = f2bf(v[j].z * rstd * g.z * (1.f + sc.z) + sh.z); o.w = f2bf(v[j].w * rstd * g.w * (1.f + sc.w) + sh.w);
        *(ushort4*)(out + (size_t)row * DM + c) = o;
    }
}
template <class Epi> __global__ void n_gemm(const bf16* A, int lda, const float* W, int N, int K, Epi epi) {
    __shared__ float As[16][65], Ws[16][65];
    const int tx = threadIdx.x & 15, ty = threadIdx.x >> 4, m0 = blockIdx.y * 64, n0 = blockIdx.x * 64;
    float acc[4][4];
#pragma unroll
    for (int i = 0; i < 4; ++i)
#pragma unroll
        for (int j = 0; j < 4; ++j) acc[i][j] = 0.f;
    for (int k0 = 0; k0 < K; k0 += 16) {
        for (int i = threadIdx.x; i < 1024; i += 256) { const int r = i >> 4, kk = i & 15; As[kk][r] = bf2f(A[(size_t)(m0 + r) * lda + k0 + kk]); }
        for (int i = threadIdx.x; i < 1024; i += 256) { const int kk = i >> 6, cc = i & 63; Ws[kk][cc] = W[(size_t)(k0 + kk) * N + n0 + cc]; }
        __syncthreads();
#pragma unroll
        for (int kk = 0; kk < 16; ++kk) {
            float a[4], b[4];
#pragma unroll
            for (int i = 0; i < 4; ++i) { a[i] = As[kk][ty * 4 + i]; b[i] = Ws[kk][tx * 4 + i]; }
#pragma unroll
            for (int i = 0; i < 4; ++i)
#pragma unroll
                for (int j = 0; j < 4; ++j) acc[i][j] += a[i] * b[j];
        }
        __syncthreads();
    }
#pragma unroll
    for (int i = 0; i < 4; ++i)
#pragma unroll
        for (int j = 0; j < 4; ++j) epi(m0 + ty * 4 + i, n0 + tx * 4 + j, acc[i][j]);
}
struct EpiInN {
    bf16* QH; float* LF; bf16 *VH, *GH, *AQ, *AKV, *SGH, *SGA; const float* LB;
    __device__ void operator()(int r, int c, float v) const {
        if (c < 512) QH[(size_t)r * 512 + c] = f2bf(silu_f(v));
        else if (c < 1024) { const int cc = c - 512; const float lb = LB[cc]; LF[(size_t)r * 512 + cc] = __logf(lb + (1.f - lb) * sigm_f(v)); }
        else if (c < 1536) VH[(size_t)r * 512 + (c - 1024)] = f2bf(v);
        else if (c < 2048) GH[(size_t)r * 512 + (c - 1536)] = f2bf(silu_f(v));
        else if (c < 2560) AQ[(size_t)r * 512 + (c - 2048)] = f2bf(v);
        else if (c < 2816) AKV[(size_t)r * 256 + (c - 2560)] = f2bf(v);
        else if (c < 3840) SGH[(size_t)r * 1024 + (c - 2816)] = f2bf(sigm_f(v));
        else SGA[(size_t)r * 1024 + (c - 3840)] = f2bf(sigm_f(v));
    }
};
struct EpiM1N { bf16* MRG; const bf16* SG; __device__ void operator()(int r, int c, float v) const { MRG[(size_t)r * 1024 + c] = f2bf(bf2f(SG[(size_t)r * 1024 + c]) * v); } };
struct EpiM2N { bf16* MRG; const bf16* SG; __device__ void operator()(int r, int c, float v) const { MRG[(size_t)r * 1024 + c] = f2bf(bf2f(MRG[(size_t)r * 1024 + c]) + bf2f(SG[(size_t)r * 1024 + c]) * v); } };
struct EpiOutN { const float* x; const float* MOD; float* out; __device__ void operator()(int r, int c, float v) const { out[(size_t)r * 1024 + c] = x[(size_t)r * 1024 + c] + MOD[(size_t)(r / SEQ) * 6144 + 2048 + c] * v; } };

__global__ void n_hgrn(const bf16* QH, const float* LF, const bf16* VH, float* OTMP) {
    const int bh = blockIdx.x >> 1, vh = blockIdx.x & 1, b = bh >> 2, h = bh & 3, v = threadIdx.x;
    __shared__ float S[128 * 64];
    __shared__ float sq[128], sf[128], sk[128];
    for (int i = v; i < 128 * 64; i += 64) S[i] = 0.f;
    for (int t = 0; t < SEQ; ++t) {
        const size_t row = (size_t)b * SEQ + t;
        __syncthreads();
        for (int k = v; k < 128; k += 64) { const float lf = LF[row * 512 + h * 128 + k]; const float f = __expf(lf); sf[k] = f; sk[k] = 1.f - f; sq[k] = bf2f(QH[row * 512 + h * 128 + k]); }
        __syncthreads();
        const float vv = bf2f(VH[row * 512 + h * 128 + vh * 64 + v]);
        float o = 0.f;
        for (int k = 0; k < 128; ++k) { float s = S[k * 64 + v]; s = sf[k] * s + sk[k] * vv; S[k * 64 + v] = s; o += s * sq[k]; }
        OTMP[row * 512 + h * 128 + vh * 64 + v] = o;
    }
}
__global__ void n_hgrn_norm(const float* OTMP, const float* gain, const bf16* GH, bf16* HOAO) {
    const int lane = threadIdx.x & 63, idx = blockIdx.x * 4 + (threadIdx.x >> 6), t = idx >> 2, h = idx & 3;
    const float a = OTMP[(size_t)t * 512 + h * 128 + lane], b = OTMP[(size_t)t * 512 + h * 128 + 64 + lane];
    const float rstd = rsqrtf(wave_sum(a * a + b * b) * (1.f / 128.f) + EPS);
    HOAO[(size_t)t * 1024 + h * 128 + lane] = f2bf(a * rstd * gain[lane] * bf2f(GH[(size_t)t * 512 + h * 128 + lane]));
    HOAO[(size_t)t * 1024 + h * 128 + 64 + lane] = f2bf(b * rstd * gain[64 + lane] * bf2f(GH[(size_t)t * 512 + h * 128 + 64 + lane]));
}
__global__ void n_qkn(const bf16* AQ, const bf16* AKV, const int* pos, const float* qg, const float* kg, float* QN, float* KN) {
    const int idx = blockIdx.x * 256 + threadIdx.x, t = idx / 10, j = idx % 10;
    if (t >= T) return;
    const bf16* src = j < 8 ? AQ + (size_t)t * 512 + j * 64 : AKV + (size_t)t * 256 + (j - 8) * 64;
    const float* g = j < 8 ? qg : kg;
    float* dst = j < 8 ? QN + (size_t)t * 512 + j * 64 : KN + (size_t)t * 128 + (j - 8) * 64;
    float ss = 0.f;
    for (int d = 0; d < 64; ++d) { const float v = bf2f(src[d]); ss += v * v; }
    const float rstd = rsqrtf(ss * (1.f / 64.f) + EPS);
    const int p = pos[t];
    for (int d = 0; d < 64; ++d) {
        float v = bf2f(src[d]) * rstd * g[d];
        if (d < 16) {
            const int i = d & 7; float cs, sn; rope_cs(p, i, cs, sn);
            const float x1 = bf2f(src[i]) * rstd * g[i], x2 = bf2f(src[i + 8]) * rstd * g[i + 8];
            v = d < 8 ? x1 * cs - x2 * sn : x2 * cs + x1 * sn;
        }
        dst[d] = v;
    }
}
__global__ void __launch_bounds__(256) n_attn(const float* QN, const float* KN, const bf16* AKV, const float* sinks, bf16* HOAO) {
    const int idx = blockIdx.x * 256 + threadIdx.x, t = idx >> 3, hq = idx & 7, kvh = hq >> 2, ts = t % SEQ, b0 = t - ts;
    float q[64], acc[64];
#pragma unroll
    for (int d = 0; d < 64; ++d) { q[d] = QN[(size_t)t * 512 + hq * 64 + d] * 0.125f; acc[d] = 0.f; }
    float m = sinks[hq], l = 1.f;
    for (int kt = (ts >= 127 ? ts - 127 : 0); kt <= ts; ++kt) {
        const float* kr = KN + (size_t)(b0 + kt) * 128 + kvh * 64; const bf16* vr = AKV + (size_t)(b0 + kt) * 256 + 128 + kvh * 64;
        float s = 0.f;
#pragma unroll
        for (int d = 0; d < 64; ++d) s += q[d] * kr[d];
        const float mn = fmaxf(m, s), sc = __expf(m - mn), p = __expf(s - mn);
        l = l * sc + p; m = mn;
#pragma unroll
        for (int d = 0; d < 64; ++d) acc[d] = acc[d] * sc + p * bf2f(vr[d]);
    }
    const float il = 1.f / l;
#pragma unroll
    for (int d = 0; d < 64; ++d) HOAO[(size_t)t * 1024 + 512 + hq * 64 + d] = f2bf(acc[d] * il);
}
__global__ void __launch_bounds__(256) n_route(const float* x1, const float* gain, const float* MOD, const float* wr, const float* br, bf16* H2, int* TOPI, float* TOPW) {
    const int lane = threadIdx.x & 63, row = blockIdx.x * 4 + (threadIdx.x >> 6), b = row / SEQ;
    const float4* xr = (const float4*)(x1 + (size_t)row * DM) + lane;
    float4 v[4]; float s = 0.f;
#pragma unroll
    for (int j = 0; j < 4; ++j) { v[j] = xr[64 * j]; s += v[j].x * v[j].x + v[j].y * v[j].y + v[j].z * v[j].z + v[j].w * v[j].w; }
    const float rstd = rsqrtf(wave_sum(s) * (1.f / DM) + EPS);
    const float* mb = MOD + (size_t)b * 6144;
    float hv[16];
#pragma unroll
    for (int j = 0; j < 4; ++j) {
        const int c = 4 * lane + 256 * j;
        const float4 g = *(const float4*)(gain + c), sc = *(const float4*)(mb + 4096 + c), sh = *(const float4*)(mb + 3072 + c);
        hv[4 * j + 0] = v[j].x * rstd * g.x * (1.f + sc.x) + sh.x; hv[4 * j + 1] = v[j].y * rstd * g.y * (1.f + sc.y) + sh.y;
        hv[4 * j + 2] = v[j].z * rstd * g.z * (1.f + sc.z) + sh.z; hv[4 * j + 3] = v[j].w * rstd * g.w * (1.f + sc.w) + sh.w;
        ushort4 o; o.x = f2bf(hv[4 * j]); o.y = f2bf(hv[4 * j + 1]); o.z = f2bf(hv[4 * j + 2]); o.w = f2bf(hv[4 * j + 3]);
        *(ushort4*)(H2 + (size_t)row * DM + c) = o;
    }
    float lg[32];
#pragma unroll
    for (int e = 0; e < 32; ++e) {
        float p = 0.f;
#pragma unroll
        for (int j = 0; j < 4; ++j)
#pragma unroll
            for (int i = 0; i < 4; ++i) p += hv[4 * j + i] * wr[(size_t)(4 * lane + 256 * j + i) * 32 + e];
        lg[e] = wave_sum(p) + br[e];
    }
    unsigned used = 0u; float tv[4]; int ti[4];
#pragma unroll
    for (int k = 0; k < 4; ++k) {
        float best = -INFINITY; int bi = 0;
#pragma unroll
        for (int e = 0; e < 32; ++e) { const bool ok = !((used >> e) & 1u) && lg[e] > best; best = ok ? lg[e] : best; bi = ok ? e : bi; }
        used |= 1u << bi; tv[k] = best; ti[k] = bi;
    }
    const float e1 = __expf(tv[1] - tv[0]), e2 = __expf(tv[2] - tv[0]), e3 = __expf(tv[3] - tv[0]), inv = 1.f / (1.f + e1 + e2 + e3);
    if (lane == 0) {
        TOPI[row * 4 + 0] = ti[0]; TOPI[row * 4 + 1] = ti[1]; TOPI[row * 4 + 2] = ti[2]; TOPI[row * 4 + 3] = ti[3];
        TOPW[row * 4 + 0] = inv; TOPW[row * 4 + 1] = e1 * inv; TOPW[row * 4 + 2] = e2 * inv; TOPW[row * 4 + 3] = e3 * inv;
    }
}
__global__ void n_moe(const bf16* H2, const int* TOPI, const float* TOPW, const float* w_up, const float* b_up, const float* w_dn, const float* b_dn, bf16* Y) {
    const int a = blockIdx.x, t = a >> 2, tid = threadIdx.x, e = TOPI[a];
    const float gate = TOPW[a];
    __shared__ float hr[1024], av[1024];
    for (int k = tid; k < 1024; k += 256) hr[k] = bf2f(H2[(size_t)t * 1024 + k]);
    __syncthreads();
    const float* wu = w_up + (size_t)e * 1024 * 2048; const float* bu = b_up + (size_t)e * 2048;
    float ag[4], al[4];
#pragma unroll
    for (int j = 0; j < 4; ++j) { ag[j] = 0.f; al[j] = 0.f; }
    for (int k = 0; k < 1024; ++k) {
        const float h = hr[k];
#pragma unroll
        for (int j = 0; j < 4; ++j) { const float2 w = *(const float2*)(wu + (size_t)k * 2048 + 2 * (tid + 256 * j)); ag[j] += h * w.x; al[j] += h * w.y; }
    }
#pragma unroll
    for (int j = 0; j < 4; ++j) {
        const int o = tid + 256 * j;
        const float g = fminf(ag[j] + bu[2 * o], 7.f), li = fminf(fmaxf(al[j] + bu[2 * o + 1], -7.f), 7.f);
        av[o] = g * sigm_f(1.702f * g) * (li + 1.f);
    }
    __syncthreads();
    const float* wd = w_dn + (size_t)e * 1024 * 1024; const float* bd = b_dn + (size_t)e * 1024;
    float y[4];
#pragma unroll
    for (int j = 0; j < 4; ++j) y[j] = 0.f;
    for (int k = 0; k < 1024; ++k) {
        const float h = av[k];
#pragma unroll
        for (int j = 0; j < 4; ++j) y[j] += h * wd[(size_t)k * 1024 + tid + 256 * j];
    }
#pragma unroll
    for (int j = 0; j < 4; ++j) Y[(size_t)a * 1024 + tid + 256 * j] = f2bf(gate * (y[j] + bd[tid + 256 * j]));
}
__global__ void k_final(float* out, const float* MOD, const bf16* Y) {
    const int lane = threadIdx.x & 63, row = blockIdx.x * 4 + (threadIdx.x >> 6), b = row / SEQ;
    const float* g2 = MOD + (size_t)b * 6144 + 5120;
#pragma unroll
    for (int j = 0; j < 4; ++j) {
        const int c = 4 * lane + 256 * j;
        float4 x = *(float4*)(out + (size_t)row * DM + c); const float4 g = *(const float4*)(g2 + c);
        float s0 = 0.f, s1 = 0.f, s2 = 0.f, s3 = 0.f;
#pragma unroll
        for (int k = 0; k < 4; ++k) { const ushort4 y = *(const ushort4*)(Y + ((size_t)row * 4 + k) * DM + c); s0 += bf2f(y.x); s1 += bf2f(y.y); s2 += bf2f(y.z); s3 += bf2f(y.w); }
        x.x += g.x * s0; x.y += g.y * s1; x.z += g.z * s2; x.w += g.w * s3;
        *(float4*)(out + (size_t)row * DM + c) = x;
    }
}

#endif

namespace pg8 {
#define PG8_LAS __attribute__((address_space(3)))
typedef unsigned short bf16_t;
typedef short bf16x8 __attribute__((ext_vector_type(8)));
typedef float f32x4 __attribute__((ext_vector_type(4)));
typedef unsigned u32x4 __attribute__((ext_vector_type(4))); typedef int v4i32_t __attribute__((ext_vector_type(4)));
constexpr int BM = 256, BK = 64, HALF = 128, HTB = HALF * BK * 2  , STAGE_BYTES = 8 * HTB, NXCD = 8, WGM = 8, MAXU = 24  ;

__host__ __device__ __forceinline__ int lds_byte(int r, int c) { const int st = (r >> 4) * 2 + (c >> 5), rr = r & 15, cc = c & 31, ob = rr * 64 + cc * 2; return st * 1024 + (ob ^ (((ob >> 9) & 1) << 5)); }
__host__ __device__ __forceinline__ void stage_rc(int b, int& R, int& C) { const int st = b / 1024, sb = b % 1024, swz = sb ^ (((sb >> 9) & 1) << 5); R = (st >> 1) * 16 + swz / 64; C = (st & 1) * 32 + (swz % 64) / 2; }
__host__ __device__ __forceinline__ int perm32(int rho) { const int n = rho >> 4, i = rho & 15; return 8 * (i >> 2) + 4 * n + (i & 3); }

struct Unit { int pm, pn, arow0, nvalid; unsigned abase; };
struct Gemm { const bf16_t* A; const bf16_t* Bt; int M, N, K; const int* rowidx; int zero_row; int lda; };

struct StaticOrder {
    int nM, nN, nwg, G, c; unsigned abase_per_pm;
    __host__ __device__ void init(int M, int N, int G_, int c_) { nM = M / BM; nN = N / BM; nwg = nM * nN; G = G_; c = c_; abase_per_pm = 0u; }
    __host__ __device__ bool next(int i, Unit& u) const {
        const long L = (long)i * G + c; if (L >= nwg) return false;
        int wgid = (int)L; { const int q = nwg / NXCD, r = nwg % NXCD, xcd = wgid % NXCD, off = wgid / NXCD; wgid = (xcd < r ? xcd * (q + 1) : r * (q + 1) + (xcd - r) * q) + off; }
        const int nig = WGM * nN, gid = wgid / nig, fm = gid * WGM, gsz = (nM - fm) < WGM ? (nM - fm) : WGM;
        u.pm = fm + ((wgid % nig) % gsz); u.pn = (wgid % nig) / gsz; u.arow0 = 0; u.nvalid = 0; u.abase = (unsigned)u.pm * abase_per_pm; return true;
    }
};
constexpr int UT_OFF = STAGE_BYTES + MAXU * 512;
struct CachedOrder {
    const PG8_LAS int* tab; int n;
    template <class Sched> __device__ __forceinline__ void build(PG8_LAS unsigned char* lds, const Sched& S) {
        PG8_LAS int* t = (PG8_LAS int*)(lds + UT_OFF);
        if (threadIdx.x < 64) { Unit u; u.pm = 0; u.pn = 0; u.arow0 = 0; u.nvalid = 0; u.abase = 0u; const int i = threadIdx.x; const bool ok = (i < MAXU) && S.next(i, u);
            if (ok) { t[8 * i] = u.pm; t[8 * i + 1] = u.pn; t[8 * i + 2] = u.arow0; t[8 * i + 3] = u.nvalid; t[8 * i + 4] = (int)u.abase; }
            const unsigned long long m = __ballot(ok); if (i == 0) t[8 * MAXU] = __popcll(m); }
        __syncthreads();
        tab = t; n = __builtin_amdgcn_readfirstlane(t[8 * MAXU]);
    }
    __device__ __forceinline__ bool next(int i, Unit& u) const {
        if (i >= n) return false;
        const v4i32_t a = *(const PG8_LAS v4i32_t*)(tab + 8 * i); u.pm = __builtin_amdgcn_readfirstlane(a.x); u.pn = __builtin_amdgcn_readfirstlane(a.y); u.arow0 = __builtin_amdgcn_readfirstlane(a.z); u.nvalid = __builtin_amdgcn_readfirstlane(a.w);
        u.abase = (unsigned)__builtin_amdgcn_readfirstlane(tab[8 * i + 4]); return true;
    }
};
__device__ __forceinline__ unsigned cvt_pk_bf16(float lo, float hi) { unsigned r; asm volatile("v_cvt_pk_bf16_f32 %0, %1, %2" : "=v"(r) : "v"(lo), "v"(hi)); return r; }

__host__ __device__ __forceinline__ int tk_pos(int r) { return (r & 63) * 4 + ((r >> 7) & 1) + 2 * ((r >> 6) & 1); }
typedef int v8i32 __attribute__((ext_vector_type(8))); typedef int v4i32 __attribute__((ext_vector_type(4)));
template <class Epi, class Sched, bool ALIGN_EPI, int GATHER, int EB = 2, int PROBE = 0, int STAMP = 0>
__device__ __forceinline__ void gemm_phase(PG8_LAS unsigned char* lds, const Gemm g, const Sched& S, const Epi& E, unsigned long long* dbg = nullptr) {
    unsigned long long st_all = 0, st_k = 0, st_e = 0, st_t = 0; if constexpr (STAMP) st_all = __builtin_amdgcn_s_memrealtime();
    const int tid = threadIdx.x, wid = __builtin_amdgcn_readfirstlane(tid >> 6), lane = tid & 63, wr = wid >> 2, wc = wid & 3, fr = lane & 15, fq = lane >> 4;
    const int K = g.K, nt = K * EB / (BK * 2), lda = g.lda;
    unsigned voffA[2], voffB[2];
#pragma unroll
    for (int i = 0; i < 2; ++i) { int R, C; stage_rc(tid * 16 + i * 8192, R, C); const int Rb = Epi::PERM ? ((R & ~31) + perm32(R & 31)) : R;
        voffA[i] = (unsigned)(R * lda * EB + C * 2); voffB[i] = (unsigned)(Rb * K * EB + C * 2); }
    unsigned tokP[2], cpk = 0, abase = 0;
    const size_t kstep = (size_t)(BK * 2);
    const size_t hstep = (size_t)HALF * K * EB;
    const size_t hstepA = GATHER ? 0 : (size_t)HALF * lda * EB; const size_t tstepA = (size_t)BM * lda * EB;
    const size_t tstep = 2 * hstep;
    const unsigned ldsw = (unsigned)wid * 1024u;
    const int aoff = lds_byte(wr * 64 + fr, fq * 8), boff = lds_byte(wc * 32 + fr, fq * 8);
#define PG8_SA(b, h) (((b) * 2 + (h)) * HTB)
#define PG8_SB(b, h) ((4 + (b) * 2 + (h)) * HTB)
#define PG8_STAGE(bufoff, gbase, voff) do { _Pragma("unroll") for (int _i = 0; _i < 2; ++_i) \
        __builtin_amdgcn_global_load_lds((const unsigned*)((const char*)(gbase) + (voff)[_i]), (PG8_LAS unsigned*)(lds + (bufoff) + ldsw + _i * 8192), 16, 0, 0); } while (0)
#define PG8_STAGE_A(b, h, gbase) do { if constexpr (PROBE == 2) { PG8_STAGE(PG8_SA(b, h), cB, voffB); } else if constexpr (GATHER) { _Pragma("unroll") for (int _i = 0; _i < 2; ++_i) { const unsigned off_ = ((tokP[_i] >> (16 * (h))) & 0xffffu) * (unsigned)(lda * EB) + ((cpk >> (8 * _i)) & 0xffu) + abase; \
        __builtin_amdgcn_global_load_lds((const unsigned*)((const char*)(gbase) + off_), (PG8_LAS unsigned*)(lds + PG8_SA(b, h) + ldsw + _i * 8192), 16, 0, 0); } } else { PG8_STAGE(PG8_SA(b, h), (gbase) + (h) * hstepA, voffA); } } while (0)
#define PG8_GOFF(dst, uo) do { if constexpr (GATHER == 1) { int R_, C_; stage_rc(tid * 16, R_, C_); const unsigned long long tn_ = *(const PG8_LAS unsigned long long*)(lds + STAGE_BYTES + (uo) * 512 + R_ * 8); dst[0] = (unsigned)tn_; dst[1] = (unsigned)(tn_ >> 32); } \
        else { int R_, C_; stage_rc(tid * 16, R_, C_); dst[0] = (unsigned)R_ | ((unsigned)(HALF + R_) << 16); dst[1] = (unsigned)(R_ + 64) | ((unsigned)(HALF + 64 + R_) << 16); } } while (0)
#define PG8_LD8(addr) __builtin_shufflevector(*(const PG8_LAS v4i32*)(addr), *(const PG8_LAS v4i32*)((addr) + 1024), 0, 1, 2, 3, 4, 5, 6, 7)
#define PG8_LDA(dst, b, h) do { if constexpr (EB == 2) { _Pragma("unroll") for (int m = 0; m < 4; ++m) _Pragma("unroll") for (int k = 0; k < 2; ++k) dst[m][k] = *(const PG8_LAS bf16x8*)(lds + PG8_SA(b, h) + aoff + m * 2048 + k * 1024); } \
        else { _Pragma("unroll") for (int m = 0; m < 4; ++m) dst##8[m] = PG8_LD8(lds + PG8_SA(b, h) + aoff + m * 2048); } } while (0)
#define PG8_LDB(dst, b, h) do { if constexpr (EB == 2) { _Pragma("unroll") for (int n = 0; n < 2; ++n) _Pragma("unroll") for (int k = 0; k < 2; ++k) dst[n][k] = *(const PG8_LAS bf16x8*)(lds + PG8_SB(b, h) + boff + n * 2048 + k * 1024); } \
        else { _Pragma("unroll") for (int n = 0; n < 2; ++n) dst##8[n] = PG8_LD8(lds + PG8_SB(b, h) + boff + n * 2048); } } while (0)
#define PG8_MMA(ai, bj, At, Bt) do { __builtin_amdgcn_s_setprio(1); if constexpr (EB == 2) { _Pragma("unroll") for (int m = 0; m < 4; ++m) _Pragma("unroll") for (int n = 0; n < 2; ++n) _Pragma("unroll") for (int k = 0; k < 2; ++k) \
        acc[ai][bj][m][n] = __builtin_amdgcn_mfma_f32_16x16x32_bf16(Bt[n][k], At[m][k], acc[ai][bj][m][n], 0, 0, 0); } else { _Pragma("unroll") for (int m = 0; m < 4; ++m) _Pragma("unroll") for (int n = 0; n < 2; ++n) \
        acc[ai][bj][m][n] = __builtin_amdgcn_mfma_scale_f32_16x16x128_f8f6f4(Bt##8[n], At##8[m], acc[ai][bj][m][n], 0, 0, 0, 0x7F7F7F7F, 0, 0x7F7F7F7F); } __builtin_amdgcn_s_setprio(0); } while (0)
#define PG8_WAIT_V(n) asm volatile("s_waitcnt vmcnt(" #n ")" ::: "memory")
#define PG8_WAIT_VX(flag) do { if constexpr (Epi::NST > 0) { asm volatile("s_cmp_lg_u32 %0, 0\n\ts_cbranch_scc1 .LWX%=\n\ts_waitcnt vmcnt(8)\n\ts_branch .LWY%=\n.LWX%=:\n\ts_waitcnt vmcnt(%1)\n.LWY%=:" :: "s"(flag), "i"(8 + Epi::NST) : "memory", "scc"); } \
        else { asm volatile("s_waitcnt vmcnt(8)" ::: "memory"); } } while (0)
#define PG8_WAIT_L(n) asm volatile("s_waitcnt lgkmcnt(" #n ")" ::: "memory")
#define PG8_BAR __builtin_amdgcn_s_barrier()
#define PG8_SCHED __builtin_amdgcn_sched_barrier(0)
    Unit cur, nxt; int ui = 0;
    if (!S.next(0, cur)) return;
    f32x4 acc[2][2][4][2];
#pragma unroll
    for (int a = 0; a < 2; ++a)
#pragma unroll
        for (int b = 0; b < 2; ++b)
#pragma unroll
            for (int m = 0; m < 4; ++m)
#pragma unroll
                for (int n = 0; n < 2; ++n) acc[a][b][m][n] = (f32x4){0.f, 0.f, 0.f, 0.f};
    bf16x8 At[4][2], B0[2][2], B1[2][2]; v8i32 At8[4], B08[2], B18[2];
    const char* cA = GATHER ? (const char*)g.A : (const char*)g.A + (size_t)cur.pm * tstepA; const char* cB = (const char*)g.Bt + (size_t)cur.pn * tstep;
    if constexpr (GATHER != 0) abase = cur.abase;
    if constexpr (GATHER) { PG8_GOFF(tokP, 0); int R0_, C0_, R1_, C1_; stage_rc(tid * 16, R0_, C0_); stage_rc(tid * 16 + 8192, R1_, C1_); cpk = (unsigned)(C0_ * 2) | ((unsigned)(C1_ * 2) << 8); }
    PG8_STAGE(PG8_SB(0, 0), cB, voffB); PG8_STAGE(PG8_SB(0, 1), cB + hstep, voffB); PG8_STAGE_A(0, 0, cA); PG8_STAGE_A(0, 1, cA);
    if (wr == 1) PG8_BAR;
    PG8_WAIT_V(2); PG8_BAR;
    PG8_STAGE(PG8_SB(1, 0), cB + kstep, voffB); PG8_STAGE_A(1, 0, cA + kstep); PG8_STAGE(PG8_SB(1, 1), cB + hstep + kstep, voffB);
    PG8_WAIT_V(6); PG8_BAR;
    for (;;) {
        const bool has_next = S.next(ui + 1, nxt);
        const char* nA = GATHER ? cA : (has_next ? (const char*)g.A + (size_t)nxt.pm * tstepA : cA); const char* nB = has_next ? (const char*)g.Bt + (size_t)nxt.pn * tstep : cB;
        if constexpr (STAMP) st_t = __builtin_amdgcn_s_memrealtime();
#pragma nounroll
        for (int t = 0; t < nt; t += 2) {
            const bool last = (t == nt - 2);
            const int relax_ = __builtin_amdgcn_readfirstlane((t == 0 && ui > 0) ? 1 : 0);
            if constexpr (GATHER != 0) asm volatile("" : "+v"(tokP[0]), "+v"(tokP[1]), "+v"(cpk));
            const char* a1 = cA + (size_t)(t + 1) * kstep;
            const char* a2 = last ? nA : cA + (size_t)(t + 2) * kstep; const char* b2 = last ? nB : cB + (size_t)(t + 2) * kstep;
            const char* a3 = a2 + kstep; const char* b3 = b2 + kstep;
            PG8_LDB(B0, 0, 0); PG8_LDB(B1, 0, 1); PG8_SCHED; PG8_LDA(At, 0, 0); PG8_STAGE_A(1, 1, a1);
            PG8_WAIT_VX(relax_);
            PG8_WAIT_L(0); PG8_BAR; PG8_MMA(0, 0, At, B0); if constexpr (PROBE != 1) PG8_MMA(0, 1, At, B1); PG8_BAR; PG8_SCHED;
            if constexpr (GATHER != 0) { if (last && has_next) abase = nxt.abase; }
            if constexpr (GATHER == 1) { if (last && has_next) { PG8_GOFF(tokP, ui + 1); } }
            PG8_LDA(At, 0, 1); PG8_STAGE(PG8_SB(0, 0), b2, voffB); PG8_STAGE(PG8_SB(0, 1), b2 + hstep, voffB); PG8_STAGE_A(0, 0, a2);
            PG8_WAIT_VX(relax_);
            PG8_WAIT_L(0); PG8_BAR; PG8_MMA(1, 0, At, B0); if constexpr (PROBE != 1) PG8_MMA(1, 1, At, B1); PG8_BAR; PG8_SCHED;
            PG8_LDB(B0, 1, 0); PG8_LDB(B1, 1, 1); PG8_SCHED; PG8_LDA(At, 1, 0); PG8_STAGE_A(0, 1, a2);
            PG8_WAIT_V(8); PG8_WAIT_L(0); PG8_BAR; PG8_MMA(0, 0, At, B0); if constexpr (PROBE != 1) PG8_MMA(0, 1, At, B1); PG8_BAR; PG8_SCHED;
            PG8_LDA(At, 1, 1); PG8_STAGE(PG8_SB(1, 0), b3, voffB); PG8_STAGE(PG8_SB(1, 1), b3 + hstep, voffB); PG8_STAGE_A(1, 0, a3);
            PG8_WAIT_V(8); PG8_WAIT_L(0); PG8_BAR; PG8_MMA(1, 0, At, B0); if constexpr (PROBE != 1) PG8_MMA(1, 1, At, B1); PG8_BAR; PG8_SCHED;
        }
        if constexpr (STAMP) { const unsigned long long n_ = __builtin_amdgcn_s_memrealtime(); st_k += n_ - st_t; st_t = n_; }
        if constexpr (ALIGN_EPI) { if (wr == 0) PG8_BAR; }
        bool keep = false;
        if constexpr (Epi::HAS_MID) { if (cur.nvalid == 1) { E.mid(acc, cur, wr, wc, fr, fq); keep = true; } else { E(acc, cur, wr, wc, fr, fq); } } else { E(acc, cur, wr, wc, fr, fq); }
        if constexpr (STAMP) { const unsigned long long n_ = __builtin_amdgcn_s_memrealtime(); st_e += n_ - st_t; }
        if (!has_next) break;
        if (!keep) {
#pragma unroll
        for (int a = 0; a < 2; ++a)
#pragma unroll
            for (int b = 0; b < 2; ++b)
#pragma unroll
                for (int m = 0; m < 4; ++m)
#pragma unroll
                    for (int n = 0; n < 2; ++n) acc[a][b][m][n] = (f32x4){0.f, 0.f, 0.f, 0.f};
        }
        cur = nxt; cA = nA; cB = nB; ++ui;
        if constexpr (ALIGN_EPI) { if (wr == 1) PG8_BAR; }
    }
    PG8_WAIT_V(0);
    if constexpr (!ALIGN_EPI) { if (wr == 0) PG8_BAR; }
    PG8_BAR;
    if constexpr (STAMP) { if (blockIdx.x == STAMP - 1 && threadIdx.x == 0 && dbg) { dbg[0] = __builtin_amdgcn_s_memrealtime() - st_all; dbg[1] = st_k; dbg[2] = st_e; dbg[3] = (unsigned long long)(ui + 1); } }
#undef PG8_SA
#undef PG8_SB
#undef PG8_STAGE
#undef PG8_STAGE_A
#undef PG8_GOFF
#undef PG8_LDA
#undef PG8_LDB
#undef PG8_MMA
#undef PG8_LD8
#undef PG8_WAIT_V
#undef PG8_WAIT_VX
#undef PG8_WAIT_L
#undef PG8_BAR
#undef PG8_SCHED
}
}

constexpr int NWAVES = 8;
constexpr int LDS_BYTES = 163840;
constexpr int LDSCTL_OFF = 162816;
constexpr int MISC_OFF = LDSCTL_OFF;
constexpr int CW_BAR = 4096;
constexpr int CW_CNT = 64;
constexpr size_t CTL_ZERO_BYTES = 64 * 1024;

#define GAS __attribute__((address_space(1)))
#define LAS __attribute__((address_space(3)))
typedef unsigned v4u __attribute__((ext_vector_type(4)));
typedef float f32x4 __attribute__((ext_vector_type(4)));
typedef short bf16x8 __attribute__((ext_vector_type(8)));
typedef GAS unsigned gu32;
#define RLX_AGENT __ATOMIC_RELAXED, __HIP_MEMORY_SCOPE_AGENT
#define LDS_WAIT() asm volatile("s_waitcnt lgkmcnt(0)" ::: "memory")
#define VM_WAIT() asm volatile("s_waitcnt vmcnt(0)" ::: "memory")
__device__ __forceinline__ unsigned pk2(float lo, float hi) { return cvtpk_s(lo, hi); }
__device__ __forceinline__ float fsigm(float x) { return __builtin_amdgcn_rcpf(1.f + __expf(-x)); }

#define XB_TMO      128
#define XB_XCNT(j)  (256  + 64 * (j))
#define XB_XSUB(j)  (1280 + 64 * (j))
#define XB_XGEN(j)  (2304 + 64 * (j))
#define XB_TOP      3328
#define XB_TOPGEN   3392
#define XCD_BAR_WORDS 3456
#define XB_SPIN_CAP (1u << 18)

__device__ __forceinline__ unsigned xb_ld(unsigned* p)              { return __hip_atomic_load(p, __ATOMIC_RELAXED, __HIP_MEMORY_SCOPE_AGENT); }
__device__ __forceinline__ unsigned xb_add(unsigned* p, unsigned v) { return __hip_atomic_fetch_add(p, v, __ATOMIC_RELAXED, __HIP_MEMORY_SCOPE_AGENT); }
__device__ __forceinline__ unsigned xb_xcc_id() { return (unsigned)__builtin_amdgcn_s_getreg((3 << 11) | 20) & 0xFu; }
#define XB_SPIN(cond, bar) do { unsigned _sp = 0; while (cond) { __builtin_amdgcn_s_sleep(1); \
    if ((++_sp & 255u) == 0u) { if (xb_ld(&(bar)[XB_TMO])) break; if (_sp > XB_SPIN_CAP) { atomicAdd(&(bar)[XB_TMO], 1u); break; } } } } while (0)

struct XcdBarrier {
    unsigned* bar; unsigned x;
    volatile LAS unsigned* st;
};

__device__ __forceinline__ XcdBarrier xcd_barrier_post(unsigned* bar, volatile LAS unsigned* st) {
    XcdBarrier b; b.bar = bar; b.x = xb_xcc_id(); b.st = st;
    if (threadIdx.x == 0) (void)xb_add(&bar[XB_XCNT(b.x)], 1u);
    return b;
}
__device__ __forceinline__ void xcd_barrier_complete(unsigned* bar, unsigned x, unsigned& nloc, unsigned& nx) {
    const unsigned G = gridDim.x * gridDim.y * gridDim.z;
    unsigned sum, cnt, mine, sp = 0u;
    for (;;) {
        sum = 0u; cnt = 0u; mine = 0u;
#pragma unroll
        for (unsigned j = 0; j < 16; ++j) { const unsigned c = xb_ld(&bar[XB_XCNT(j)]); sum += c; cnt += (c > 0u) ? 1u : 0u; mine = (j == x) ? c : mine; }
        if (sum == G) break;
        __builtin_amdgcn_s_sleep(1);
        if ((++sp & 255u) == 0u) { if (xb_ld(&bar[XB_TMO])) break; if (sp > XB_SPIN_CAP) { atomicAdd(&bar[XB_TMO], 1u); break; } }
    }
    nloc = mine > 0u ? mine : 1u; nx = cnt > 0u ? cnt : 1u;
}

__device__ __forceinline__ void xcd_barrier(const XcdBarrier& b) {
    asm volatile("s_waitcnt vmcnt(0)" ::: "memory");
    __syncthreads();
    if (threadIdx.x == 0) {
        unsigned* bar = b.bar;
        __builtin_amdgcn_s_waitcnt(0);
        unsigned nloc = b.st[0], nx = b.st[1];
        if (nloc == 0u) { xcd_barrier_complete(bar, b.x, nloc, nx); b.st[0] = nloc; b.st[1] = nx; }
        const unsigned old = xb_add(&bar[XB_XSUB(b.x)], 1u);
        const unsigned gen = old / nloc;
        if (old + 1u == (gen + 1u) * nloc) {
            __builtin_amdgcn_fence(__ATOMIC_RELEASE, "agent");
            asm volatile("s_waitcnt vmcnt(0)" ::: "memory");
            const unsigned og = xb_add(&bar[XB_TOP], 1u);
            const unsigned tg = og / nx;
            if (og + 1u == (tg + 1u) * nx) xb_add(&bar[XB_TOPGEN], 1u);
            else XB_SPIN(xb_ld(&bar[XB_TOPGEN]) == tg, bar);
            __builtin_amdgcn_fence(__ATOMIC_ACQUIRE, "agent");
            xb_add(&bar[XB_XGEN(b.x)], 1u);
            asm volatile("s_waitcnt vmcnt(0)" ::: "memory");
        } else {
            XB_SPIN(xb_ld(&bar[XB_XGEN(b.x)]) == gen, bar);
            __builtin_amdgcn_fence(__ATOMIC_ACQUIRE, "agent");
            asm volatile("s_waitcnt vmcnt(0)" ::: "memory");
        }
    }
    __syncthreads();
}

__device__ __forceinline__ const void* inptr(int k) { const __attribute__((address_space(4))) char* ka = (const __attribute__((address_space(4))) char*)__builtin_amdgcn_kernarg_segment_ptr(); asm volatile("" : "+s"(ka)); return (const void*)(*(const __attribute__((address_space(4))) unsigned long long*)(ka + 8 * k)); }
struct Frame {
    LAS unsigned char* lds; volatile LAS unsigned* MISC; gu32* ctl; int tid, lane, wave, G;
    float* out; unsigned char* ws;
    __device__ __forceinline__ const float* x() const { return (const float*)inptr(0); }
    __device__ __forceinline__ const float* c() const { return (const float*)inptr(1); }
    __device__ __forceinline__ const int* pos() const { return (const int*)inptr(2); }
    __device__ __forceinline__ const float* w_ada() const { return (const float*)inptr(3); }
    __device__ __forceinline__ const float* b_ada() const { return (const float*)inptr(4); }
    __device__ __forceinline__ const float* n1g() const { return (const float*)inptr(5); }
    __device__ __forceinline__ const float* w_in() const { return (const float*)inptr(6); }
    __device__ __forceinline__ const float* lbl() const { return (const float*)inptr(7); }
    __device__ __forceinline__ const float* hgg() const { return (const float*)inptr(8); }
    __device__ __forceinline__ const float* w_hg() const { return (const float*)inptr(9); }
    __device__ __forceinline__ const float* qg() const { return (const float*)inptr(10); }
    __device__ __forceinline__ const float* kg() const { return (const float*)inptr(11); }
    __device__ __forceinline__ const float* sinks() const { return (const float*)inptr(12); }
    __device__ __forceinline__ const float* w_att() const { return (const float*)inptr(13); }
    __device__ __forceinline__ const float* w_out() const { return (const float*)inptr(14); }
    __device__ __forceinline__ const float* n2g() const { return (const float*)inptr(15); }
    __device__ __forceinline__ const float* w_r() const { return (const float*)inptr(16); }
    __device__ __forceinline__ const float* b_r() const { return (const float*)inptr(17); }
    __device__ __forceinline__ const float* w_up() const { return (const float*)inptr(18); }
    __device__ __forceinline__ const float* b_up() const { return (const float*)inptr(19); }
    __device__ __forceinline__ const float* w_dn() const { return (const float*)inptr(20); }
    __device__ __forceinline__ const float* b_dn() const { return (const float*)inptr(21); }
};
__device__ __forceinline__ int up_vrow(int c) { const int o = c >> 1; return 256 * (o >> 7) + 128 * (c & 1) + (o & 127); }

template <int MAP> __device__ __forceinline__ void p0_item(const float* W, int K, int N, bf16* WT, LAS float* scr, int kb, int nb, int lane) {
    const int k0 = 64 * kb, n0 = 64 * nb;
#pragma unroll 4
    for (int i = 0; i < 16; ++i) { const int kk = 4 * i + (lane >> 4); const f32x4 v = *(const GAS f32x4*)(W + (size_t)(k0 + kk) * N + n0 + 4 * (lane & 15));
        LAS float* d = scr + kk * 65 + 4 * (lane & 15); d[0] = v.x; d[1] = v.y; d[2] = v.z; d[3] = v.w; }
    LDS_WAIT(); asm volatile("" ::: "memory");
    const int c = lane >> 3;
#pragma unroll
    for (int j = 0; j < 8; ++j) { const int n = (lane & 7) + 8 * j; const LAS float* s = scr + (8 * c) * 65 + n;
        v4u o; o.x = pk2(s[0], s[65]); o.y = pk2(s[130], s[195]); o.z = pk2(s[260], s[325]); o.w = pk2(s[390], s[455]);
        const int col = n0 + n, row = MAP ? up_vrow(col) : col;
        *(GAS v4u*)(WT + (size_t)row * K + k0 + 8 * c) = o; }
    LDS_WAIT(); asm volatile("" ::: "memory");
}
__device__ __forceinline__ unsigned pk4_fp8(float a, float b, float c, float d) { int w = 0; w = __builtin_amdgcn_cvt_pk_fp8_f32(a, b, w, false); w = __builtin_amdgcn_cvt_pk_fp8_f32(c, d, w, true); return (unsigned)w; }
constexpr float W8_SCALE = 32.f, W8_INV = 1.f / 32.f;
template <int MAP> __device__ __forceinline__ void p0_item8(const float* W, int K, int N, unsigned char* WT, LAS float* scr, int kb, int nb, int lane) {
    const int k0 = 64 * kb, n0 = 64 * nb;
#pragma unroll 4
    for (int i = 0; i < 16; ++i) { const int kk = 4 * i + (lane >> 4); const f32x4 v = __builtin_nontemporal_load((const GAS f32x4*)(W + (size_t)(k0 + kk) * N + n0 + 4 * (lane & 15)));
        LAS float* d = scr + kk * 65 + 4 * (lane & 15); d[0] = v.x; d[1] = v.y; d[2] = v.z; d[3] = v.w; }
    LDS_WAIT(); asm volatile("" ::: "memory");
    const int c = lane >> 4;
#pragma unroll
    for (int j = 0; j < 4; ++j) { const int n = (lane & 15) + 16 * j; const LAS float* s = scr + (16 * c) * 65 + n;
        v4u o; o.x = pk4_fp8(s[0] * W8_SCALE, s[65] * W8_SCALE, s[130] * W8_SCALE, s[195] * W8_SCALE); o.y = pk4_fp8(s[260] * W8_SCALE, s[325] * W8_SCALE, s[390] * W8_SCALE, s[455] * W8_SCALE);
        o.z = pk4_fp8(s[520] * W8_SCALE, s[585] * W8_SCALE, s[650] * W8_SCALE, s[715] * W8_SCALE); o.w = pk4_fp8(s[780] * W8_SCALE, s[845] * W8_SCALE, s[910] * W8_SCALE, s[975] * W8_SCALE);
        const int col = n0 + n, row = MAP ? up_vrow(col) : col;
        *(GAS v4u*)(WT + (size_t)row * K + k0 + 16 * c) = o; }
    LDS_WAIT(); asm volatile("" ::: "memory");
}
__device__ __forceinline__ void p0_mod(Frame& F) {
    LAS float* cT = (LAS float*)F.lds;
    LAS float* red = (LAS float*)(F.lds + 69632);
    const int wg = blockIdx.x;
    for (int i = F.tid; i < 16 * 1024; i += 512) { const int b = i >> 10, k = i & 1023; cT[k * 16 + (k >> 4) * 4 + b] = silu_f(F.c()[i]); }
    __syncthreads();
    const int ks = F.tid >> 3, c4 = F.tid & 7, col = wg * 32 + 4 * c4;
    float acc[16][4];
#pragma unroll
    for (int b = 0; b < 16; ++b)
#pragma unroll
        for (int j = 0; j < 4; ++j) acc[b][j] = 0.f;
#pragma unroll 4
    for (int r = 0; r < 16; ++r) {
        const int k = ks * 16 + r; const f32x4 w = *(const GAS f32x4*)(F.w_ada() + (size_t)k * 6144 + col);
        const LAS f32x4* cp = (const LAS f32x4*)(cT + k * 16 + (k >> 4) * 4);
#pragma unroll
        for (int q = 0; q < 4; ++q) { const f32x4 cv = cp[q];
#pragma unroll
            for (int j = 0; j < 4; ++j) { acc[4 * q + j][0] += cv[j] * w.x; acc[4 * q + j][1] += cv[j] * w.y; acc[4 * q + j][2] += cv[j] * w.z; acc[4 * q + j][3] += cv[j] * w.w; } }
    }
#pragma unroll
    for (int b = 0; b < 16; ++b)
#pragma unroll
        for (int j = 0; j < 4; ++j) { float v = acc[b][j]; v += __shfl_xor(v, 8); v += __shfl_xor(v, 16); v += __shfl_xor(v, 32); acc[b][j] = v; }
    if (F.lane < 8) {
#pragma unroll
        for (int b = 0; b < 16; ++b)
#pragma unroll
            for (int j = 0; j < 4; ++j) red[(F.wave * 16 + b) * 32 + 4 * c4 + j] = acc[b][j];
    }
    __syncthreads();
    { const int b = F.tid >> 5, cc = F.tid & 31; float s = 0.f;
#pragma unroll
      for (int w = 0; w < 8; ++w) s += red[(w * 16 + b) * 32 + cc];
      ((float*)(F.ws + WS_MOD))[b * 6144 + wg * 32 + cc] = s + F.b_ada()[wg * 32 + cc]; }
    __syncthreads();
}
__device__ __forceinline__ void p0_prologue(Frame& F) {
    if (blockIdx.x < 192) p0_mod(F);
    else {
        const int i = ((int)blockIdx.x - 192) * 512 + F.tid;
        float* BUPP = (float*)(F.ws + WS_BUPP);
#pragma unroll
        for (int q = 0; q < 2; ++q) { const int idx = i * 2 + q, e = idx >> 11, c = idx & 2047; BUPP[e * 2048 + up_vrow(c)] = F.b_up()[idx]; }
        if (i < 512) ((float*)(F.ws + WS_LB))[i] = 1.f / (1.f + __expf(F.lbl()[512 + i] - F.lbl()[i]));
        if (i >= 1024 && i < 1280) ((unsigned*)(F.ws + WS_H2))[(size_t)T * 256 + (i - 1024)] = 0u;
        if (i >= 2048 && i < 2304) ((int*)(F.ws + WS_IDT))[i - 2048] = (i - 2048) << 2;
    }
}
__device__ __forceinline__ void dense_weight_copies(Frame& F) {
    LAS float* scr = (LAS float*)(F.lds + F.wave * 16640);
    const int gw = (int)blockIdx.x * NWAVES + F.wave, NGW = F.G * NWAVES;
    constexpr int I_IN = 16 * 76, I_HG = 8 * 16, I_OUT = 16 * 16;
    constexpr int NITEMS = I_IN + 2 * I_HG + I_OUT;
    for (int it = gw; it < NITEMS; it += NGW) {
        int r = it;
        if (r < I_IN) { p0_item8<0>(F.w_in(), 1024, INW, F.ws + WS_WIN, scr, r / 76, r % 76, F.lane); continue; } r -= I_IN;
        if (r < I_HG) { p0_item8<0>(F.w_hg(), 512, 1024, F.ws + WS_WHG, scr, r / 16, r % 16, F.lane); continue; } r -= I_HG;
        if (r < I_HG) { p0_item8<0>(F.w_att(), 512, 1024, F.ws + WS_WATT, scr, r / 16, r % 16, F.lane); continue; } r -= I_HG;
        p0_item8<0>(F.w_out(), 1024, 1024, F.ws + WS_WOUT, scr, r / 16, r % 16, F.lane);
    }
}
__device__ __forceinline__ void moe_weight_copies(Frame& F, int gw, int NGW) {
    LAS float* scr = (LAS float*)(F.lds + F.wave * 16640);
    constexpr int I_UP = 16 * 32, I_DN = 16 * 16;
    for (int it = gw; it < 32 * (I_UP + I_DN); it += NGW) {
        int r = it;
        if (r < 32 * I_UP) { const int e = r / I_UP, q = r % I_UP; p0_item8<1>(F.w_up() + (size_t)e * 1024 * 2048, 1024, 2048, F.ws + WS_WUP + (size_t)e * 2048 * 1024, scr, q / 32, q % 32, F.lane); continue; } r -= 32 * I_UP;
        { const int e = r / I_DN, q = r % I_DN; p0_item8<0>(F.w_dn() + (size_t)e * 1024 * 1024, 1024, 1024, F.ws + WS_WDN + (size_t)e * 1024 * 1024, scr, q / 16, q % 16, F.lane); }
    }
}
__device__ __forceinline__ void normmod_row8(const float* xrow, const float* gain, const float* sh, const float* sc, unsigned char* orow, int lane) {
    const GAS f32x4* xr = (const GAS f32x4*)xrow + lane;
    f32x4 v[4]; float s = 0.f;
#pragma unroll
    for (int j = 0; j < 4; ++j) { v[j] = xr[64 * j]; s += (v[j].x * v[j].x + v[j].y * v[j].y) + (v[j].z * v[j].z + v[j].w * v[j].w); }
    const float rstd = rsqrtf(wave_sum(s) * (1.f / DM) + EPS);
#pragma unroll
    for (int j = 0; j < 4; ++j) {
        const int c = 4 * lane + 256 * j;
        const f32x4 g = *(const GAS f32x4*)(gain + c), a = *(const GAS f32x4*)(sc + c), b = *(const GAS f32x4*)(sh + c);
        *(GAS unsigned*)(orow + c) = pk4_fp8(v[j].x * rstd * g.x * (1.f + a.x) + b.x, v[j].y * rstd * g.y * (1.f + a.y) + b.y, v[j].z * rstd * g.z * (1.f + a.z) + b.z, v[j].w * rstd * g.w * (1.f + a.w) + b.w);
    }
}
__device__ __forceinline__ void p1_xn(Frame& F) {
    const int gw = (int)blockIdx.x * NWAVES + F.wave, NGW = F.G * NWAVES; const float* MOD = (const float*)(F.ws + WS_MOD); unsigned char* XN = F.ws + WS_XN;
    for (int m = gw; m < T; m += NGW) { const float* mb = MOD + (size_t)(m / SEQ) * 6144; normmod_row8(F.x() + (size_t)m * DM, F.n1g(), mb, mb + 1024, XN + (size_t)m * DM, F.lane); }
}

typedef float f32x2 __attribute__((ext_vector_type(2)));
__device__ __forceinline__ f32x2 ex2_2(f32x2 t) { return (f32x2){__builtin_amdgcn_exp2f(t.x), __builtin_amdgcn_exp2f(t.y)}; }
__device__ __forceinline__ f32x2 rcp_2(f32x2 t) { return (f32x2){__builtin_amdgcn_rcpf(t.x), __builtin_amdgcn_rcpf(t.y)}; }
__device__ __forceinline__ f32x2 sigm_2(f32x2 x) { return rcp_2(ex2_2(x * (-1.4426950408889634f)) + 1.0f); }
__device__ __forceinline__ f32x2 swiglu_2(f32x2 g, f32x2 l) {
    const f32x2 ga = {fminf(g.x, 7.f), fminf(g.y, 7.f)}, la = {__builtin_amdgcn_fmed3f(l.x, -7.f, 7.f), __builtin_amdgcn_fmed3f(l.y, -7.f, 7.f)};
    return (ga * rcp_2(ex2_2(ga * (-1.702f * 1.4426950408889634f)) + 1.0f)) * (la + 1.0f);
}
__device__ __forceinline__ v4u pair16(unsigned long long a, unsigned long long b, bool odd) {
    const unsigned long long send = odd ? a : b;
    const unsigned rlo = (unsigned)__shfl_xor((int)(unsigned)send, 16), rhi = (unsigned)__shfl_xor((int)(unsigned)(send >> 32), 16);
    return odd ? (v4u){rlo, rhi, (unsigned)b, (unsigned)(b >> 32)} : (v4u){(unsigned)a, (unsigned)(a >> 32), rlo, rhi};
}
__device__ __forceinline__ float bflo(unsigned u) { return __uint_as_float(u << 16); }
__device__ __forceinline__ float bfhi(unsigned u) { return __uint_as_float(u & 0xffff0000u); }
struct EpiIn {
    static constexpr bool PERM = true, HAS_MID = false; static constexpr int NST = 0; unsigned char* ws;
    __device__ __forceinline__ void operator()(const f32x4 (&acc)[2][2][4][2], const pg8::Unit& u, int wr, int wc, int fr, int fq) const {
        const int pn = u.pn, row0 = u.pm * 256 + wr * 64 + fr, cl = wc * 32 + 8 * fq;
        if (pn == 2 || pn == 3) {
            bf16* LF = (bf16*)(ws + WS_LF); const float* LB = (const float*)(ws + WS_LB); const int cb = (pn - 2) * 256;
#pragma unroll
            for (int bj = 0; bj < 2; ++bj) { const int col = cb + 128 * bj + cl; const f32x4 l0 = *(const f32x4*)(LB + col), l1 = *(const f32x4*)(LB + col + 4);
#pragma unroll
                for (int ai = 0; ai < 2; ++ai)
#pragma unroll
                    for (int m = 0; m < 4; ++m) { bf16* rp = LF + (size_t)(row0 + 128 * ai + 16 * m) * 512 + col; const f32x4 v0 = acc[ai][bj][m][0] * W8_INV, v1 = acc[ai][bj][m][1] * W8_INV; f32x4 o0, o1;
                        { const f32x2 s0 = sigm_2((f32x2){v0[0], v0[1]}), s1 = sigm_2((f32x2){v0[2], v0[3]}), s2 = sigm_2((f32x2){v1[0], v1[1]}), s3 = sigm_2((f32x2){v1[2], v1[3]});
                          const f32x4 sa = {s0.x, s0.y, s1.x, s1.y}, sb = {s2.x, s2.y, s3.x, s3.y}; const f32x4 fa = l0 + (1.0f - l0) * sa, fb = l1 + (1.0f - l1) * sb;
#pragma unroll
                          for (int j = 0; j < 4; ++j) { o0[j] = __builtin_amdgcn_logf(fa[j]) * 0.6931471805599453f; o1[j] = __builtin_amdgcn_logf(fb[j]) * 0.6931471805599453f; } }
                        v4u w; w.x = pg8::cvt_pk_bf16(o0[0], o0[1]); w.y = pg8::cvt_pk_bf16(o0[2], o0[3]); w.z = pg8::cvt_pk_bf16(o1[0], o1[1]); w.w = pg8::cvt_pk_bf16(o1[2], o1[3]); *(v4u*)rp = w; } }
            return;
        }
        bf16* dst; int ld = 512, cb, act = 0;
        if (pn < 2) { dst = (bf16*)(ws + WS_QH); cb = pn * 256; act = 1; }
        else if (pn < 6) { dst = (bf16*)(ws + WS_VH); cb = (pn - 4) * 256; }
        else if (pn < 8) { dst = (bf16*)(ws + WS_GH); cb = (pn - 6) * 256; act = 1; }
        else if (pn < 10) { dst = (bf16*)(ws + WS_AQ); cb = (pn - 8) * 256; }
        else if (pn == 10) { dst = (bf16*)(ws + WS_AKV); cb = 0; ld = 256; }
        else if (pn < 15) { dst = (bf16*)(ws + WS_SGH); cb = (pn - 11) * 256; ld = 1024; act = 2; }
        else { dst = (bf16*)(ws + WS_SGA); cb = (pn - 15) * 256; ld = 1024; act = 2; }
#pragma unroll
        for (int ai = 0; ai < 2; ++ai)
#pragma unroll
            for (int m = 0; m < 4; ++m) { bf16* rp = dst + (size_t)(row0 + 128 * ai + 16 * m) * ld + cb + cl;
#pragma unroll
                for (int bj = 0; bj < 2; ++bj) { f32x4 v0 = acc[ai][bj][m][0] * W8_INV, v1 = acc[ai][bj][m][1] * W8_INV;
                    if (act != 0) {
                        const f32x2 a0 = {v0[0], v0[1]}, a1 = {v0[2], v0[3]}, a2 = {v1[0], v1[1]}, a3 = {v1[2], v1[3]};
                        f32x2 s0 = sigm_2(a0), s1 = sigm_2(a1), s2 = sigm_2(a2), s3 = sigm_2(a3);
                        if (act == 1) { s0 = s0 * a0; s1 = s1 * a1; s2 = s2 * a2; s3 = s3 * a3; }
                        v0 = (f32x4){s0.x, s0.y, s1.x, s1.y}; v1 = (f32x4){s2.x, s2.y, s3.x, s3.y}; }
                    v4u w; w.x = pg8::cvt_pk_bf16(v0[0], v0[1]); w.y = pg8::cvt_pk_bf16(v0[2], v0[3]); w.z = pg8::cvt_pk_bf16(v1[0], v1[1]); w.w = pg8::cvt_pk_bf16(v1[2], v1[3]);
                    *(v4u*)(rp + 128 * bj) = w; } }
    }
};
struct PairOrder {
    pg8::StaticOrder S;
    __device__ __forceinline__ bool next(int i, pg8::Unit& u) const { if (!S.next(i >> 1, u)) return false; const int hf = i & 1; u.pn += 8 * hf; u.abase += 512u * (unsigned)hf; u.nvalid = hf ? 0 : 1; return true; }
};
struct EpiMrg {
    static constexpr bool PERM = true, HAS_MID = true; static constexpr int NST = 0; unsigned char* MRG; const bf16* SGH; const bf16* SGA;
    __device__ __forceinline__ void mid(f32x4 (&acc)[2][2][4][2], const pg8::Unit& u, int wr, int wc, int fr, int fq) const {
        const int row0 = u.pm * 256 + wr * 64 + fr, col0 = (u.pn & 3) * 256 + wc * 32 + 8 * fq;
#pragma unroll
        for (int ai = 0; ai < 2; ++ai)
#pragma unroll
            for (int m = 0; m < 4; ++m) { const size_t off = (size_t)(row0 + 128 * ai + 16 * m) * 1024 + col0;
#pragma unroll
                for (int bj = 0; bj < 2; ++bj) { const v4u h = *(const v4u*)(SGH + off + 128 * bj), a = *(const v4u*)(SGA + off + 128 * bj);
                    const f32x4 r0 = {bflo(h.x) * __builtin_amdgcn_rcpf(bflo(a.x)), bfhi(h.x) * __builtin_amdgcn_rcpf(bfhi(a.x)), bflo(h.y) * __builtin_amdgcn_rcpf(bflo(a.y)), bfhi(h.y) * __builtin_amdgcn_rcpf(bfhi(a.y))};
                    const f32x4 r1 = {bflo(h.z) * __builtin_amdgcn_rcpf(bflo(a.z)), bfhi(h.z) * __builtin_amdgcn_rcpf(bfhi(a.z)), bflo(h.w) * __builtin_amdgcn_rcpf(bflo(a.w)), bfhi(h.w) * __builtin_amdgcn_rcpf(bfhi(a.w))};
                    acc[ai][bj][m][0] *= r0; acc[ai][bj][m][1] *= r1; }
                asm volatile("" ::: "memory"); }
    }
    __device__ __forceinline__ void operator()(const f32x4 (&acc)[2][2][4][2], const pg8::Unit& u, int wr, int wc, int fr, int fq) const {
        const int row0 = u.pm * 256 + wr * 64 + fr, col0 = (u.pn & 3) * 256 + wc * 32 + 8 * fq;
#pragma unroll
        for (int ai = 0; ai < 2; ++ai)
#pragma unroll
            for (int m = 0; m < 4; ++m) { const size_t off = (size_t)(row0 + 128 * ai + 16 * m) * 1024 + col0;
                unsigned long long w[2];
#pragma unroll
                for (int bj = 0; bj < 2; ++bj) { const v4u s = *(const v4u*)(SGA + off + 128 * bj); const f32x4 v0 = acc[ai][bj][m][0] * W8_INV, v1 = acc[ai][bj][m][1] * W8_INV;
                    w[bj] = (unsigned long long)pk4_fp8(bflo(s.x) * v0[0], bfhi(s.x) * v0[1], bflo(s.y) * v0[2], bfhi(s.y) * v0[3]) | ((unsigned long long)pk4_fp8(bflo(s.z) * v1[0], bfhi(s.z) * v1[1], bflo(s.w) * v1[2], bfhi(s.w) * v1[3]) << 32); }
                *(v4u*)(MRG + off + ((fq & 1) ? 120 : 0)) = pair16(w[0], w[1], (fq & 1) != 0); }
    }
};
struct EpiOut {
    static constexpr bool PERM = true, HAS_MID = false; static constexpr int NST = 0; const float* x; const float* MOD; bf16* X1B; int skip;
    __device__ __forceinline__ void operator()(const f32x4 (&acc)[2][2][4][2], const pg8::Unit& u, int wr, int wc, int fr, int fq) const {
        if (skip) { if (acc[0][0][0][0][0] == 12345.678f) X1B[0] = 1; return; }
        const int row0 = u.pm * 256 + wr * 64 + fr, col0 = u.pn * 256 + wc * 32 + 8 * fq; const float* g1 = MOD + (size_t)(u.pm >> 3) * 6144 + 2048;
        f32x4 gv[2][2];
#pragma unroll
        for (int bj = 0; bj < 2; ++bj)
#pragma unroll
            for (int n = 0; n < 2; ++n) gv[bj][n] = *(const f32x4*)(g1 + col0 + 128 * bj + 4 * n) * W8_INV;
#pragma unroll
        for (int ai = 0; ai < 2; ++ai)
#pragma unroll
            for (int m = 0; m < 4; ++m) { const size_t off = (size_t)(row0 + 128 * ai + 16 * m) * 1024 + col0;
#pragma unroll
                for (int bj = 0; bj < 2; ++bj) { const f32x4 v0 = *(const f32x4*)(x + off + 128 * bj) + gv[bj][0] * acc[ai][bj][m][0], v1 = *(const f32x4*)(x + off + 128 * bj + 4) + gv[bj][1] * acc[ai][bj][m][1];
                    v4u w; w.x = pg8::cvt_pk_bf16(v0[0], v0[1]); w.y = pg8::cvt_pk_bf16(v0[2], v0[3]); w.z = pg8::cvt_pk_bf16(v1[0], v1[1]); w.w = pg8::cvt_pk_bf16(v1[2], v1[3]);
                    *(v4u*)(X1B + off + 128 * bj) = w; } }
    }
};

typedef float f32x16 __attribute__((ext_vector_type(16)));
constexpr int RT_PITCH = 2064;
constexpr int R_TILE = 0, R_PART = 66048, R_LOG = 99840, R_REC = 104064, R_HIST = 112256;
__device__ __forceinline__ void p6_route(Frame& F, int dry) {
    const float* MOD = (const float*)(F.ws + WS_MOD); unsigned* H2 = (unsigned*)(F.ws + WS_H2);
    int* TOKL = (int*)(F.ws + (dry ? WS_TMP : WS_TOKL)); int* SLOT = (int*)(F.ws + (dry ? WS_TMP + 8 * MiB : WS_GATL)); const int cw = dry ? 8192 : CW_CNT; int* TOPI = (int*)(F.ws + WS_TOPI); float* TOPW = (float*)(F.ws + WS_TOPW);
    LAS float* PART = (LAS float*)(F.lds + R_PART); LAS float* LOG = (LAS float*)(F.lds + R_LOG);
    LAS int* REC_E = (LAS int*)(F.lds + R_REC); LAS int* REC_TK = REC_E + 512; LAS float* REC_G = (LAS float*)(REC_E + 1024); LAS int* REC_RK = REC_E + 1536;
    LAS int* HIST = (LAS int*)(F.lds + R_HIST); LAS int* BASE = HIST + 32;
    const int lane = F.lane, wave = F.wave, r32 = lane & 31, hi = lane >> 5;
    bf16x8 wB[8];
#pragma unroll
    for (int s = 0; s < 8; ++s) { const int k0 = 128 * wave + 16 * s + 8 * hi; unsigned p[4];
#pragma unroll
        for (int j = 0; j < 4; ++j) p[j] = pk2(F.w_r()[(size_t)(k0 + 2 * j) * 32 + r32], F.w_r()[(size_t)(k0 + 2 * j + 1) * 32 + r32]);
        v4u q = {p[0], p[1], p[2], p[3]}; wB[s] = __builtin_bit_cast(bf16x8, q); }
    if (F.tid < 32) HIST[F.tid] = 0;
    __syncthreads();
    const bf16* X1B = (const bf16*)(F.ws + WS_X1B);
    for (int tb = (int)blockIdx.x * 4; tb < T / 32; tb += F.G * 4) {
        const int ntile = (T / 32 - tb) < 4 ? (T / 32 - tb) : 4;
        f32x4 cm[4], ca[4];
        { const float* mb = MOD + (size_t)((tb * 32) / SEQ) * 6144;
#pragma unroll
          for (int j = 0; j < 4; ++j) { const int c = 4 * lane + 256 * j; const f32x4 g = *(const GAS f32x4*)(F.n2g() + c), a = *(const GAS f32x4*)(mb + 4096 + c); cm[j] = g * (1.0f + a); ca[j] = *(const GAS f32x4*)(mb + 3072 + c); } }
        unsigned long long xw[4][4];
#define P6_LOAD(tl_) do { _Pragma("unroll") for (int rr = 0; rr < 4; ++rr) { const GAS unsigned long long* xr = (const GAS unsigned long long*)(X1B + (size_t)((tb + (tl_)) * 32 + 4 * wave + rr) * DM) + lane; \
        _Pragma("unroll") for (int j = 0; j < 4; ++j) xw[rr][j] = xr[64 * j]; } } while (0)
        P6_LOAD(0);
        for (int tl = 0; tl < ntile; ++tl) {
            const int t0 = (tb + tl) * 32;
#pragma unroll
            for (int rr = 0; rr < 4; ++rr) {
                const int row = t0 + 4 * wave + rr;
                f32x4 v[4]; float s = 0.f;
#pragma unroll
                for (int j = 0; j < 4; ++j) { const unsigned xl = (unsigned)xw[rr][j], xh = (unsigned)(xw[rr][j] >> 32); v[j] = (f32x4){bflo(xl), bfhi(xl), bflo(xh), bfhi(xh)}; s += (v[j].x * v[j].x + v[j].y * v[j].y) + (v[j].z * v[j].z + v[j].w * v[j].w); }
                const float rstd = rsqrtf(wave_sum(s) * (1.f / DM) + EPS);
#pragma unroll
                for (int j = 0; j < 4; ++j) {
                    const int c = 4 * lane + 256 * j;
                    const f32x4 hv = v[j] * rstd * cm[j] + ca[j];
                    const unsigned lo = pk2(hv.x, hv.y), hh = pk2(hv.z, hv.w);
                    *(GAS unsigned*)(H2 + (size_t)row * 256 + (c >> 2)) = pk4_fp8(hv.x, hv.y, hv.z, hv.w);
                    *(LAS unsigned long long*)(F.lds + R_TILE + (4 * wave + rr) * RT_PITCH + c * 2) = (unsigned long long)lo | ((unsigned long long)hh << 32);
                }
            }
            if (tl + 1 < ntile) P6_LOAD(tl + 1);
            __syncthreads();
            f32x16 acc = {};
#pragma unroll
            for (int s = 0; s < 8; ++s) { const bf16x8 af = *(const LAS bf16x8*)(F.lds + R_TILE + r32 * RT_PITCH + (128 * wave + 16 * s + 8 * hi) * 2);
                acc = __builtin_amdgcn_mfma_f32_32x32x16_bf16(af, wB[s], acc, 0, 0, 0); }
#pragma unroll
            for (int r = 0; r < 16; ++r) { const int tok = (r & 3) + 8 * (r >> 2) + 4 * hi; PART[(wave * 32 + tok) * 33 + r32] = acc[r]; }
            __syncthreads();
#pragma unroll
            for (int q = 0; q < 2; ++q) { const int idx = F.tid + 512 * q, tok = idx >> 5, e = idx & 31; float s = F.b_r()[e];
#pragma unroll
                for (int w = 0; w < 8; ++w) s += PART[(w * 32 + tok) * 33 + e];
                LOG[tok * 33 + e] = s; }
            __syncthreads();
            if (F.tid < 32) {
                float lg[32];
#pragma unroll
                for (int e = 0; e < 32; ++e) lg[e] = LOG[F.tid * 33 + e];
                unsigned used = 0u; float tv[4]; int ti[4];
#pragma unroll
                for (int k = 0; k < 4; ++k) { float best = -INFINITY; int bi = 0;
#pragma unroll
                    for (int e = 0; e < 32; ++e) { const bool ok = !((used >> e) & 1u) && lg[e] > best; best = ok ? lg[e] : best; bi = ok ? e : bi; }
                    used |= 1u << bi; tv[k] = best; ti[k] = bi; }
                const float e1 = __expf(tv[1] - tv[0]), e2 = __expf(tv[2] - tv[0]), e3 = __expf(tv[3] - tv[0]), inv = 1.f / (1.f + e1 + e2 + e3);
                const float gw[4] = {inv, e1 * inv, e2 * inv, e3 * inv};
                const int t = t0 + F.tid;
#pragma unroll
                for (int k = 0; k < 4; ++k) { const int slot = tl * 128 + F.tid * 4 + k; REC_E[slot] = ti[k]; REC_TK[slot] = t * 4 + k; REC_G[slot] = gw[k];
                    REC_RK[slot] = __hip_atomic_fetch_add(&HIST[ti[k]], 1, __ATOMIC_RELAXED, __HIP_MEMORY_SCOPE_WORKGROUP);
                    TOPI[t * 4 + k] = ti[k]; TOPW[t * 4 + k] = gw[k]; }
            }
        }
        __syncthreads();
        if (F.tid < 32) BASE[F.tid] = (int)__hip_atomic_fetch_add(F.ctl + cw + 64 * F.tid, (unsigned)HIST[F.tid], RLX_AGENT);
        __syncthreads();
        for (int slot = F.tid; slot < ntile * 128; slot += 512) { const int e = REC_E[slot], p = BASE[e] + REC_RK[slot]; const int tk = REC_TK[slot]; TOKL[(size_t)e * T + p] = tk; SLOT[tk] = (e << 16) | p; }
        __syncthreads();
        if (F.tid < 32) HIST[F.tid] = 0;
        __syncthreads();
    }
#undef P6_LOAD
}

__device__ __forceinline__ void moe_tables(Frame& F) {
    if (F.tid < 32) F.MISC[64 + F.tid] = __hip_atomic_load(F.ctl + CW_CNT + 64 * F.tid, RLX_AGENT);
    __syncthreads();
    if (F.tid == 0) { unsigned s = 0; for (int e = 0; e < 32; ++e) { F.MISC[16 + e] = s; s += (F.MISC[64 + e] + 255u) >> 8; } F.MISC[48] = s; }
    __syncthreads();
}
template <int NC> struct MoeOrder {
    volatile LAS unsigned* MISC; int G, c;
    __device__ __forceinline__ bool next(int i, pg8::Unit& u) const {
        const int total = (int)MISC[48]; int rt, pl;
        if ((G & 7) == 0 && ((G >> 3) % NC) == 0) { const int rpr = G / NC, perx = rpr >> 3, xcd = c & 7, s = c >> 3; rt = i * rpr + xcd * perx + s / NC; pl = s % NC; }
        else { const int L = i * G + c; rt = L / NC; pl = L % NC; }
        if (rt >= total) return false;
        int e = 0;
        for (int q = 1; q < 32; ++q) e += ((int)MISC[16 + q] <= rt) ? 1 : 0;
        const int j = rt - (int)MISC[16 + e];
        u.pm = rt; u.pn = e * NC + pl;
        if (NC == 8) { u.arow0 = e * T + 256 * j; u.nvalid = (int)MISC[64 + e] - 256 * j; u.abase = 0u; }
        else { u.arow0 = 0; u.nvalid = 256; u.abase = (unsigned)rt * (256u * 1024u); }
        return true;
    }
};
__device__ __forceinline__ void moe_prefill_tokens(Frame& F, const pg8::CachedOrder& CS, const int* rowidx) {
    LAS unsigned short* TK = (LAS unsigned short*)(F.lds + pg8::STAGE_BYTES);
    const int total = CS.n * 256;
    for (int base = 0; base < total; base += 2048) {
        int v[4]; int nv[4];
#pragma unroll
        for (int q = 0; q < 4; ++q) { const int idx = base + q * 512 + F.tid, i = idx >> 8, r = idx & 255; v[q] = 0; nv[q] = 0;
            if (idx < total) { const int arow0 = CS.tab[8 * i + 2]; nv[q] = CS.tab[8 * i + 3]; v[q] = rowidx[arow0 + r]; } }
#pragma unroll
        for (int q = 0; q < 4; ++q) { const int idx = base + q * 512 + F.tid, i = idx >> 8, r = idx & 255; if (idx < total) TK[i * 256 + pg8::tk_pos(r)] = (unsigned short)((r < nv[q]) ? (v[q] >> 2) : T); }
    }
    __syncthreads();
}
struct EpiUp {
    static constexpr bool PERM = true, HAS_MID = false; static constexpr int NST = 8; unsigned char* ACT; const float* BUPP; int skip;
    __device__ __forceinline__ void operator()(const f32x4 (&acc)[2][2][4][2], const pg8::Unit& u, int wr, int wc, int fr, int fq) const {
        if (skip) { if (acc[0][0][0][0][0] == 12345.678f) ACT[0] = 1; return; }
        const int e = u.pn >> 3, pl = u.pn & 7, row0 = u.pm * 256 + wr * 64 + fr, cl = wc * 32 + 8 * fq;
        const float* bp = BUPP + e * 2048 + 256 * pl + cl;
        const f32x4 bg0 = *(const f32x4*)bp, bg1 = *(const f32x4*)(bp + 4), bl0 = *(const f32x4*)(bp + 128), bl1 = *(const f32x4*)(bp + 132);
#pragma unroll
        for (int ai = 0; ai < 2; ++ai)
#pragma unroll
            for (int m = 0; m < 4; ++m) { unsigned char* rp = ACT + (size_t)(row0 + 128 * ai + 16 * m) * 1024 + 128 * pl + cl;
                const f32x4 g0 = acc[ai][0][m][0] * W8_INV + bg0, g1 = acc[ai][0][m][1] * W8_INV + bg1, l0 = acc[ai][1][m][0] * W8_INV + bl0, l1 = acc[ai][1][m][1] * W8_INV + bl1;
                const f32x2 o0 = swiglu_2((f32x2){g0[0], g0[1]}, (f32x2){l0[0], l0[1]}), o1 = swiglu_2((f32x2){g0[2], g0[3]}, (f32x2){l0[2], l0[3]}),
                            o2 = swiglu_2((f32x2){g1[0], g1[1]}, (f32x2){l1[0], l1[1]}), o3 = swiglu_2((f32x2){g1[2], g1[3]}, (f32x2){l1[2], l1[3]});
                *(unsigned long long*)rp = (unsigned long long)pk4_fp8(o0.x, o0.y, o1.x, o1.y) | ((unsigned long long)pk4_fp8(o2.x, o2.y, o3.x, o3.y) << 32); }
    }
};
constexpr float Y8_SCALE = 8.f, Y8_INV = 0.125f;
struct EpiDn {
    static constexpr bool PERM = true, HAS_MID = false; static constexpr int NST = 8; unsigned char* Y; const float* b_dn;
    __device__ __forceinline__ void operator()(const f32x4 (&acc)[2][2][4][2], const pg8::Unit& u, int wr, int wc, int fr, int fq) const {
        const bool odd = (fq & 1) != 0; const int e = u.pn >> 2, pl = u.pn & 3, row0 = u.pm * 256 + wr * 64 + fr, cl = wc * 32 + 8 * fq; const float* bp = b_dn + e * 1024 + 256 * pl + cl;
        f32x4 bv[2][2];
#pragma unroll
        for (int bj = 0; bj < 2; ++bj) { bv[bj][0] = *(const f32x4*)(bp + 128 * bj) * Y8_SCALE; bv[bj][1] = *(const f32x4*)(bp + 128 * bj + 4) * Y8_SCALE; }
#pragma unroll
        for (int ai = 0; ai < 2; ++ai)
#pragma unroll
            for (int m = 0; m < 4; ++m) { unsigned char* rp = Y + (size_t)(row0 + 128 * ai + 16 * m) * 1024 + 256 * pl + cl; unsigned long long w[2];
#pragma unroll
                for (int bj = 0; bj < 2; ++bj) { const f32x4 v0 = acc[ai][bj][m][0] * (W8_INV * Y8_SCALE) + bv[bj][0], v1 = acc[ai][bj][m][1] * (W8_INV * Y8_SCALE) + bv[bj][1];
                    w[bj] = (unsigned long long)pk4_fp8(v0[0], v0[1], v0[2], v0[3]) | ((unsigned long long)pk4_fp8(v1[0], v1[1], v1[2], v1[3]) << 32); }
                *(v4u*)(rp + (odd ? 120 : 0)) = pair16(w[0], w[1], odd); }
    }
};
__device__ __forceinline__ void p9_final(Frame& F) {
    moe_tables(F);
    const int gw = (int)blockIdx.x * NWAVES + F.wave, NGW = F.G * NWAVES; const float* MOD = (const float*)(F.ws + WS_MOD); const unsigned char* Y = F.ws + WS_Y;
    const int* SLOT = (const int*)(F.ws + WS_GATL); const float* TOPW = (const float*)(F.ws + WS_TOPW); const bf16* X1B = (const bf16*)(F.ws + WS_X1B);
    for (int row = gw; row < T; row += NGW) {
        const float* g2 = MOD + (size_t)(row / SEQ) * 6144 + 5120;
        const v4u sl = *(const GAS v4u*)(SLOT + row * 4); const f32x4 gt = *(const GAS f32x4*)(TOPW + row * 4);
        const unsigned slv[4] = {sl.x, sl.y, sl.z, sl.w}; const float gtv[4] = {gt.x * Y8_INV, gt.y * Y8_INV, gt.z * Y8_INV, gt.w * Y8_INV}; const unsigned char* yr[4];
#pragma unroll
        for (int k = 0; k < 4; ++k) yr[k] = Y + ((size_t)F.MISC[16 + (slv[k] >> 16)] * 256 + (slv[k] & 0xffffu)) * DM;
#pragma unroll
        for (int j = 0; j < 4; ++j) {
            const int c = 4 * F.lane + 256 * j;
            const unsigned long long xw = *(const GAS unsigned long long*)(X1B + (size_t)row * DM + c); const unsigned xl = (unsigned)xw, xh = (unsigned)(xw >> 32);
            const f32x4 g = *(const GAS f32x4*)(g2 + c);
            float s0 = 0.f, s1 = 0.f, s2 = 0.f, s3 = 0.f;
#pragma unroll
            for (int k = 0; k < 4; ++k) { const unsigned y = *(const GAS unsigned*)(yr[k] + c);
                s0 += gtv[k] * __builtin_amdgcn_cvt_f32_fp8(y, 0); s1 += gtv[k] * __builtin_amdgcn_cvt_f32_fp8(y, 1); s2 += gtv[k] * __builtin_amdgcn_cvt_f32_fp8(y, 2); s3 += gtv[k] * __builtin_amdgcn_cvt_f32_fp8(y, 3); }
            f32x4 ov_ = {bflo(xl) + g.x * s0, bfhi(xl) + g.y * s1, bflo(xh) + g.z * s2, bfhi(xh) + g.w * s3};
#ifdef DBG_STAT
            { const unsigned long long* dbg = (const unsigned long long*)(F.ws + WS_TMP); const float us = (DBG_STAT == 4) ? (float)dbg[3] : 8.f * floorf(((float)dbg[DBG_STAT] * 0.01f + DBG_OFS) * 0.125f); ov_ = ov_ + sqrtf(us) * 0.03125f; }
#endif
            *(GAS f32x4*)(F.out + (size_t)row * DM + c) = ov_;
        }
    }
}
typedef short v4i16_t __attribute__((ext_vector_type(4)));
namespace att {
constexpr int L_K = 0, L_V = 32768, L_OST = 65536, L_WSF = 98304;
constexpr float SC2 = 0.125f * 1.4426950408889634f;
__device__ __forceinline__ int crow(int r, int hi) { return (r & 3) + 8 * (r >> 2) + 4 * hi; }
__device__ __forceinline__ bf16x8 vtr2(LAS const unsigned char* p) {
    const v4i16_t lo = __builtin_amdgcn_ds_read_tr16_b64_v4i16((LAS v4i16_t*)p), hi = __builtin_amdgcn_ds_read_tr16_b64_v4i16((LAS v4i16_t*)(p + 512));
    return (bf16x8){lo[0], lo[1], lo[2], lo[3], hi[0], hi[1], hi[2], hi[3]};
}
__device__ __forceinline__ void unit(Frame& F, int b, int kvh, int qb) {
    const bf16* AQ = (const bf16*)(F.ws + WS_AQ); const bf16* AKV = (const bf16*)(F.ws + WS_AKV); unsigned char* HOAO = F.ws + WS_HOAO;
    const int tid = F.tid, lane = F.lane, wave = F.wave, r32 = lane & 31, hi = lane >> 5;
    const int tq0 = b * SEQ + qb * 128, tk0 = tq0 - 128;
    {
        const int key = tid >> 1, half = tid & 1; const bool valid = (qb > 0) || (key >= 128); const int token = valid ? tk0 + key : tq0;
        const bf16* kp = AKV + (size_t)token * 256 + kvh * 64 + half * 32;
        v4u kr[4], vr[4];
#pragma unroll
        for (int q = 0; q < 4; ++q) { kr[q] = *(const GAS v4u*)(kp + 8 * q); vr[q] = *(const GAS v4u*)(kp + 128 + 8 * q); }
        float x[32]; float ss = 0.f;
#pragma unroll
        for (int q = 0; q < 4; ++q) { x[8 * q + 0] = bflo(kr[q].x); x[8 * q + 1] = bfhi(kr[q].x); x[8 * q + 2] = bflo(kr[q].y); x[8 * q + 3] = bfhi(kr[q].y);
            x[8 * q + 4] = bflo(kr[q].z); x[8 * q + 5] = bfhi(kr[q].z); x[8 * q + 6] = bflo(kr[q].w); x[8 * q + 7] = bfhi(kr[q].w); }
#pragma unroll
        for (int d = 0; d < 32; ++d) ss += x[d] * x[d];
        ss += __shfl_xor(ss, 1);
        const float rstd = valid ? rsqrtf(ss * (1.f / 64.f) + EPS) : 0.f;
#pragma unroll
        for (int q = 0; q < 8; ++q) { const f32x4 g = *(const GAS f32x4*)(F.kg() + half * 32 + 4 * q); x[4 * q] *= rstd * g.x; x[4 * q + 1] *= rstd * g.y; x[4 * q + 2] *= rstd * g.z; x[4 * q + 3] *= rstd * g.w; }
        if (half == 0) { const int p = F.pos()[token];
#pragma unroll
            for (int i = 0; i < 8; ++i) { float cs, sn; rope_cs(p, i, cs, sn); const float x1 = x[i], x2 = x[i + 8]; x[i] = x1 * cs - x2 * sn; x[i + 8] = x2 * cs + x1 * sn; } }
#pragma unroll
        for (int q = 0; q < 4; ++q) { v4u w; w.x = pk2(x[8 * q], x[8 * q + 1]); w.y = pk2(x[8 * q + 2], x[8 * q + 3]); w.z = pk2(x[8 * q + 4], x[8 * q + 5]); w.w = pk2(x[8 * q + 6], x[8 * q + 7]);
            *(LAS v4u*)(F.lds + L_K + (half * 4 + q) * 4096 + key * 16) = w; }
        const int kk = key & 63; LAS unsigned char* vd = F.lds + L_V + (key >> 6) * 8192 + half * 4096 + (kk >> 4) * 1024 + (kk & 15) * 64;
#pragma unroll
        for (int q = 0; q < 4; ++q) { v4u w = vr[q]; if (!valid) w = (v4u){0u, 0u, 0u, 0u}; *(LAS v4u*)(vd + 16 * q) = w; }
    }
    __syncthreads();
    LAS float* wsf = (LAS float*)(F.lds + L_WSF) + wave * 64;
    LAS unsigned char* stg = F.lds + L_OST + wave * 4096;
    LAS const unsigned char* vbase = F.lds + L_V + ((lane >> 4) & 1) * 32 + (lane & 3) * 8 + (4 * hi + ((lane & 15) >> 2)) * 64;
#pragma unroll 1
    for (int sbi = 0; sbi < 2; ++sbi) {
        const int sb = wave * 2 + sbi, g = sb >> 2, r0 = (sb & 3) * 32, hq = kvh * 4 + g, tq = tq0 + r0 + r32;
        bf16x8 qr[4];
        {
            const bf16* qp = AQ + (size_t)tq * 512 + hq * 64 + 8 * hi; float x[4][8]; float ss = 0.f;
#pragma unroll
            for (int d0 = 0; d0 < 4; ++d0) { const v4u r = *(const GAS v4u*)(qp + 16 * d0); x[d0][0] = bflo(r.x); x[d0][1] = bfhi(r.x); x[d0][2] = bflo(r.y); x[d0][3] = bfhi(r.y); x[d0][4] = bflo(r.z); x[d0][5] = bfhi(r.z); x[d0][6] = bflo(r.w); x[d0][7] = bfhi(r.w); }
#pragma unroll
            for (int d0 = 0; d0 < 4; ++d0)
#pragma unroll
                for (int j = 0; j < 8; ++j) ss += x[d0][j] * x[d0][j];
            ss += __shfl_xor(ss, 32);
            const float rs = rsqrtf(ss * (1.f / 64.f) + EPS) * SC2;
#pragma unroll
            for (int d0 = 0; d0 < 4; ++d0) { const f32x4 g0 = *(const GAS f32x4*)(F.qg() + 16 * d0 + 8 * hi), g1 = *(const GAS f32x4*)(F.qg() + 16 * d0 + 8 * hi + 4);
                x[d0][0] *= rs * g0.x; x[d0][1] *= rs * g0.y; x[d0][2] *= rs * g0.z; x[d0][3] *= rs * g0.w; x[d0][4] *= rs * g1.x; x[d0][5] *= rs * g1.y; x[d0][6] *= rs * g1.z; x[d0][7] *= rs * g1.w; }
            const int p = F.pos()[tq];
#pragma unroll
            for (int j = 0; j < 8; ++j) { float cs, sn; rope_cs(p, j, cs, sn); const float mine = x[0][j], oth = __shfl_xor(mine, 32); x[0][j] = mine * cs + (hi ? oth : -oth) * sn; }
#pragma unroll
            for (int d0 = 0; d0 < 4; ++d0) { v4u w; w.x = pk2(x[d0][0], x[d0][1]); w.y = pk2(x[d0][2], x[d0][3]); w.z = pk2(x[d0][4], x[d0][5]); w.w = pk2(x[d0][6], x[d0][7]); qr[d0] = __builtin_bit_cast(bf16x8, w); }
        }
        const int kt0 = r0 >> 5, qi = r0 + r32;
        f32x16 p[5];
#pragma unroll
        for (int t = 0; t < 5; ++t) {
            f32x16 a = {};
#pragma unroll
            for (int d0 = 0; d0 < 4; ++d0) { const bf16x8 kf = *(const LAS bf16x8*)(F.lds + L_K + (2 * d0 + hi) * 4096 + (32 * (kt0 + t) + r32) * 16); a = __builtin_amdgcn_mfma_f32_32x32x16_bf16(kf, qr[d0], a, 0, 0, 0); }
            if (t == 0) {
#pragma unroll
                for (int r = 0; r < 16; ++r) a[r] = (crow(r, hi) > r32) ? a[r] : -INFINITY; }
            if (t == 4) {
#pragma unroll
                for (int r = 0; r < 16; ++r) a[r] = (crow(r, hi) <= r32) ? a[r] : -INFINITY; }
            if (qb == 0 && kt0 + t < 4) {
#pragma unroll
                for (int r = 0; r < 16; ++r) a[r] = -INFINITY; }
            p[t] = a;
        }
        const float sink2 = F.sinks()[hq] * 1.4426950408889634f;
        float m = sink2;
#pragma unroll
        for (int t = 0; t < 5; ++t)
#pragma unroll
            for (int r = 0; r < 16; ++r) m = fmaxf(m, p[t][r]);
        m = fmaxf(m, __shfl_xor(m, 32));
        float l = 0.f;
#pragma unroll
        for (int t = 0; t < 5; ++t)
#pragma unroll
            for (int r = 0; r < 16; ++r) { const float e = __builtin_amdgcn_exp2f(p[t][r] - m); p[t][r] = e; l += e; }
        l += __shfl_xor(l, 32);
        l += __builtin_amdgcn_exp2f(sink2 - m);
        f32x16 o[2]; o[0] = (f32x16){}; o[1] = (f32x16){};
#pragma unroll
        for (int t = 0; t < 5; ++t) {
            const int kt = kt0 + t; LAS const unsigned char* vs = vbase + (kt >> 1) * 8192 + (2 * (kt & 1)) * 1024;
#pragma unroll
            for (int s = 0; s < 2; ++s) {
                v4u w; w.x = pk2(p[t][8 * s], p[t][8 * s + 1]); w.y = pk2(p[t][8 * s + 2], p[t][8 * s + 3]); w.z = pk2(p[t][8 * s + 4], p[t][8 * s + 5]); w.w = pk2(p[t][8 * s + 6], p[t][8 * s + 7]);
                const bf16x8 pa = __builtin_bit_cast(bf16x8, w);
#pragma unroll
                for (int d0 = 0; d0 < 2; ++d0) { const bf16x8 vf = vtr2(vs + d0 * 4096 + s * 1024); o[d0] = __builtin_amdgcn_mfma_f32_32x32x16_bf16(pa, vf, o[d0], 0, 0, 0); }
            }
        }
        if (hi == 0) wsf[r32] = l;
        LDS_WAIT(); asm volatile("" ::: "memory");
#pragma unroll
        for (int r = 0; r < 16; ++r) { const int orow = crow(r, hi); const float rl = __builtin_amdgcn_rcpf(wsf[orow]);
#pragma unroll
            for (int d0 = 0; d0 < 2; ++d0) { const float ov = o[d0][r] * rl; stg[orow * 64 + d0 * 32 + r32] = (unsigned char)(__builtin_amdgcn_cvt_pk_fp8_f32(ov, ov, 0, false) & 0xff); } }
        LDS_WAIT(); asm volatile("" ::: "memory");
#pragma unroll
        for (int i = 0; i < 2; ++i) { const int row = i * 16 + (lane >> 2), ch = lane & 3; const v4u v = *(const LAS v4u*)(stg + row * 64 + ch * 16);
            *(GAS v4u*)(HOAO + (size_t)(tq0 + r0 + row) * 1024 + 512 + hq * 64 + ch * 16) = v; }
        LDS_WAIT(); asm volatile("" ::: "memory");
    }
    __syncthreads();
}
}

namespace hg {
typedef float f32x2v __attribute__((ext_vector_type(2)));
constexpr int PK = 272, PJ = 144;
constexpr int L_QE = 0, L_KE = 17408, L_KDT = 34816, L_VT = 53248, L_P = 71680, L_ST = 80896, L_OST = 115712, L_SEGP = 149504, L_DK = 153600;
constexpr int OP = 132;
__device__ __forceinline__ void run(Frame& F, int b, int h) {
    const bf16* QH = (const bf16*)(F.ws + WS_QH); const bf16* LF = (const bf16*)(F.ws + WS_LF); const bf16* VH = (const bf16*)(F.ws + WS_VH); const bf16* GH = (const bf16*)(F.ws + WS_GH);
    unsigned char* HOAO = F.ws + WS_HOAO;
    const int tid = F.tid, lane = F.lane, wave = F.wave, r32 = lane & 31, hi = lane >> 5;
    LAS unsigned char* L = F.lds;
    LAS float* SEGP = (LAS float*)(L + L_SEGP); LAS float* DK = (LAS float*)(L + L_DK); LAS float* OST = (LAS float*)(L + L_OST);
    for (int i = tid; i < (L_OST - L_P) / 16; i += 512) *(LAS v4u*)(L + L_P + i * 16) = (v4u){0u, 0u, 0u, 0u};
    f32x16 st[2]; st[0] = (f32x16){}; st[1] = (f32x16){};
    const int kp2 = 2 * lane;
    const size_t rowb = (size_t)b * SEQ;
    float fv[8][2]; unsigned qv[8], vv[8];
    unsigned lr[8], qr_[8], vr_[8];
    const int oi = tid >> 3, os = tid & 7;
    float gn[16];
#pragma unroll
    for (int q = 0; q < 4; ++q) { const f32x4 g = *(const GAS f32x4*)(F.hgg() + 16 * os + 4 * q); gn[4 * q] = g.x; gn[4 * q + 1] = g.y; gn[4 * q + 2] = g.z; gn[4 * q + 3] = g.w; }
#define HG_LOAD(c) do { _Pragma("unroll") for (int jj = 0; jj < 8; ++jj) { const size_t row = rowb + (size_t)(c) * 64 + 8 * wave + jj; \
        lr[jj] = *(const GAS unsigned*)(LF + row * 512 + h * 128 + kp2); \
        qr_[jj] = *(const GAS unsigned*)(QH + row * 512 + h * 128 + kp2); vr_[jj] = *(const GAS unsigned*)(VH + row * 512 + h * 128 + kp2); } } while (0)
#define HG_A1() do { float p0 = 1.f, p1 = 1.f; _Pragma("unroll") for (int jj = 0; jj < 8; ++jj) { fv[jj][0] = __expf(bflo(lr[jj])); fv[jj][1] = __expf(bfhi(lr[jj])); p0 *= fv[jj][0]; p1 *= fv[jj][1]; qv[jj] = qr_[jj]; vv[jj] = vr_[jj]; } \
        *(LAS f32x2v*)(SEGP + wave * 128 + kp2) = (f32x2v){p0, p1}; } while (0)
    HG_LOAD(0); HG_A1(); HG_LOAD(1);
    __syncthreads();
#ifdef DBG_HG
    unsigned long long hs[4] = {0, 0, 0, 0}, ht = __builtin_amdgcn_s_memrealtime();
#define HG_STAMP(k) do { const unsigned long long n_ = __builtin_amdgcn_s_memrealtime(); hs[k] += n_ - ht; ht = n_; } while (0)
#else
#define HG_STAMP(k) do {} while (0)
#endif
#pragma unroll 1
    for (int c = 0; c < SEQ / 64; ++c) {
        {
            float pre0 = 1.f, pre1 = 1.f, all0 = 1.f, all1 = 1.f;
#pragma unroll
            for (int s = 0; s < 8; ++s) { const f32x2v sp = *(const LAS f32x2v*)(SEGP + s * 128 + kp2); all0 *= sp.x; all1 *= sp.y; if (s < wave) { pre0 *= sp.x; pre1 *= sp.y; } }
            if (wave == 0) *(LAS f32x2v*)(DK + kp2) = (f32x2v){all0, all1};
            f32x2 e2 = {pre0, pre1}; const f32x2 all2 = {all0, all1}; unsigned kd0[4], kd1[4], vt0[4], vt1[4]; f32x2 dprev = {0.f, 0.f};
#pragma unroll
            for (int jj = 0; jj < 8; ++jj) {
                const f32x2 f2 = {fv[jj][0], fv[jj][1]};
                e2 = e2 * f2;
                const f32x2 ke2 = (1.0f - f2) * rcp_2(e2), qe2 = (f32x2){bflo(qv[jj]), bfhi(qv[jj])} * e2, d2 = ke2 * all2;
                const int j = 8 * wave + jj;
                *(LAS unsigned*)(L + L_QE + j * PK + kp2 * 2) = pk2(qe2.x, qe2.y);
                *(LAS unsigned*)(L + L_KE + j * PK + kp2 * 2) = pk2(ke2.x, ke2.y);
                if (jj & 1) { kd0[jj >> 1] = pk2(dprev.x, d2.x); kd1[jj >> 1] = pk2(dprev.y, d2.y); vt0[jj >> 1] = (vv[jj - 1] & 0xffffu) | (vv[jj] << 16); vt1[jj >> 1] = (vv[jj - 1] >> 16) | (vv[jj] & 0xffff0000u); }
                else dprev = d2;
            }
            *(LAS v4u*)(L + L_KDT + kp2 * PJ + 16 * wave) = (v4u){kd0[0], kd0[1], kd0[2], kd0[3]};
            *(LAS v4u*)(L + L_KDT + (kp2 + 1) * PJ + 16 * wave) = (v4u){kd1[0], kd1[1], kd1[2], kd1[3]};
            *(LAS v4u*)(L + L_VT + kp2 * PJ + 16 * wave) = (v4u){vt0[0], vt0[1], vt0[2], vt0[3]};
            *(LAS v4u*)(L + L_VT + (kp2 + 1) * PJ + 16 * wave) = (v4u){vt1[0], vt1[1], vt1[2], vt1[3]};
        }
        const size_t orow = rowb + (size_t)c * 64 + oi;
        const v4u gg0 = *(const GAS v4u*)(GH + orow * 512 + h * 128 + 16 * os), gg1 = *(const GAS v4u*)(GH + orow * 512 + h * 128 + 16 * os + 8);
        __syncthreads();
        HG_STAMP(0);
        for (int tl = wave; tl < 10; tl += 8) {
            const int ib = (tl >= 1) + (tl >= 3) + (tl >= 6), jb = tl - ((ib * (ib + 1)) >> 1);
            typedef float f32x4v __attribute__((ext_vector_type(4)));
            f32x4v a = {0.f, 0.f, 0.f, 0.f}; const int l15 = lane & 15, l4 = lane >> 4;
#pragma unroll
            for (int s = 0; s < 4; ++s) { const bf16x8 af = *(const LAS bf16x8*)(L + L_QE + (16 * ib + l15) * PK + (32 * s + 8 * l4) * 2), bfr = *(const LAS bf16x8*)(L + L_KE + (16 * jb + l15) * PK + (32 * s + 8 * l4) * 2);
                a = __builtin_amdgcn_mfma_f32_16x16x32_bf16(af, bfr, a, 0, 0, 0); }
#pragma unroll
            for (int r = 0; r < 4; ++r) { const int i = 16 * ib + 4 * l4 + r, j = 16 * jb + l15; const float v = (j <= i) ? a[r] : 0.f; *(LAS bf16*)(L + L_P + i * PJ + j * 2) = f2bf(v); }
        }
        const int ib = wave >> 2, vb = wave & 3;
        f32x16 o = {};
#pragma unroll
        for (int s = 0; s < 8; ++s) { const bf16x8 af = *(const LAS bf16x8*)(L + L_QE + (32 * ib + r32) * PK + (16 * s + 8 * hi) * 2), bfr = *(const LAS bf16x8*)(L + L_ST + (32 * vb + r32) * PK + (16 * s + 8 * hi) * 2);
            o = __builtin_amdgcn_mfma_f32_32x32x16_bf16(af, bfr, o, 0, 0, 0); }
#pragma unroll
        for (int q = 0; q < 2; ++q) { const int kb = 2 * (wave >> 2) + q; const float dk = DK[32 * kb + r32];
#pragma unroll
            for (int r = 0; r < 16; ++r) st[q][r] *= dk;
#pragma unroll
            for (int s = 0; s < 4; ++s) { const bf16x8 af = *(const LAS bf16x8*)(L + L_VT + (32 * vb + r32) * PJ + (16 * s + 8 * hi) * 2), bfr = *(const LAS bf16x8*)(L + L_KDT + (32 * kb + r32) * PJ + (16 * s + 8 * hi) * 2);
                st[q] = __builtin_amdgcn_mfma_f32_32x32x16_bf16(af, bfr, st[q], 0, 0, 0); } }
        HG_A1(); { const int cn = (c + 2 < SEQ / 64) ? c + 2 : SEQ / 64 - 1; HG_LOAD(cn); }
        __syncthreads();
        HG_STAMP(1);
#pragma unroll
        for (int s = 0; s < 4; ++s) { const bf16x8 af = *(const LAS bf16x8*)(L + L_P + (32 * ib + r32) * PJ + (16 * s + 8 * hi) * 2), bfr = *(const LAS bf16x8*)(L + L_VT + (32 * vb + r32) * PJ + (16 * s + 8 * hi) * 2);
            o = __builtin_amdgcn_mfma_f32_32x32x16_bf16(af, bfr, o, 0, 0, 0); }
#pragma unroll
        for (int r = 0; r < 16; ++r) OST[(32 * ib + att::crow(r, hi)) * OP + 32 * vb + r32] = o[r];
#pragma unroll
        for (int q = 0; q < 2; ++q) { const int kb = 2 * (wave >> 2) + q;
#pragma unroll
            for (int r = 0; r < 16; ++r) *(LAS bf16*)(L + L_ST + (32 * vb + att::crow(r, hi)) * PK + (32 * kb + r32) * 2) = f2bf(st[q][r]); }
        __syncthreads();
        HG_STAMP(2);
        {
            float ov[16]; float ss = 0.f;
#pragma unroll
            for (int q = 0; q < 4; ++q) { const f32x4 t = *(const LAS f32x4*)(OST + oi * OP + 16 * os + 4 * q); ov[4 * q] = t.x; ov[4 * q + 1] = t.y; ov[4 * q + 2] = t.z; ov[4 * q + 3] = t.w; ss += (t.x * t.x + t.y * t.y) + (t.z * t.z + t.w * t.w); }
            ss += __shfl_xor(ss, 1); ss += __shfl_xor(ss, 2); ss += __shfl_xor(ss, 4);
            const float rstd = rsqrtf(ss * (1.f / 128.f) + EPS);
            const unsigned gw[8] = {gg0.x, gg0.y, gg0.z, gg0.w, gg1.x, gg1.y, gg1.z, gg1.w}; float of[16];
#pragma unroll
            for (int q = 0; q < 8; ++q) { of[2 * q] = ov[2 * q] * rstd * gn[2 * q] * bflo(gw[q]); of[2 * q + 1] = ov[2 * q + 1] * rstd * gn[2 * q + 1] * bfhi(gw[q]); }
            *(GAS v4u*)(HOAO + orow * 1024 + h * 128 + 16 * os) = (v4u){pk4_fp8(of[0], of[1], of[2], of[3]), pk4_fp8(of[4], of[5], of[6], of[7]), pk4_fp8(of[8], of[9], of[10], of[11]), pk4_fp8(of[12], of[13], of[14], of[15])};
        }
        HG_STAMP(3);
    }
#ifdef DBG_HG
    if (blockIdx.x == 0 && tid == 0) { unsigned long long* dbg = (unsigned long long*)(F.ws + WS_TMP); dbg[0] = hs[0]; dbg[1] = hs[1]; dbg[2] = hs[2]; dbg[3] = hs[3]; }
#endif
#undef HG_STAMP
#undef HG_LOAD
#undef HG_A1
    __syncthreads();
}
}
__device__ __forceinline__ void p3_mixers(Frame& F, int sub) {
    constexpr int NHG = 64;
    if ((int)blockIdx.x < NHG) { if (sub & 1) { for (int u = blockIdx.x; u < BATCH * 4; u += NHG) hg::run(F, u >> 2, u & 3); } }
    else { const int na = F.G - NHG; if (sub & 2) { for (int u = (int)blockIdx.x - NHG; u < BATCH * 2 * 16; u += na) att::unit(F, u >> 5, (u >> 4) & 1, u & 15); }
        if (sub & 4) moe_weight_copies(F, ((int)blockIdx.x - NHG) * NWAVES + F.wave, na * NWAVES); }
}

struct Args { const void* in[22]; float* out; unsigned char* ws; int ph_lo, ph_hi, one, sub; };
__global__ void __launch_bounds__(NWAVES * 64, 2) skel_fwd(Args args) {
    extern __shared__ __attribute__((aligned(16))) unsigned char lds[];
    Frame F;
    F.lds = (LAS unsigned char*)lds; F.MISC = (volatile LAS unsigned*)(F.lds + MISC_OFF);
    F.tid = threadIdx.x; F.lane = F.tid & 63; F.wave = __builtin_amdgcn_readfirstlane(F.tid >> 6); F.G = gridDim.x;
    F.out = args.out; F.ws = args.ws; F.ctl = (gu32*)(args.ws + WS_CTL);
    for (int u = F.tid; u < (LDS_BYTES - LDSCTL_OFF) / 4; u += NWAVES * 64) ((LAS unsigned*)(F.lds + LDSCTL_OFF))[u] = 0u;
    __syncthreads();
    XcdBarrier bar; bar.bar = (unsigned*)(F.ctl + CW_BAR); bar.x = 0; bar.st = nullptr;
    if (args.one) bar = xcd_barrier_post((unsigned*)(F.ctl + CW_BAR), F.MISC + 8);
    const int lo = args.ph_lo, hi = args.ph_hi;
#define IN(k) (lo <= (k) && (k) < hi)
#ifndef PROBE_MASK
#define PROBE_MASK 0
#endif
#define REP(k) for (int rep_ = 0; rep_ < (((PROBE_MASK >> (k)) & 1) ? 2 : 1); ++rep_)
#define RSEAM() do { if (rep_ == 0 && ((PROBE_MASK) != 0)) { if (args.one) xcd_barrier(bar); } } while (0)
#define SEAM(k) do { if (IN(k) && IN((k) + 1)) xcd_barrier(bar); } while (0)
    unsigned char* ws = args.ws;
    if (IN(0)) { REP(0) { p0_prologue(F); if ((PROBE_MASK >> 0) & 1) RSEAM(); } SEAM(0); }
    if (IN(1)) { REP(1) { dense_weight_copies(F); p1_xn(F); if ((PROBE_MASK >> 1) & 1) RSEAM(); } SEAM(1); }
    if (IN(2)) REP(2) {
        pg8::Gemm g{(const bf16*)(ws + WS_XN), (const bf16*)(ws + WS_WIN), T, INW, 1024, nullptr, 0, 1024}; pg8::StaticOrder S; S.init(T, INW, F.G, (int)blockIdx.x); S.abase_per_pm = 256u * 1024u;
        { LAS unsigned short* TK = (LAS unsigned short*)(F.lds + pg8::STAGE_BYTES); for (int i = F.tid; i < pg8::MAXU * 256; i += 512) TK[(i & ~255) + pg8::tk_pos(i & 255)] = (unsigned short)(i & 255); __syncthreads(); }
        pg8::CachedOrder CS; CS.build(F.lds, S);
        EpiIn E{ws}; pg8::gemm_phase<EpiIn, pg8::CachedOrder, true, 1, 1>(F.lds, g, CS, E); if ((PROBE_MASK >> 2) & 1) RSEAM();
    }
    SEAM(2);
    if (IN(3)) { REP(3) { p3_mixers(F, args.sub); if ((PROBE_MASK >> 3) & 1) RSEAM(); }
#ifdef DBG_HG
        xcd_barrier(bar); p3_mixers(F, 1);
#endif
        SEAM(3); }
    if (IN(4)) REP(4) {
        PairOrder PS; PS.S.init(T, 1024, F.G, (int)blockIdx.x); PS.S.abase_per_pm = 256u * 1024u; pg8::CachedOrder CS; CS.build(F.lds, PS);
        { LAS unsigned short* TK = (LAS unsigned short*)(F.lds + pg8::STAGE_BYTES); for (int i = F.tid; i < pg8::MAXU * 256; i += 512) TK[(i & ~255) + pg8::tk_pos(i & 255)] = (unsigned short)(i & 255); __syncthreads(); }
        { pg8::Gemm g{(const bf16*)(ws + WS_HOAO), (const bf16*)(ws + WS_WHG), T, 1024, 512, nullptr, 0, 1024}; EpiMrg E{ws + WS_MRG, (const bf16*)(ws + WS_SGH), (const bf16*)(ws + WS_SGA)};
          pg8::gemm_phase<EpiMrg, pg8::CachedOrder, true, 1, 1>(F.lds, g, CS, E); }
        if ((PROBE_MASK >> 4) & 1) RSEAM();
    }
    SEAM(4);
    if (IN(5)) REP(5) {
        pg8::Gemm g{(const bf16*)(ws + WS_MRG), (const bf16*)(ws + WS_WOUT), T, 1024, 1024, nullptr, 0, 1024}; pg8::StaticOrder S; S.init(T, 1024, F.G, (int)blockIdx.x); S.abase_per_pm = 256u * 1024u;
        { LAS unsigned short* TK = (LAS unsigned short*)(F.lds + pg8::STAGE_BYTES); for (int i = F.tid; i < pg8::MAXU * 256; i += 512) TK[(i & ~255) + pg8::tk_pos(i & 255)] = (unsigned short)(i & 255); __syncthreads(); }
        EpiOut E{F.x(), (const float*)(ws + WS_MOD), (bf16*)(ws + WS_X1B), (args.sub >> 3) & 1}; pg8::CachedOrder CS; CS.build(F.lds, S); pg8::gemm_phase<EpiOut, pg8::CachedOrder, true, 1, 1>(F.lds, g, CS, E); if ((PROBE_MASK >> 5) & 1) RSEAM();
    }
    SEAM(5);
    if (IN(6)) { p6_route(F, (args.sub >> 4) & 1); SEAM(6); }
    if (IN(7)) REP(7) {
        moe_tables(F);
        pg8::Gemm g{(const bf16*)(ws + WS_H2), (const bf16*)(ws + WS_WUP), T, NEXP * 2048, 1024, (const int*)(ws + WS_TOKL), T, 1024}; MoeOrder<8> S{F.MISC, F.G, (int)blockIdx.x};
        pg8::CachedOrder CS; CS.build(F.lds, S);
        moe_prefill_tokens(F, CS, (const int*)(ws + WS_TOKL));
        EpiUp E{ws + WS_ACT, (const float*)(ws + WS_BUPP), (args.sub >> 3) & 1};
#if DEV_ORACLE
        if ((args.sub >> 5) & 1) pg8::gemm_phase<EpiUp, pg8::CachedOrder, true, 1, 1, 1>(F.lds, g, CS, E); else if ((args.sub >> 6) & 1) pg8::gemm_phase<EpiUp, pg8::CachedOrder, true, 1, 1, 2>(F.lds, g, CS, E); else
#endif
#if defined(DBG_STAT) && !defined(DBG_HG)
        pg8::gemm_phase<EpiUp, pg8::CachedOrder, true, 1, 1, 0, DBG_BLOCK + 1>(F.lds, g, CS, E, (unsigned long long*)(ws + WS_TMP));
#else
        pg8::gemm_phase<EpiUp, pg8::CachedOrder, true, 1, 1>(F.lds, g, CS, E);
#endif
        if ((PROBE_MASK >> 7) & 1) RSEAM();
    }
    SEAM(7);
    if (IN(8)) REP(8) {
        moe_tables(F);
        pg8::Gemm g{(const bf16*)(ws + WS_ACT), (const bf16*)(ws + WS_WDN), T, NEXP * 1024, 1024, (const int*)(ws + WS_IDT), 0, 1024}; MoeOrder<4> S{F.MISC, F.G, (int)blockIdx.x};
        { LAS unsigned short* TK = (LAS unsigned short*)(F.lds + pg8::STAGE_BYTES); for (int i = F.tid; i < pg8::MAXU * 256; i += 512) TK[(i & ~255) + pg8::tk_pos(i & 255)] = (unsigned short)(i & 255); __syncthreads(); }
        EpiDn E{ws + WS_Y, F.b_dn()}; pg8::CachedOrder CS; CS.build(F.lds, S); pg8::gemm_phase<EpiDn, pg8::CachedOrder, true, 1, 1>(F.lds, g, CS, E); if ((PROBE_MASK >> 8) & 1) RSEAM();
    }
    SEAM(8);
    if (IN(9)) { p9_final(F); }
#undef IN
#undef SEAM
}

#ifndef DEV_MASK
#define DEV_MASK 0x3ff
#ifndef DEV_SUB
#define DEV_SUB 7
#endif
#endif

#if DEV_ORACLE
template <int KIND> __global__ void __launch_bounds__(512, 2) mfma_bench(float* sink, int iters) {
    typedef int v8i __attribute__((ext_vector_type(8))); typedef short s8 __attribute__((ext_vector_type(8))); typedef float f4 __attribute__((ext_vector_type(4))); typedef float f16v __attribute__((ext_vector_type(16)));
    v8i a8, b8; s8 ab, bb;
    for (int i = 0; i < 8; ++i) { a8[i] = threadIdx.x * 2654435761u + i; b8[i] = threadIdx.x * 40503u + 7 * i; ab[i] = (short)(threadIdx.x + i); bb[i] = (short)(3 * threadIdx.x + i); }
    f4 c[8]; f16v d[4];
    for (int i = 0; i < 8; ++i) c[i] = (f4){0.f, 0.f, 0.f, 0.f};
    for (int i = 0; i < 4; ++i) d[i] = (f16v){};
    for (int it = 0; it < iters; ++it) {
        if (KIND == 0) {
#pragma unroll
            for (int i = 0; i < 8; ++i) c[i] = __builtin_amdgcn_mfma_f32_16x16x32_bf16(ab, bb, c[i], 0, 0, 0);
        } else if (KIND == 1) {
#pragma unroll
            for (int i = 0; i < 8; ++i) c[i] = __builtin_amdgcn_mfma_scale_f32_16x16x128_f8f6f4(a8, b8, c[i], 0, 0, 0, 0x7F7F7F7F, 0, 0x7F7F7F7F);
        } else {
#pragma unroll
            for (int i = 0; i < 4; ++i) d[i] = __builtin_amdgcn_mfma_scale_f32_32x32x64_f8f6f4(a8, b8, d[i], 0, 0, 0, 0x7F7F7F7F, 0, 0x7F7F7F7F);
        }
    }
    float s = 0.f;
    for (int i = 0; i < 8; ++i) s += c[i][0] + c[i][1] + c[i][2] + c[i][3];
    for (int i = 0; i < 4; ++i) for (int j = 0; j < 16; ++j) s += d[i][j];
    if (s == 123.456f) sink[threadIdx.x] = s;
}
#endif
extern "C" void kernel_launch(void* const* d_in, const int* in_sizes, int n_in, void* d_out, int out_size, void* d_ws, size_t ws_size, hipStream_t stream) {
    static int grid = 0;
    if (grid == 0) {
        if (n_in != 22 || ws_size < WS_END || out_size != T * DM) { fprintf(stderr, "kernel_launch: unexpected shapes n_in %d ws %zu out %d\n", n_in, ws_size, out_size); grid = -1; return; }
        int dev = 0, cus = 0;
        if (hipGetDevice(&dev) != hipSuccess || hipDeviceGetAttribute(&cus, hipDeviceAttributeMultiprocessorCount, dev) != hipSuccess) { grid = -1; return; }
        if (hipFuncSetAttribute((const void*)skel_fwd, hipFuncAttributeMaxDynamicSharedMemorySize, LDS_BYTES) != hipSuccess) { fprintf(stderr, "kernel_launch: hipFuncSetAttribute failed\n"); grid = -1; return; }
        int per_cu = 0;
        if (hipOccupancyMaxActiveBlocksPerMultiprocessor(&per_cu, (const void*)skel_fwd, NWAVES * 64, LDS_BYTES) != hipSuccess || per_cu < 1) { fprintf(stderr, "kernel_launch: occupancy query says %d workgroups per CU; nothing launched\n", per_cu); grid = -1; return; }
        (void)hipGetLastError();
        grid = cus;
    }
    if (grid < 0) return;
    unsigned char* ws = (unsigned char*)d_ws; float* out = (float*)d_out;
#if DEV_ORACLE
    const float* x = (const float*)d_in[0]; const int* pos = (const int*)d_in[2];
    const float* hgg = (const float*)d_in[8]; const float* qg = (const float*)d_in[10]; const float* kg = (const float*)d_in[11];
    const float* sinks = (const float*)d_in[12]; const float* n2g = (const float*)d_in[15]; const float* w_r = (const float*)d_in[16]; const float* b_r = (const float*)d_in[17];
    const float* w_up = (const float*)d_in[18]; const float* b_up = (const float*)d_in[19]; const float* w_dn = (const float*)d_in[20]; const float* b_dn = (const float*)d_in[21];
    float* MOD = (float*)(ws + WS_MOD); float* LB = (float*)(ws + WS_LB);
    bf16* XN = (bf16*)(ws + WS_XN); bf16* QH = (bf16*)(ws + WS_QH); float* LF = (float*)(ws + WS_LF); bf16* VH = (bf16*)(ws + WS_VH); bf16* GH = (bf16*)(ws + WS_GH);
    bf16* AQ = (bf16*)(ws + WS_AQ); bf16* AKV = (bf16*)(ws + WS_AKV); bf16* SGH = (bf16*)(ws + WS_SGH); bf16* SGA = (bf16*)(ws + WS_SGA);
    bf16* HOAO = (bf16*)(ws + WS_HOAO); bf16* MRG = (bf16*)(ws + WS_MRG); bf16* H2 = (bf16*)(ws + WS_H2); bf16* Y = (bf16*)(ws + WS_Y);
    int* TOPI = (int*)(ws + WS_TOPI); float* TOPW = (float*)(ws + WS_TOPW);
    float* OTMP = (float*)(ws + WS_OTMP); float* QN = (float*)(ws + WS_QN); float* KN = (float*)(ws + WS_KN);
#endif
    (void)hipMemsetAsync(ws + WS_CTL, 0, CTL_ZERO_BYTES, stream);
    Args a{}; for (int i = 0; i < 22; ++i) a.in[i] = d_in[i];
    a.out = out; a.ws = ws; a.one = 0;
#if DEV_ORACLE
#ifndef DEV_REP
#define DEV_REP 0
#endif
#define SK(p) do { a.ph_lo = (p); a.ph_hi = (p) + 1; for (int r_ = 0; r_ < (((DEV_REP >> (p)) & 1) ? 2 : 1); ++r_) hipLaunchKernelGGL(skel_fwd, dim3(grid), dim3(NWAVES * 64), LDS_BYTES, stream, a); } while (0)
#define ON(p) ((DEV_MASK >> (p)) & 1)
    if (ON(0)) SK(0); else { n_mod<<<dim3(24, 16), 256, 0, stream>>>((const float*)d_in[1], (const float*)d_in[3], (const float*)d_in[4], MOD); n_misc<<<4, 256, 0, stream>>>((const float*)d_in[7], LB, H2); }
    if (ON(1)) SK(1); else k_normmod<<<T / 4, 256, 0, stream>>>(x, (const float*)d_in[5], MOD, 0, 1024, XN);
    if (ON(2)) SK(2); else n_gemm<EpiInN><<<dim3(INW / 64, T / 64), 256, 0, stream>>>(XN, 1024, (const float*)d_in[6], INW, 1024, EpiInN{QH, LF, VH, GH, AQ, AKV, SGH, SGA, LB});
    a.sub = ON(3) ? DEV_SUB : 0;
    if (a.sub) { a.ph_lo = 3; a.ph_hi = 4; hipLaunchKernelGGL(skel_fwd, dim3(grid), dim3(NWAVES * 64), LDS_BYTES, stream, a);
#ifdef DEV_SUB2
        a.sub = DEV_SUB2; hipLaunchKernelGGL(skel_fwd, dim3(grid), dim3(NWAVES * 64), LDS_BYTES, stream, a); a.sub = DEV_SUB;
#endif
    }
    if (!(a.sub & 1)) { n_hgrn<<<128, 64, 0, stream>>>(QH, LF, VH, OTMP); n_hgrn_norm<<<T, 256, 0, stream>>>(OTMP, hgg, GH, HOAO); }
    if (!(a.sub & 2)) { n_qkn<<<(T * 10 + 255) / 256, 256, 0, stream>>>(AQ, AKV, pos, qg, kg, QN, KN); n_attn<<<T * 8 / 256, 256, 0, stream>>>(QN, KN, AKV, sinks, HOAO); }
    if (ON(4)) SK(4); else {
        n_gemm<EpiM1N><<<dim3(16, T / 64), 256, 0, stream>>>(HOAO, 1024, (const float*)d_in[9], 1024, 512, EpiM1N{MRG, SGH});
        n_gemm<EpiM2N><<<dim3(16, T / 64), 256, 0, stream>>>(HOAO + 512, 1024, (const float*)d_in[13], 1024, 512, EpiM2N{MRG, SGA});
    }
    if (ON(5)) { SK(5);
#ifdef DEV_SUB5
        a.sub = DEV_SUB5; a.ph_lo = 5; a.ph_hi = 6; hipLaunchKernelGGL(skel_fwd, dim3(grid), dim3(NWAVES * 64), LDS_BYTES, stream, a); a.sub = DEV_SUB;
#endif
    } else n_gemm<EpiOutN><<<dim3(16, T / 64), 256, 0, stream>>>(MRG, 1024, (const float*)d_in[14], 1024, 1024, EpiOutN{x, MOD, out});
    if (ON(6)) { SK(6);
#ifdef DEV_P6_TWICE
        a.sub = DEV_SUB | 16; a.ph_lo = 6; a.ph_hi = 7; hipLaunchKernelGGL(skel_fwd, dim3(grid), dim3(NWAVES * 64), LDS_BYTES, stream, a); a.sub = DEV_SUB;
#endif
    } else n_route<<<T / 4, 256, 0, stream>>>(out, n2g, MOD, w_r, b_r, H2, TOPI, TOPW);
    if (ON(7) && ON(8)) { SK(7);
#ifdef DEV_SUB7
        a.sub = DEV_SUB7; a.ph_lo = 7; a.ph_hi = 8; hipLaunchKernelGGL(skel_fwd, dim3(grid), dim3(NWAVES * 64), LDS_BYTES, stream, a); a.sub = DEV_SUB;
#endif
        SK(8); } else n_moe<<<T * 4, 256, 0, stream>>>(H2, TOPI, TOPW, w_up, b_up, w_dn, b_dn, Y);
#ifdef DEV_BENCH
    mfma_bench<DEV_BENCH><<<256, 512, 0, stream>>>((float*)(ws + WS_TMP), 512);
#endif
    if (ON(9)) SK(9); else k_final<<<T / 4, 256, 0, stream>>>(out, MOD, Y);
#else
    a.one = 1; a.sub = 7; a.ph_lo = 0; a.ph_hi = 10;
    hipLaunchKernelGGL(skel_fwd, dim3(grid), dim3(NWAVES * 64), LDS_BYTES, stream, a);
#endif
}
```
